# Optimizing an MI355X kernel written in HIP

```python
import jax, jax.numpy as jnp
from jax import lax
import numpy as np

D_MODEL = 2048
BATCH = 4
SEQ = 4096
DEPTH = 2

HEAD_DIM = 128
A_HEADS = D_MODEL // (2 * HEAD_DIM)
A_WIDTH = A_HEADS * HEAD_DIM
A_PATTERNS = ((128, 1), (512, 4), (2048, 16))
A_BLOCK = 128
B_KEY_DIM = 128
B_VAL_DIM = 128
B_HEADS = D_MODEL // (2 * B_VAL_DIM)
B_KW = B_HEADS * B_KEY_DIM
B_VW = B_HEADS * B_VAL_DIM
B_CHUNK = 64
C_HEADS = D_MODEL // HEAD_DIM
C_WIDTH = C_HEADS * HEAD_DIM
C_BLOCK = 128
REL_BUCKETS = 32
REL_MAX_DIST = 2048
N_EXPERTS = 64
TOP_K = 8
N_GROUPS = 8
TOPK_GROUPS = 4
EXPERT_DIM = 512
SHARED_DIM = 512
ROUTED_SCALE = 2.5
LN_EPS = 1e-5
RMS_EPS = 1e-6
DN_ALPHA = (2 * DEPTH) ** 0.25
DN_BETA = (8 * DEPTH) ** -0.25
NEG_INF = -1e30
IN0_SIZES = (A_WIDTH, A_WIDTH, A_WIDTH, B_KW, B_KW, B_VW, B_VW)
IN0_WIDTH = sum(IN0_SIZES)
IN1_WIDTH = 3 * C_WIDTH + C_HEADS

kernel_name = 'hybrid_dilated_hgrn2_fox_moe_deepnorm'


def _layer_norm(x, g, b):
    xf = x.astype(jnp.float32)
    mu = jnp.mean(xf, axis=-1, keepdims=True)
    var = jnp.mean(jnp.square(xf - mu), axis=-1, keepdims=True)
    y = (xf - mu) * lax.rsqrt(var + LN_EPS) * g.astype(jnp.float32) + b.astype(jnp.float32)
    return y.astype(x.dtype)


def _t5_bucket(dist):
    max_exact = REL_BUCKETS // 2
    d = np.maximum(dist, 1).astype(np.float64)
    large = max_exact + (np.log(d / max_exact) / np.log(REL_MAX_DIST / max_exact)
                         * (REL_BUCKETS - max_exact)).astype(np.int64)
    large = np.minimum(large, REL_BUCKETS - 1)
    return np.where(dist < max_exact, dist, large).astype(np.int32)


def _dilated_branch(q, k, v, rel_bias, window, dilation):
    bsz, seq, heads, hd = q.shape
    L = seq // dilation
    wd = window // dilation
    nb = -(-L // A_BLOCK)
    Lp = nb * A_BLOCK

    def to_blocks(t):
        t = t.reshape(bsz, L, dilation, heads, hd).transpose(0, 2, 3, 1, 4)
        t = jnp.pad(t, ((0, 0), (0, 0), (0, 0), (0, Lp - L), (0, 0)))
        return t.reshape(bsz, dilation, heads, nb, A_BLOCK, hd)

    def with_prev(t):
        prev = jnp.pad(t, ((0, 0), (0, 0), (0, 0), (1, 0), (0, 0), (0, 0)))[:, :, :, :nb]
        return jnp.concatenate([prev, t], axis=4)

    qb = to_blocks(q)
    kb = with_prev(to_blocks(k))
    vb = with_prev(to_blocks(v))
    qi = np.arange(A_BLOCK)[:, None]
    ki = np.arange(2 * A_BLOCK)[None, :]
    rel = qi + A_BLOCK - ki
    band = (rel >= 0) & (rel <= wd)
    valid = band[None] & ((np.arange(nb)[:, None, None] > 0) | (ki[None] >= A_BLOCK))
    bucket = _t5_bucket(np.clip(rel, 0, None) * dilation)
    bias = rel_bias.astype(jnp.float32)[bucket].transpose(2, 0, 1)[:, None]
    s = jnp.einsum('bdhnqe,bdhnke->bdhnqk', qb, kb).astype(jnp.float32) * HEAD_DIM ** -0.5 + bias
    s = jnp.where(valid, s, NEG_INF)
    m = jnp.max(s, axis=-1, keepdims=True)
    p = jnp.exp(s - m)
    l = jnp.sum(p, axis=-1)
    o = jnp.einsum('bdhnqk,bdhnke->bdhnqe', p, vb.astype(jnp.float32)) / l[..., None]
    lse = m[..., 0] + jnp.log(l)
    o = o.reshape(bsz, dilation, heads, Lp, hd)[:, :, :, :L].transpose(0, 3, 1, 2, 4).reshape(bsz, seq, heads, hd)
    lse = lse.reshape(bsz, dilation, heads, Lp)[..., :L].transpose(0, 3, 1, 2).reshape(bsz, seq, heads)
    return o, lse


def _dilated_mixture(q, k, v, rel_bias):
    outs, lses = [], []
    for window, dilation in A_PATTERNS:
        o, lse = _dilated_branch(q, k, v, rel_bias, window, dilation)
        outs.append(o)
        lses.append(lse)
    w = jax.nn.softmax(jnp.stack(lses, axis=0), axis=0)
    return jnp.sum(w[..., None] * jnp.stack(outs, axis=0), axis=0)


def _hgrn2(q, f_logit, i, g, gn_g, lb):
    f32 = jnp.float32
    bsz, seq, _ = q.shape
    H, dk, dv, C = B_HEADS, B_KEY_DIM, B_VAL_DIM, B_CHUNK
    n = seq // C
    lb = lb.astype(f32).reshape(H, dk)
    fq = jax.nn.silu(q.astype(f32)).reshape(bsz, seq, H, dk)
    forget = lb + (1.0 - lb) * jax.nn.sigmoid(f_logit.astype(f32).reshape(bsz, seq, H, dk))
    log_f = jnp.log(forget)
    key = 1.0 - forget
    val = i.astype(f32).reshape(bsz, seq, H, dv)

    def chunks(t):
        return t.reshape(bsz, n, C, H, t.shape[-1]).transpose(1, 0, 3, 2, 4)

    qc, kc, vc = chunks(fq), chunks(key), chunks(val)
    ac = jnp.cumsum(chunks(log_f), axis=3)
    causal = np.tril(np.ones((C, C), dtype=bool))

    def step(state, xs):
        q_c, k_c, v_c, a_c = xs
        inter = jnp.einsum('bhtk,bhkv->bhtv', q_c * jnp.exp(a_c), state)
        diff = a_c[:, :, :, None, :] - a_c[:, :, None, :, :]
        decay = jnp.exp(jnp.where(causal[:, :, None], diff, NEG_INF))
        scores = jnp.einsum('bhtk,bhsk,bhtsk->bhts', q_c, k_c, decay)
        intra = jnp.einsum('bhts,bhsv->bhtv', scores, v_c)
        a_last = a_c[:, :, -1:, :]
        k_dec = k_c * jnp.exp(a_last - a_c)
        state = jnp.exp(a_last[:, :, 0, :, None]) * state + jnp.einsum('bhsk,bhsv->bhkv', k_dec, v_c)
        return state, inter + intra

    state0 = jnp.zeros((bsz, H, dk, dv), f32)
    _, o = lax.scan(step, state0, (qc, kc, vc, ac))
    o = o.transpose(1, 0, 3, 2, 4).reshape(bsz, seq, H, dv)
    o = o * lax.rsqrt(jnp.mean(o * o, axis=-1, keepdims=True) + RMS_EPS) * gn_g.astype(f32).reshape(H, dv)
    o = o.reshape(bsz, seq, H * dv) * jax.nn.silu(g.astype(f32))
    return o.astype(q.dtype)


def _even_mixer(h, w_in, gn_g, w_out, rel_bias, lb):
    bsz, seq, _ = h.shape
    proj = h @ w_in
    qa, ka, va, qb, fb, ib, gb = jnp.split(proj, list(np.cumsum(IN0_SIZES)[:-1]), axis=-1)
    shp = (bsz, seq, A_HEADS, HEAD_DIM)
    o_a = _dilated_mixture(qa.reshape(shp), ka.reshape(shp), va.reshape(shp), rel_bias)
    o_a = o_a.reshape(bsz, seq, A_WIDTH).astype(h.dtype)
    o_b = _hgrn2(qb, fb, ib, gb, gn_g, lb)
    return jnp.concatenate([o_a, o_b], axis=-1) @ w_out


def _fox_attention(q, k, v, f_logit):
    bsz, seq, heads, hd = q.shape
    nq = seq // C_BLOCK
    c = jnp.cumsum(jax.nn.log_sigmoid(f_logit.astype(jnp.float32)), axis=1)
    c_k = c.transpose(0, 2, 1)[:, :, None, :]
    qb = q.reshape(bsz, nq, C_BLOCK, heads, hd).transpose(1, 0, 2, 3, 4)
    cb = c.reshape(bsz, nq, C_BLOCK, heads).transpose(1, 0, 2, 3)
    qpos = jnp.arange(seq).reshape(nq, C_BLOCK)
    kpos = jnp.arange(seq)

    def block(xs):
        q_blk, c_blk, pos = xs
        s = jnp.einsum('bqhe,bkhe->bhqk', q_blk, k).astype(jnp.float32) * hd ** -0.5
        s = s + c_blk.transpose(0, 2, 1)[..., None] - c_k
        s = jnp.where(kpos[None, :] <= pos[:, None], s, NEG_INF)
        p = jax.nn.softmax(s, axis=-1)
        return jnp.einsum('bhqk,bkhe->bqhe', p.astype(v.dtype), v)

    o = lax.map(block, (qb, cb, qpos))
    return o.transpose(1, 0, 2, 3, 4).reshape(bsz, seq, heads, hd)


def _odd_mixer(h, w_in, b_f, w_out):
    bsz, seq, _ = h.shape
    proj = h @ w_in
    q, k, v, f = jnp.split(proj, [C_WIDTH, 2 * C_WIDTH, 3 * C_WIDTH], axis=-1)
    shp = (bsz, seq, C_HEADS, HEAD_DIM)
    o = _fox_attention(q.reshape(shp), k.reshape(shp), v.reshape(shp), f + b_f)
    return o.reshape(bsz, seq, C_WIDTH) @ w_out


def _moe(h, router_w, router_bias, w_gate, w_up, w_down, s_gate, s_up, s_down):
    bsz, seq, d = h.shape
    t = h.reshape(-1, d)
    n_tok = t.shape[0]
    scores = jax.nn.sigmoid((t @ router_w).astype(jnp.float32))
    sel = scores + router_bias.astype(jnp.float32)
    grouped = sel.reshape(n_tok, N_GROUPS, N_EXPERTS // N_GROUPS)
    group_score = jnp.sum(lax.top_k(grouped, 2)[0], axis=-1)
    _, gidx = lax.top_k(group_score, TOPK_GROUPS)
    gmask = jnp.sum(jax.nn.one_hot(gidx, N_GROUPS, dtype=jnp.float32), axis=1)
    emask = jnp.repeat(gmask, N_EXPERTS // N_GROUPS, axis=1)
    _, eidx = lax.top_k(jnp.where(emask > 0, sel, NEG_INF), TOP_K)
    w = jnp.take_along_axis(scores, eidx, axis=1)
    w = w / jnp.sum(w, axis=-1, keepdims=True) * ROUTED_SCALE
    gate = jnp.sum(jax.nn.one_hot(eidx, N_EXPERTS, dtype=jnp.float32) * w[..., None], axis=1)
    shared = (jax.nn.silu(t @ s_gate) * (t @ s_up)) @ s_down

    def expert_step(acc, xs):
        wg, wu, wd, g_e = xs
        y = (jax.nn.silu(t @ wg) * (t @ wu)) @ wd
        return acc + g_e[:, None].astype(t.dtype) * y, None

    routed, _ = lax.scan(expert_step, jnp.zeros_like(t), (w_gate, w_up, w_down, gate.T))
    return (shared + routed).reshape(bsz, seq, d)


def setup_inputs(seed: int = 0) -> dict:
    key = jax.random.key(seed)
    ks = jax.random.split(key, 21)
    f32 = jnp.float32
    n_even, n_odd = (DEPTH + 1) // 2, DEPTH // 2

    def nrm(k, shape, scale):
        return jax.random.normal(k, shape, f32) * scale

    return {
        'x': nrm(ks[0], (BATCH, SEQ, D_MODEL), 1.0),
        'rel_bias': nrm(ks[1], (REL_BUCKETS, A_HEADS), 0.5),
        'hgrn_lb_logits': nrm(ks[2], (DEPTH + 1, B_KW), 0.5),
        'a_w_in': nrm(ks[3], (n_even, D_MODEL, IN0_WIDTH), D_MODEL ** -0.5),
        'a_gn_g': 1.0 + nrm(ks[4], (n_even, B_VW), 0.02),
        'a_w_out': nrm(ks[5], (n_even, A_WIDTH + B_VW, D_MODEL), (A_WIDTH + B_VW) ** -0.5 * DN_BETA),
        'c_w_in': nrm(ks[6], (n_odd, D_MODEL, IN1_WIDTH), D_MODEL ** -0.5),
        'c_b_f': 1.0 + nrm(ks[7], (n_odd, C_HEADS), 0.1),
        'c_w_out': nrm(ks[8], (n_odd, C_WIDTH, D_MODEL), C_WIDTH ** -0.5 * DN_BETA),
        'ln_mix_g': 1.0 + nrm(ks[9], (DEPTH, D_MODEL), 0.02),
        'ln_mix_b': nrm(ks[10], (DEPTH, D_MODEL), 0.02),
        'ln_ffn_g': 1.0 + nrm(ks[11], (DEPTH, D_MODEL), 0.02),
        'ln_ffn_b': nrm(ks[12], (DEPTH, D_MODEL), 0.02),
        'router_w': nrm(ks[13], (DEPTH, D_MODEL, N_EXPERTS), D_MODEL ** -0.5),
        'router_bias': nrm(ks[14], (DEPTH, N_EXPERTS), 0.01),
        'exp_w_gate': nrm(ks[15], (DEPTH, N_EXPERTS, D_MODEL, EXPERT_DIM), D_MODEL ** -0.5),
        'exp_w_up': nrm(ks[16], (DEPTH, N_EXPERTS, D_MODEL, EXPERT_DIM), D_MODEL ** -0.5),
        'exp_w_down': nrm(ks[17], (DEPTH, N_EXPERTS, EXPERT_DIM, D_MODEL), EXPERT_DIM ** -0.5 * DN_BETA),
        'sh_w_gate': nrm(ks[18], (DEPTH, D_MODEL, SHARED_DIM), D_MODEL ** -0.5),
        'sh_w_up': nrm(ks[19], (DEPTH, D_MODEL, SHARED_DIM), D_MODEL ** -0.5),
        'sh_w_down': nrm(ks[20], (DEPTH, SHARED_DIM, D_MODEL), SHARED_DIM ** -0.5 * DN_BETA),
    }


def reference(x, rel_bias, hgrn_lb_logits, a_w_in, a_gn_g, a_w_out, c_w_in, c_b_f, c_w_out,
              ln_mix_g, ln_mix_b, ln_ffn_g, ln_ffn_b, router_w, router_bias,
              exp_w_gate, exp_w_up, exp_w_down, sh_w_gate, sh_w_up, sh_w_down):
    lb_all = jnp.cumsum(jax.nn.softmax(hgrn_lb_logits.astype(jnp.float32), axis=0), axis=0)
    for layer in range(DEPTH):
        j = layer // 2
        if layer % 2 == 0:
            mix = _even_mixer(x, a_w_in[j], a_gn_g[j], a_w_out[j], rel_bias, lb_all[layer])
        else:
            mix = _odd_mixer(x, c_w_in[j], c_b_f[j], c_w_out[j])
        x = _layer_norm(DN_ALPHA * x + mix, ln_mix_g[layer], ln_mix_b[layer])
        ffn = _moe(x, router_w[layer], router_bias[layer], exp_w_gate[layer], exp_w_up[layer],
                   exp_w_down[layer], sh_w_gate[layer], sh_w_up[layer], sh_w_down[layer])
        x = _layer_norm(DN_ALPHA * x + ffn, ln_ffn_g[layer], ln_ffn_b[layer])
    return x
```

```cpp
#include <hip/hip_runtime.h>
#include <cstdio>
#include <cstdint>

#define LAS __attribute__((address_space(3)))
#define GAS __attribute__((address_space(1)))
typedef unsigned short bf16_t;
typedef short bf16x8 __attribute__((ext_vector_type(8)));
typedef short s16x4 __attribute__((ext_vector_type(4)));
typedef float f32x4 __attribute__((ext_vector_type(4)));
typedef float f32x2 __attribute__((ext_vector_type(2)));
typedef unsigned u32x4 __attribute__((ext_vector_type(4)));
typedef unsigned u32x2 __attribute__((ext_vector_type(2)));

constexpr int D = 2048, NTOK = 16384, SEQ = 4096, NBATCH = 4;
constexpr int IN0W = 7168, IN1W = 6144, IN1FULL = 6160;
constexpr int NE = 64, NEX = 65  , EDIM = 512, LISTCAP = 16384;
constexpr float LN_EPS = 1e-5f, RMS_EPS = 1e-6f;
constexpr float DN_ALPHA = 1.4142135623730951f;
constexpr float ATT_SCALE = 0.08838834764831845f;
constexpr int NWAVES = 8, NTHREADS = 512;

constexpr size_t MiB = 1u << 20;
constexpr size_t WS_CTL = 0, CTL_ZERO_BYTES = 1 * MiB;
constexpr size_t WS_LB = 1 * MiB;
constexpr size_t WS_BIASREL = 1 * MiB + 16384;
constexpr size_t WS_FGHI = 1 * MiB + 65536;
constexpr size_t WS_FGLO = 1 * MiB + 131072;
constexpr size_t WS_RT = 2 * MiB;
constexpr size_t WS_WTS = 3 * MiB;
constexpr size_t WS_FLOG = 4 * MiB;
constexpr size_t WS_CC = 5 * MiB;
constexpr size_t WS_LSE = 6 * MiB;
constexpr size_t WS_ALAST = 8 * MiB;
constexpr size_t WS_LISTS = 9 * MiB;
constexpr size_t WS_WIN0 = 16 * MiB, WS_WOUT0 = 44 * MiB, WS_WIN1 = 52 * MiB, WS_WOUT1 = 76 * MiB;
constexpr size_t WS_WGU = 84 * MiB;
constexpr size_t WS_WD = 344 * MiB;
constexpr size_t WS_XA = 474 * MiB;
constexpr size_t WS_X1B = 538 * MiB;
constexpr size_t WS_A2 = 602 * MiB;
constexpr size_t WS_YF = 666 * MiB;
constexpr size_t WS_X1F = 794 * MiB;
constexpr size_t WS_X2F = 922 * MiB;
constexpr size_t WS_H = 1050 * MiB;
constexpr size_t WS_Y = 1210 * MiB;
constexpr size_t WS_PROJ = 1210 * MiB;
constexpr size_t WS_LT = 1434 * MiB;
constexpr size_t WS_ST = 1562 * MiB;
constexpr size_t WS_OBR = 1626 * MiB;
constexpr size_t WS_END = 1786 * MiB;
constexpr int CW_BAR = 4096;
constexpr int CW_CNT = 16384;

__device__ __forceinline__ unsigned cvt_pk_bf16(float lo, float hi) { unsigned r; asm volatile("v_cvt_pk_bf16_f32 %0, %1, %2" : "=v"(r) : "v"(lo), "v"(hi)); return r; }
__device__ __forceinline__ float bf_lo(unsigned w) { return __uint_as_float(w << 16); }
__device__ __forceinline__ float bf_hi(unsigned w) { return __uint_as_float(w & 0xffff0000u); }
__device__ __forceinline__ float bf2f(bf16_t b) { return __uint_as_float(((unsigned)b) << 16); }
__device__ __forceinline__ float sigmoidf_(float x) { return 1.0f / (1.0f + __expf(-x)); }
__device__ __forceinline__ float siluf_(float x) { return x / (1.0f + __expf(-x)); }
__device__ __forceinline__ float wave_sum(float v) {
#pragma unroll
    for (int o = 1; o < 64; o <<= 1) v += __shfl_xor(v, o);
    return v;
}
#define MFMA16(a, b, c) __builtin_amdgcn_mfma_f32_16x16x32_bf16((a), (b), (c), 0, 0, 0)
#define LDS_WAIT() asm volatile("s_waitcnt lgkmcnt(0)" ::: "memory")
#define VM_WAIT() asm volatile("s_waitcnt vmcnt(0)" ::: "memory")
__device__ __forceinline__ unsigned off_b(unsigned row, unsigned ch) { return 256u * row + 16u * (ch ^ (((row & 3u) << 2) | ((row >> 2) & 3u))); }
__device__ __forceinline__ s16x4 tr_read(unsigned addr) { s16x4 r; asm volatile("ds_read_b64_tr_b16 %0, %1" : "=v"(r) : "v"(addr) : "memory"); return r; }
__device__ __forceinline__ bf16x8 cat8(s16x4 a, s16x4 b) { return __builtin_shufflevector(a, b, 0, 1, 2, 3, 4, 5, 6, 7); }

#define XB_TMO      128
#define XB_XCNT(j)  (256  + 64 * (j))
#define XB_XSUB(j)  (1280 + 64 * (j))
#define XB_XGEN(j)  (2304 + 64 * (j))
#define XB_TOP      3328
#define XB_TOPGEN   3392
#define XCD_BAR_WORDS 3456
#define XB_SPIN_CAP (1u << 22)
__device__ __forceinline__ unsigned xb_ld(unsigned* p)              { return __hip_atomic_load(p, __ATOMIC_RELAXED, __HIP_MEMORY_SCOPE_AGENT); }
__device__ __forceinline__ unsigned xb_add(unsigned* p, unsigned v) { return __hip_atomic_fetch_add(p, v, __ATOMIC_RELAXED, __HIP_MEMORY_SCOPE_AGENT); }
__device__ __forceinline__ unsigned xb_xcc_id() { return (unsigned)__builtin_amdgcn_s_getreg((3 << 11) | 20) & 0xFu; }
#define XB_SPIN(cond, bar) do { unsigned _sp = 0; while (cond) { __builtin_amdgcn_s_sleep(1); \
    if ((++_sp & 255u) == 0u) { if (xb_ld(&(bar)[XB_TMO])) break; if (_sp > XB_SPIN_CAP) { atomicAdd(&(bar)[XB_TMO], 1u); break; } } } } while (0)
struct XcdBarrier { unsigned* bar; unsigned x; volatile LAS unsigned* st; };
__device__ __forceinline__ XcdBarrier xcd_barrier_post(unsigned* bar, volatile LAS unsigned* st) {
    XcdBarrier b; b.bar = bar; b.x = xb_xcc_id(); b.st = st;
    if (threadIdx.x == 0) (void)xb_add(&bar[XB_XCNT(b.x)], 1u);
    return b;
}
__device__ __forceinline__ void xcd_barrier_complete(unsigned* bar, unsigned x, unsigned& nloc, unsigned& nx) {
    const unsigned G = gridDim.x * gridDim.y * gridDim.z;
    unsigned sum, cnt, mine, sp = 0u;
    for (;;) {
        sum = 0u; cnt = 0u; mine = 0u;
#pragma unroll
        for (unsigned j = 0; j < 16; ++j) { const unsigned c = xb_ld(&bar[XB_XCNT(j)]); sum += c; cnt += (c > 0u) ? 1u : 0u; mine = (j == x) ? c : mine; }
        if (sum == G) break;
        __builtin_amdgcn_s_sleep(1);
        if ((++sp & 255u) == 0u) { if (xb_ld(&bar[XB_TMO])) break; if (sp > XB_SPIN_CAP) { atomicAdd(&bar[XB_TMO], 1u); break; } }
    }
    nloc = mine > 0u ? mine : 1u; nx = cnt > 0u ? cnt : 1u;
}
__device__ __forceinline__ void xcd_barrier(const XcdBarrier& b) {
    asm volatile("s_waitcnt vmcnt(0)" ::: "memory");
    __syncthreads();
    if (threadIdx.x == 0) {
        unsigned* bar = b.bar;
        __builtin_amdgcn_s_waitcnt(0);
        unsigned nloc = b.st[0], nx = b.st[1];
        if (nloc == 0u) { xcd_barrier_complete(bar, b.x, nloc, nx); b.st[0] = nloc; b.st[1] = nx; }
        const unsigned old = xb_add(&bar[XB_XSUB(b.x)], 1u);
        const unsigned gen = old / nloc;
        if (old + 1u == (gen + 1u) * nloc) {
            __builtin_amdgcn_fence(__ATOMIC_RELEASE, "agent");
            asm volatile("s_waitcnt vmcnt(0)" ::: "memory");
            const unsigned og = xb_add(&bar[XB_TOP], 1u);
            const unsigned tg = og / nx;
            if (og + 1u == (tg + 1u) * nx) xb_add(&bar[XB_TOPGEN], 1u);
            else XB_SPIN(xb_ld(&bar[XB_TOPGEN]) == tg, bar);
            __builtin_amdgcn_fence(__ATOMIC_ACQUIRE, "agent");
            xb_add(&bar[XB_XGEN(b.x)], 1u);
            asm volatile("s_waitcnt vmcnt(0)" ::: "memory");
        } else {
            XB_SPIN(xb_ld(&bar[XB_XGEN(b.x)]) == gen, bar);
            __builtin_amdgcn_fence(__ATOMIC_ACQUIRE, "agent");
            asm volatile("s_waitcnt vmcnt(0)" ::: "memory");
        }
    }
    __syncthreads();
}
namespace pg8 {
constexpr int BM = 256, BK = 64, HALF = 128, HTB = HALF * BK * 2, STAGE_BYTES = 8 * HTB, NXCD = 8, WGM = 8;
__host__ __device__ __forceinline__ int lds_byte(int r, int c) { const int st = (r >> 4) * 2 + (c >> 5), rr = r & 15, cc = c & 31, ob = rr * 64 + cc * 2; return st * 1024 + (ob ^ (((ob >> 9) & 1) << 5)); }
__host__ __device__ __forceinline__ void stage_rc(int b, int& R, int& C) { const int st = b / 1024, sb = b % 1024, swz = sb ^ (((sb >> 9) & 1) << 5); R = (st >> 1) * 16 + swz / 64; C = (st & 1) * 32 + (swz % 64) / 2; }
__host__ __device__ __forceinline__ int perm32(int rho) { const int n = rho >> 4, i = rho & 15; return 8 * (i >> 2) + 4 * n + (i & 3); }

struct Unit { int pm, pn, e, nrows, lbase; };

__device__ __forceinline__ bool enum_unit(int i, int nM, int nN, int G, int c, int& pm, int& pn) {
    const int nwg = nM * nN; const long L = (long)i * G + c; if (L >= nwg) return false;
    int wgid = (int)L; { const int q = nwg / NXCD, r = nwg % NXCD, xcd = wgid % NXCD, off = wgid / NXCD; wgid = (xcd < r ? xcd * (q + 1) : r * (q + 1) + (xcd - r) * q) + off; }
    const int nig = WGM * nN, gid = wgid / nig, fm = gid * WGM, gsz = (nM - fm) < WGM ? (nM - fm) : WGM;
    pm = fm + ((wgid % nig) % gsz); pn = (wgid % nig) / gsz; return true;
}

struct ProbPlain {
    const char* A; const char* Bt; int K, nM, nN, G, c;
    __device__ __forceinline__ bool next(int i, Unit& u) const { u.e = 0; u.nrows = 256; u.lbase = 0; return enum_unit(i, nM, nN, G, c, u.pm, u.pn); }
    __device__ __forceinline__ const char* a_base() const { return A; }
    __device__ __forceinline__ unsigned a_rowoff(const Unit& u, int r) const { return (unsigned)(u.pm * BM + r) * (unsigned)(K * 2); }
    __device__ __forceinline__ const char* b_base(const Unit& u) const { return Bt + (size_t)u.pn * BM * K * 2; }
};
struct ProbMoE {
    const char* A; const char* Bt; int K, nM, nN, G, c; const int* list; const LAS int* tt; const LAS int* cnts; int gather;
    __device__ __forceinline__ bool next(int i, Unit& u) const {
        if (!enum_unit(i, nM, nN, G, c, u.pm, u.pn)) return false;
        const int e = tt[2 * u.pm], ti = tt[2 * u.pm + 1]; u.e = e; const int rem = cnts[e] - ti * BM; u.nrows = rem < BM ? rem : BM; u.lbase = e * LISTCAP + ti * BM; return true;
    }
    __device__ __forceinline__ const char* a_base() const { return A; }
    __device__ __forceinline__ unsigned a_rowoff(const Unit& u, int r) const {
        if (gather) { const int rr = r < u.nrows ? r : u.nrows - 1; const int v = list[u.lbase + rr]; return (unsigned)(v >> 4) * (unsigned)(K * 2); }
        return (unsigned)(u.pm * BM + r) * (unsigned)(K * 2);
    }
    __device__ __forceinline__ const char* b_base(const Unit& u) const { return Bt + ((size_t)u.e * nN + u.pn) * BM * K * 2; }
};

struct EpiBf16 {
    static constexpr bool PERM = true;
    bf16_t* O; int ldc;
    __device__ __forceinline__ void operator()(const f32x4 (&acc)[2][2][4][2], const Unit& u, int wr, int wc, int fr, int fq) const {
        const int row0 = u.pm * BM + wr * 64 + fr, col0 = u.pn * BM + wc * 32 + 8 * fq;
#pragma unroll
        for (int ai = 0; ai < 2; ++ai)
#pragma unroll
            for (int m = 0; m < 4; ++m) { bf16_t* rowp = O + (size_t)(row0 + ai * HALF + m * 16) * ldc + col0;
#pragma unroll
                for (int bj = 0; bj < 2; ++bj) { const f32x4 v0 = acc[ai][bj][m][0], v1 = acc[ai][bj][m][1];
                    u32x4 w; w.x = cvt_pk_bf16(v0[0], v0[1]); w.y = cvt_pk_bf16(v0[2], v0[3]); w.z = cvt_pk_bf16(v1[0], v1[1]); w.w = cvt_pk_bf16(v1[2], v1[3]);
                    *(u32x4*)(rowp + bj * HALF) = w; } }
    }
};
struct EpiResF32 {
    static constexpr bool PERM = false;
    const float* res; float* out; int ldc; float alpha;
    __device__ __forceinline__ void operator()(const f32x4 (&acc)[2][2][4][2], const Unit& u, int wr, int wc, int fr, int fq) const {
        const int row0 = u.pm * BM + wr * 64 + fr, col0 = u.pn * BM + wc * 32 + 4 * fq;
#pragma unroll
        for (int ai = 0; ai < 2; ++ai)
#pragma unroll
            for (int m = 0; m < 4; ++m) { const size_t off = (size_t)(row0 + ai * HALF + m * 16) * ldc + col0;
#pragma unroll
                for (int bj = 0; bj < 2; ++bj)
#pragma unroll
                    for (int n = 0; n < 2; ++n) { const f32x4 r = *(const f32x4*)(res + off + bj * HALF + n * 16); *(f32x4*)(out + off + bj * HALF + n * 16) = r * alpha + acc[ai][bj][m][n]; }
                asm volatile("" ::: "memory"); }
    }
};
struct EpiSwiGLU {
    static constexpr bool PERM = true;
    bf16_t* H;
    __device__ __forceinline__ void operator()(const f32x4 (&acc)[2][2][4][2], const Unit& u, int wr, int wc, int fr, int fq) const {
        const int row0 = u.pm * BM + wr * 64 + fr, col0 = u.pn * HALF + wc * 32 + 8 * fq;
#pragma unroll
        for (int ai = 0; ai < 2; ++ai)
#pragma unroll
            for (int m = 0; m < 4; ++m) { bf16_t* rowp = H + (size_t)(row0 + ai * HALF + m * 16) * EDIM + col0;
                float h[8];
#pragma unroll
                for (int n = 0; n < 2; ++n)
#pragma unroll
                    for (int j = 0; j < 4; ++j) { const float g = acc[ai][0][m][n][j], up = acc[ai][1][m][n][j]; h[n * 4 + j] = g / (1.0f + __expf(-g)) * up; }
                u32x4 w; w.x = cvt_pk_bf16(h[0], h[1]); w.y = cvt_pk_bf16(h[2], h[3]); w.z = cvt_pk_bf16(h[4], h[5]); w.w = cvt_pk_bf16(h[6], h[7]);
                *(u32x4*)rowp = w; }
    }
};
struct EpiDown {
    static constexpr bool PERM = true;
    bf16_t* Y; const int* list; const float* wts;
    __device__ __forceinline__ void operator()(const f32x4 (&acc)[2][2][4][2], const Unit& u, int wr, int wc, int fr, int fq) const {
        const int col0 = u.pn * BM + wc * 32 + 8 * fq;
#pragma unroll
        for (int ai = 0; ai < 2; ++ai)
#pragma unroll
            for (int m = 0; m < 4; ++m) { const int r = ai * HALF + wr * 64 + m * 16 + fr; const bool ok = r < u.nrows; const int rr = ok ? r : u.nrows - 1;
                const int v = list[u.lbase + rr]; const int tok = v >> 4, slot = v & 15; const float wq = wts[tok * 8 + (slot & 7)]; const float w = slot == 8 ? 1.0f : wq;
                bf16_t* rowp = Y + (size_t)(tok * 9 + slot) * D + col0;
#pragma unroll
                for (int bj = 0; bj < 2; ++bj) { const f32x4 v0 = acc[ai][bj][m][0] * w, v1 = acc[ai][bj][m][1] * w;
                    u32x4 o; o.x = cvt_pk_bf16(v0[0], v0[1]); o.y = cvt_pk_bf16(v0[2], v0[3]); o.z = cvt_pk_bf16(v1[0], v1[1]); o.w = cvt_pk_bf16(v1[2], v1[3]);
                    if (ok) *(u32x4*)(rowp + bj * HALF) = o; } }
    }
};

template <class Prob, class Epi>
__device__ __forceinline__ void gemm_phase(LAS unsigned char* lds, const Prob& P, const Epi& E) {
    const int tid = threadIdx.x, wid = __builtin_amdgcn_readfirstlane(tid >> 6), lane = tid & 63, wr = wid >> 2, wc = wid & 3, fr = lane & 15, fq = lane >> 4;
    const int K = P.K, nt = K / BK;
    int Rst[2]; unsigned Cst2[2], voffB[2];
#pragma unroll
    for (int i = 0; i < 2; ++i) { int R, C; stage_rc(tid * 16 + i * 8192, R, C); const int Rb = Epi::PERM ? ((R & ~31) + perm32(R & 31)) : R;
        Rst[i] = R; Cst2[i] = (unsigned)C * 2u; voffB[i] = (unsigned)(Rb * K + C) * 2u; }
    const size_t kstep = (size_t)(BK * 2);
    const size_t hstep = (size_t)HALF * K * 2;
    const unsigned ldsw = (unsigned)wid * 1024u;
    const int aoff = lds_byte(wr * 64 + fr, fq * 8), boff = lds_byte(wc * 32 + fr, fq * 8);
#define PG8_SA(b, h) (((b) * 2 + (h)) * HTB)
#define PG8_SB(b, h) ((4 + (b) * 2 + (h)) * HTB)
#define PG8_STAGE(bufoff, gbase, voff) do { _Pragma("unroll") for (int _i = 0; _i < 2; ++_i) \
        __builtin_amdgcn_global_load_lds((const unsigned*)((const char*)(gbase) + (voff)[_i]), (LAS unsigned*)(lds + (bufoff) + ldsw + _i * 8192), 16, 0, 0); } while (0)
#define PG8_LDA(dst, b, h) do { _Pragma("unroll") for (int m = 0; m < 4; ++m) _Pragma("unroll") for (int k = 0; k < 2; ++k) dst[m][k] = *(const LAS bf16x8*)(lds + PG8_SA(b, h) + aoff + m * 2048 + k * 1024); } while (0)
#define PG8_LDB(dst, b, h) do { _Pragma("unroll") for (int n = 0; n < 2; ++n) _Pragma("unroll") for (int k = 0; k < 2; ++k) dst[n][k] = *(const LAS bf16x8*)(lds + PG8_SB(b, h) + boff + n * 2048 + k * 1024); } while (0)
#define PG8_MMA(ai, bj, At, Bt) do { __builtin_amdgcn_s_setprio(1); _Pragma("unroll") for (int m = 0; m < 4; ++m) _Pragma("unroll") for (int n = 0; n < 2; ++n) _Pragma("unroll") for (int k = 0; k < 2; ++k) \
        acc[ai][bj][m][n] = __builtin_amdgcn_mfma_f32_16x16x32_bf16(Bt[n][k], At[m][k], acc[ai][bj][m][n], 0, 0, 0); __builtin_amdgcn_s_setprio(0); } while (0)
#define PG8_WAIT_V(n) asm volatile("s_waitcnt vmcnt(" #n ")" ::: "memory")
#define PG8_WAIT_L(n) asm volatile("s_waitcnt lgkmcnt(" #n ")" ::: "memory")
#define PG8_BAR __builtin_amdgcn_s_barrier()
#define PG8_SCHED __builtin_amdgcn_sched_barrier(0)
    Unit cur, nxt; int ui = 0;
    if (!P.next(0, cur)) return;
    f32x4 acc[2][2][4][2];
#pragma unroll
    for (int a = 0; a < 2; ++a)
#pragma unroll
        for (int b = 0; b < 2; ++b)
#pragma unroll
            for (int m = 0; m < 4; ++m)
#pragma unroll
                for (int n = 0; n < 2; ++n) acc[a][b][m][n] = (f32x4){0.f, 0.f, 0.f, 0.f};
    bf16x8 At[4][2], B0[2][2], B1[2][2];
    const char* aB = P.a_base();
    unsigned voAc[2][2], voAn[2][2];
#pragma unroll
    for (int h = 0; h < 2; ++h)
#pragma unroll
        for (int i = 0; i < 2; ++i) voAc[h][i] = P.a_rowoff(cur, h * HALF + Rst[i]) + Cst2[i];
    const char* cB = P.b_base(cur);
    PG8_STAGE(PG8_SB(0, 0), cB, voffB); PG8_STAGE(PG8_SB(0, 1), cB + hstep, voffB); PG8_STAGE(PG8_SA(0, 0), aB, voAc[0]); PG8_STAGE(PG8_SA(0, 1), aB, voAc[1]);
    if (wr == 1) PG8_BAR;
    PG8_WAIT_V(2); PG8_BAR;
    PG8_STAGE(PG8_SB(1, 0), cB + kstep, voffB); PG8_STAGE(PG8_SA(1, 0), aB + kstep, voAc[0]); PG8_STAGE(PG8_SB(1, 1), cB + hstep + kstep, voffB);
    PG8_WAIT_V(6); PG8_BAR;
    for (;;) {
        const bool has_next = P.next(ui + 1, nxt);
        const char* nB = cB;
#pragma unroll
        for (int h = 0; h < 2; ++h)
#pragma unroll
            for (int i = 0; i < 2; ++i) voAn[h][i] = voAc[h][i];
        if (has_next) { nB = P.b_base(nxt);
#pragma unroll
            for (int h = 0; h < 2; ++h)
#pragma unroll
                for (int i = 0; i < 2; ++i) voAn[h][i] = P.a_rowoff(nxt, h * HALF + Rst[i]) + Cst2[i]; }
        for (int t = 0; t < nt; t += 2) {
            const bool last = (t == nt - 2);
            const char* a1 = aB + (size_t)(t + 1) * kstep;
            const char* a2 = last ? aB : aB + (size_t)(t + 2) * kstep; const char* b2 = last ? nB : cB + (size_t)(t + 2) * kstep;
            const char* a3 = a2 + kstep; const char* b3 = b2 + kstep;
            unsigned vo2[2][2];
#pragma unroll
            for (int h = 0; h < 2; ++h)
#pragma unroll
                for (int i = 0; i < 2; ++i) vo2[h][i] = last ? voAn[h][i] : voAc[h][i];
            PG8_LDB(B0, 0, 0); PG8_LDB(B1, 0, 1); PG8_SCHED; PG8_LDA(At, 0, 0); PG8_STAGE(PG8_SA(1, 1), a1, voAc[1]);
            PG8_WAIT_V(8); PG8_WAIT_L(0); PG8_BAR; PG8_MMA(0, 0, At, B0); PG8_MMA(0, 1, At, B1); PG8_BAR; PG8_SCHED;
            PG8_LDA(At, 0, 1); PG8_STAGE(PG8_SB(0, 0), b2, voffB); PG8_STAGE(PG8_SB(0, 1), b2 + hstep, voffB); PG8_STAGE(PG8_SA(0, 0), a2, vo2[0]);
            PG8_WAIT_V(8); PG8_WAIT_L(0); PG8_BAR; PG8_MMA(1, 0, At, B0); PG8_MMA(1, 1, At, B1); PG8_BAR; PG8_SCHED;
            PG8_LDB(B0, 1, 0); PG8_LDB(B1, 1, 1); PG8_SCHED; PG8_LDA(At, 1, 0); PG8_STAGE(PG8_SA(0, 1), a2, vo2[1]);
            PG8_WAIT_V(8); PG8_WAIT_L(0); PG8_BAR; PG8_MMA(0, 0, At, B0); PG8_MMA(0, 1, At, B1); PG8_BAR; PG8_SCHED;
            PG8_LDA(At, 1, 1); PG8_STAGE(PG8_SB(1, 0), b3, voffB); PG8_STAGE(PG8_SB(1, 1), b3 + hstep, voffB); PG8_STAGE(PG8_SA(1, 0), a3, vo2[0]);
            PG8_WAIT_V(8); PG8_WAIT_L(0); PG8_BAR; PG8_MMA(1, 0, At, B0); PG8_MMA(1, 1, At, B1); PG8_BAR; PG8_SCHED;
        }
        if (wr == 0) PG8_BAR;
        E(acc, cur, wr, wc, fr, fq);
        if (!has_next) break;
#pragma unroll
        for (int a = 0; a < 2; ++a)
#pragma unroll
            for (int b = 0; b < 2; ++b)
#pragma unroll
                for (int m = 0; m < 4; ++m)
#pragma unroll
                    for (int n = 0; n < 2; ++n) acc[a][b][m][n] = (f32x4){0.f, 0.f, 0.f, 0.f};
        cur = nxt; cB = nB; ++ui;
#pragma unroll
        for (int h = 0; h < 2; ++h)
#pragma unroll
            for (int i = 0; i < 2; ++i) voAc[h][i] = voAn[h][i];
        if (wr == 1) PG8_BAR;
    }
    PG8_WAIT_V(0);
    PG8_BAR;
#undef PG8_SA
#undef PG8_SB
#undef PG8_STAGE
#undef PG8_LDA
#undef PG8_LDB
#undef PG8_MMA
#undef PG8_WAIT_V
#undef PG8_WAIT_L
#undef PG8_BAR
#undef PG8_SCHED
}
}
constexpr int LDS_BYTES = 147456;
constexpr int LDS_MISC = 143360;
constexpr int LDS_TT = 131072;
struct Frame {
    LAS unsigned char* lds; int tid, lane, wave, G, bid;
    const float* const* in; float* out; unsigned char* ws;
};

__device__ __forceinline__ void p0_transpose_item(const float* W, int ldw, int K, int k0, int n0, bf16_t* WT, int dest_row0, LAS float* scr, int lane) {
#pragma unroll 8
    for (int i = 0; i < 32; ++i) { const int kk = 2 * i + (lane >> 5); scr[kk * 33 + (lane & 31)] = W[(size_t)(k0 + kk) * ldw + n0 + (lane & 31)]; }
    LDS_WAIT(); asm volatile("" ::: "memory");
    const int c = lane & 7;
#pragma unroll
    for (int j = 0; j < 4; ++j) { const int n = (lane >> 3) + 8 * j; const LAS float* s = scr + (8 * c) * 33 + n;
        u32x4 o; o.x = cvt_pk_bf16(s[0 * 33], s[1 * 33]); o.y = cvt_pk_bf16(s[2 * 33], s[3 * 33]); o.z = cvt_pk_bf16(s[4 * 33], s[5 * 33]); o.w = cvt_pk_bf16(s[6 * 33], s[7 * 33]);
        *(u32x4*)(WT + (size_t)(dest_row0 + n) * K + k0 + 8 * c) = o; }
    LDS_WAIT(); asm volatile("" ::: "memory");
}
__device__ __forceinline__ void p0_matrix_item(const float* W, int ldw, int K, int N, bf16_t* WT, int item, LAS float* scr, int lane) {
    const int nblk = N / 32, kb = item / nblk, nb = item % nblk;
    p0_transpose_item(W, ldw, K, 64 * kb, 32 * nb, WT, 32 * nb, scr, lane);
}
__device__ __forceinline__ void p0_expert_item(const Frame& F, int layer, int item, LAS float* scr, int lane) {
    const int e = item / 1536, r = item % 1536, which = r / 512, it = r % 512;
    bf16_t* WGU = (bf16_t*)(F.ws + WS_WGU) + (size_t)e * 1024 * D; bf16_t* WDt = (bf16_t*)(F.ws + WS_WD) + (size_t)e * D * EDIM;
    if (which < 2) {
        const float* W = e < NE ? F.in[15 + which] + ((size_t)layer * NE + e) * D * EDIM : F.in[18 + which] + (size_t)layer * D * EDIM;
        const int kb = it / 16, nb = it % 16, n0 = 32 * nb;
        const int dest = (n0 >> 7) * 256 + which * 128 + (n0 & 127);
        p0_transpose_item(W, EDIM, D, 64 * kb, n0, WGU, dest, scr, lane);
    } else {
        const float* W = e < NE ? F.in[17] + ((size_t)layer * NE + e) * EDIM * D : F.in[20] + (size_t)layer * EDIM * D;
        const int kb = it / 64, nb = it % 64;
        p0_transpose_item(W, D, EDIM, 64 * kb, 32 * nb, WDt, 32 * nb, scr, lane);
    }
}
__device__ __forceinline__ int t5_bucket(int dist) {
    if (dist < 16) return dist;
    const double v = log((double)dist / 16.0) / log(2048.0 / 16.0) * 16.0;
    int b = 16 + (int)v; return b > 31 ? 31 : b;
}
__device__ __forceinline__ void phase_prologue(const Frame& F) {
    LAS float* scr = (LAS float*)(F.lds + F.wave * 16384);
    const int gw = F.bid * NWAVES + F.wave, NGW = F.G * NWAVES, lane = F.lane;
    constexpr int I0 = (D / 64) * (IN0W / 32), I1 = (D / 64) * (D / 32), I2 = (D / 64) * (IN1W / 32), I3 = I1, I4 = NEX * 1536;
    for (int it = gw; it < I0 + I1 + I2 + I3 + I4; it += NGW) {
        int r = it;
        if (r < I0) { p0_matrix_item(F.in[3], IN0W, D, IN0W, (bf16_t*)(F.ws + WS_WIN0), r, scr, lane); continue; } r -= I0;
        if (r < I1) { p0_matrix_item(F.in[5], D, D, D, (bf16_t*)(F.ws + WS_WOUT0), r, scr, lane); continue; } r -= I1;
        if (r < I2) { p0_matrix_item(F.in[6], IN1FULL, D, IN1W, (bf16_t*)(F.ws + WS_WIN1), r, scr, lane); continue; } r -= I2;
        if (r < I3) { p0_matrix_item(F.in[8], D, D, D, (bf16_t*)(F.ws + WS_WOUT1), r, scr, lane); continue; } r -= I3;
        p0_expert_item(F, 0, r, scr, lane);
    }
    { const size_t gt = (size_t)F.bid * NTHREADS + F.tid, GT = (size_t)F.G * NTHREADS; const float* x = F.in[0]; bf16_t* xa = (bf16_t*)(F.ws + WS_XA);
      for (size_t i = gt; i < (size_t)NTOK * D / 8; i += GT) { const f32x4 a = *(const f32x4*)(x + i * 8), b = *(const f32x4*)(x + i * 8 + 4);
          u32x4 w; w.x = cvt_pk_bf16(a[0], a[1]); w.y = cvt_pk_bf16(a[2], a[3]); w.z = cvt_pk_bf16(b[0], b[1]); w.w = cvt_pk_bf16(b[2], b[3]); *(u32x4*)(xa + i * 8) = w; } }
    { const int gt = F.bid * NTHREADS + F.tid, GT = F.G * NTHREADS;
      bf16_t* rt = (bf16_t*)(F.ws + WS_RT);
      for (int i = gt; i < 2 * 64 * D; i += GT) { const int layer = i / (64 * D), e = (i / D) % 64, k = i % D; const float w = F.in[13][((size_t)layer * D + k) * 64 + e];
          const unsigned hi = cvt_pk_bf16(w, 0.f) & 0xffffu; const float lo = w - __uint_as_float(hi << 16);
          rt[((size_t)(layer * 2 + 0) * 64 + e) * D + k] = (bf16_t)hi; rt[((size_t)(layer * 2 + 1) * 64 + e) * D + k] = (bf16_t)(cvt_pk_bf16(lo, 0.f) & 0xffffu); }
      bf16_t* fh = (bf16_t*)(F.ws + WS_FGHI); bf16_t* fl = (bf16_t*)(F.ws + WS_FGLO);
      for (int i = gt; i < 16 * D; i += GT) { const int j = i / D, k = i % D; const float w = F.in[6][(size_t)k * IN1FULL + IN1W + j];
          const unsigned hi = cvt_pk_bf16(w, 0.f) & 0xffffu; const float lo = w - __uint_as_float(hi << 16);
          fh[(size_t)j * D + k] = (bf16_t)hi; fl[(size_t)j * D + k] = (bf16_t)(cvt_pk_bf16(lo, 0.f) & 0xffffu); }
      float* lb = (float*)(F.ws + WS_LB);
      for (int i = gt; i < 1024; i += GT) { const float a = F.in[2][i], b = F.in[2][1024 + i], c = F.in[2][2048 + i]; const float m = fmaxf(a, fmaxf(b, c));
          const float ea = expf(a - m), eb = expf(b - m), ec = expf(c - m); lb[i] = ea / (ea + eb + ec); }
      float* br = (float*)(F.ws + WS_BIASREL);
      for (int i = gt; i < 3 * 8 * 132; i += GT) { const int b3 = i / (8 * 132), h = (i / 132) % 8, rel = i % 132; const int dil = b3 == 0 ? 1 : (b3 == 1 ? 4 : 16);
          br[i] = rel <= 128 ? F.in[1][t5_bucket(rel * dil) * 8 + h] : 0.f; } }
}
__device__ __forceinline__ void phase_convert_l1(const Frame& F) {
    LAS float* scr = (LAS float*)(F.lds + F.wave * 16384);
    const int gw = F.bid * NWAVES + F.wave, NGW = F.G * NWAVES, lane = F.lane;
    if (gw < 64) { const int b = gw >> 4, h = gw & 15; const float* fl = (const float*)(F.ws + WS_FLOG); float* cc = (float*)(F.ws + WS_CC) + (size_t)gw * SEQ; const float bf = F.in[7][h];
        float run = 0.f;
        for (int blk = 0; blk < SEQ / 64; ++blk) { const int t = blk * 64 + lane; const float z = fl[((size_t)b * SEQ + t) * 16 + h] + bf;
            float v = fminf(z, 0.f) - log1pf(__expf(-fabsf(z)));
#pragma unroll
            for (int o = 1; o < 64; o <<= 1) { const float u = __shfl_up(v, o); if (lane >= o) v += u; }
            cc[t] = run + v; run += __shfl(v, 63); } }
    for (int it = gw; it < NEX * 1536; it += NGW) p0_expert_item(F, 1, it, scr, lane);
}
struct RowArgs {
    const float* vin; const bf16_t* Y; const float* gam; const float* bet; float* xo; bf16_t* xob;
    const bf16_t* whi; const bf16_t* wlo; const float* rbias; unsigned* cnt; int* lists; float* wts; float* flog;
};
template <int MODE, int NT>
__device__ __forceinline__ void phase_rows(const Frame& F, const RowArgs& a) {
    const int lane = F.lane, wave = F.wave, fr = lane & 15, fq = lane >> 4;
    LAS float* xch = (LAS float*)(F.lds);
    LAS float* scb = (LAS float*)(F.lds + 16384);
    for (int base = F.bid * 4; base < NTOK / 16; base += F.G * 4) {
        for (int i = 0; i < 8; ++i) {
            const int tok = (base + (wave >> 1)) * 16 + (wave & 1) * 8 + i;
            f32x4 v[8];
            const f32x4* src = (const f32x4*)(a.vin + (size_t)tok * D) + lane;
#pragma unroll
            for (int j = 0; j < 8; ++j) v[j] = src[64 * j];
            if (MODE == 1) {
#pragma unroll
                for (int j = 0; j < 8; ++j) v[j] = v[j] * DN_ALPHA;
#pragma unroll
                for (int s = 0; s < 9; ++s) { const u32x2* ys = (const u32x2*)(a.Y + ((size_t)tok * 9 + s) * D) + lane;
#pragma unroll
                    for (int j = 0; j < 8; ++j) { const u32x2 w = ys[64 * j]; v[j][0] += bf_lo(w.x); v[j][1] += bf_hi(w.x); v[j][2] += bf_lo(w.y); v[j][3] += bf_hi(w.y); } }
            }
            float s1 = 0.f;
#pragma unroll
            for (int j = 0; j < 8; ++j) s1 += (v[j][0] + v[j][1]) + (v[j][2] + v[j][3]);
            const float mean = wave_sum(s1) * (1.0f / D); float s2 = 0.f;
#pragma unroll
            for (int j = 0; j < 8; ++j) { v[j] = v[j] - mean; s2 += (v[j][0] * v[j][0] + v[j][1] * v[j][1]) + (v[j][2] * v[j][2] + v[j][3] * v[j][3]); }
            const float rstd = 1.0f / sqrtf(wave_sum(s2) * (1.0f / D) + LN_EPS);
            f32x4* dst = (f32x4*)(a.xo + (size_t)tok * D) + lane; u32x2* dstb = (u32x2*)(a.xob + (size_t)tok * D) + lane;
#pragma unroll
            for (int j = 0; j < 8; ++j) { const f32x4 g = *((const f32x4*)a.gam + lane + 64 * j), b = *((const f32x4*)a.bet + lane + 64 * j);
                const f32x4 o = v[j] * rstd * g + b; dst[64 * j] = o; u32x2 w; w.x = cvt_pk_bf16(o[0], o[1]); w.y = cvt_pk_bf16(o[2], o[3]); dstb[64 * j] = w; }
        }
        if (NT == 0) continue;
        VM_WAIT(); __syncthreads();
        const int task = base + (wave & 3), kh = wave >> 2;
        f32x4 acc[NT > 0 ? NT : 1];
#pragma unroll
        for (int n = 0; n < NT; ++n) acc[n] = (f32x4){0.f, 0.f, 0.f, 0.f};
        const float* xr = a.xo + (size_t)(task * 16 + fr) * D + 8 * fq;
#pragma unroll 4
        for (int kb = kh * 32; kb < kh * 32 + 32; ++kb) {
            const f32x4 x0 = *(const f32x4*)(xr + 32 * kb), x1 = *(const f32x4*)(xr + 32 * kb + 4);
            u32x4 hi; hi.x = cvt_pk_bf16(x0[0], x0[1]); hi.y = cvt_pk_bf16(x0[2], x0[3]); hi.z = cvt_pk_bf16(x1[0], x1[1]); hi.w = cvt_pk_bf16(x1[2], x1[3]);
            u32x4 lo; lo.x = cvt_pk_bf16(x0[0] - bf_lo(hi.x), x0[1] - bf_hi(hi.x)); lo.y = cvt_pk_bf16(x0[2] - bf_lo(hi.y), x0[3] - bf_hi(hi.y));
            lo.z = cvt_pk_bf16(x1[0] - bf_lo(hi.z), x1[1] - bf_hi(hi.z)); lo.w = cvt_pk_bf16(x1[2] - bf_lo(hi.w), x1[3] - bf_hi(hi.w));
            const bf16x8 ah = __builtin_bit_cast(bf16x8, hi), al = __builtin_bit_cast(bf16x8, lo);
#pragma unroll
            for (int n = 0; n < NT; ++n) { const size_t wo = (size_t)(16 * n + fr) * D + 32 * kb + 8 * fq;
                const bf16x8 bh = *(const bf16x8*)(a.whi + wo), bl = *(const bf16x8*)(a.wlo + wo);
                acc[n] = MFMA16(ah, bh, acc[n]); acc[n] = MFMA16(al, bh, acc[n]); acc[n] = MFMA16(ah, bl, acc[n]); }
        }
        if (kh == 1) {
#pragma unroll
            for (int n = 0; n < NT; ++n) *(LAS f32x4*)(xch + (((wave & 3) * 4 + n) * 64 + lane) * 4) = acc[n];
        }
        __syncthreads();
        if (kh == 0) {
#pragma unroll
            for (int n = 0; n < NT; ++n) acc[n] = acc[n] + *(const LAS f32x4*)(xch + (((wave & 3) * 4 + n) * 64 + lane) * 4);
            if (NT == 1) {
#pragma unroll
                for (int r = 0; r < 4; ++r) a.flog[(size_t)(task * 16 + 4 * fq + r) * 16 + fr] = acc[0][r];
            } else {
                LAS float* sc = scb + (wave & 3) * (2 * 16 * 68); LAS float* sl = sc + 16 * 68;
#pragma unroll
                for (int n = 0; n < NT; ++n)
#pragma unroll
                    for (int r = 0; r < 4; ++r) { const int e = 16 * n + fr; const float s = 1.0f / (1.0f + expf(-acc[n][r])); sc[(4 * fq + r) * 68 + e] = s; sl[(4 * fq + r) * 68 + e] = s + a.rbias[e]; }
                LDS_WAIT(); asm volatile("" ::: "memory");
                if (lane < 16) {
                    const int tok = task * 16 + lane; const LAS float* ms = sc + lane * 68; LAS float* ml = sl + lane * 68;
                    float gs[8];
#pragma unroll
                    for (int g = 0; g < 8; ++g) { float m1 = -3e38f, m2 = -3e38f;
#pragma unroll
                        for (int j = 0; j < 8; ++j) { const float x = ml[8 * g + j]; if (x > m1) { m2 = m1; m1 = x; } else if (x > m2) m2 = x; }
                        gs[g] = m1 + m2; }
                    unsigned gmask = 0u;
#pragma unroll
                    for (int rnd = 0; rnd < 4; ++rnd) { float best = -3e38f; int bi = 0;
#pragma unroll
                        for (int g = 0; g < 8; ++g) { const bool ok = !((gmask >> g) & 1u) && gs[g] > best; best = ok ? gs[g] : best; bi = ok ? g : bi; }
                        gmask |= 1u << bi; }
                    int eid[8]; float ew[8]; float wsum = 0.f;
#pragma unroll
                    for (int rnd = 0; rnd < 8; ++rnd) { float best = -3e38f; int bi = 0;
#pragma unroll 1
                        for (int e = 0; e < 64; ++e) { const float x = ml[e]; const bool ok = ((gmask >> (e >> 3)) & 1u) && x > best; best = ok ? x : best; bi = ok ? e : bi; }
                        eid[rnd] = bi; ew[rnd] = ms[bi]; wsum += ms[bi]; ml[bi] = -3e38f; }
                    const float inv = 2.5f / wsum;
#pragma unroll
                    for (int j = 0; j < 8; ++j) { const unsigned pos = atomicAdd(a.cnt + 64 * eid[j], 1u); a.lists[(size_t)eid[j] * LISTCAP + pos] = tok * 16 + j; a.wts[tok * 8 + j] = ew[j] * inv; }
                    a.lists[(size_t)NE * LISTCAP + tok] = tok * 16 + 8;
                }
            }
        }
        __syncthreads();
    }
}
struct AttnState { float m, l; f32x4 o[8]; };
__device__ __forceinline__ void attn_init(AttnState& st) { st.m = -1e30f; st.l = 0.f;
#pragma unroll
    for (int c = 0; c < 8; ++c) st.o[c] = (f32x4){0.f, 0.f, 0.f, 0.f}; }
__device__ __forceinline__ void attn_scores(const LAS unsigned char* lds, unsigned kb, const bf16x8 (&qf)[4], f32x4 (&s)[4], int fr, int fq) {
#pragma unroll
    for (int kt = 0; kt < 4; ++kt) { s[kt] = (f32x4){0.f, 0.f, 0.f, 0.f};
#pragma unroll
        for (int ks = 0; ks < 4; ++ks) { const bf16x8 kf = *(const LAS bf16x8*)(lds + kb + off_b(16 * kt + fr, 4 * ks + fq)); s[kt] = MFMA16(kf, qf[ks], s[kt]); } }
}
__device__ __forceinline__ void attn_update(unsigned ldsbase, unsigned vb, f32x4 (&s)[4], AttnState& st, int lane) {
    float mx = -1e30f;
#pragma unroll
    for (int kt = 0; kt < 4; ++kt)
#pragma unroll
        for (int r = 0; r < 4; ++r) mx = fmaxf(mx, s[kt][r]);
    mx = fmaxf(mx, __shfl_xor(mx, 16)); mx = fmaxf(mx, __shfl_xor(mx, 32));
    const float mn = fmaxf(st.m, mx), alpha = __expf(st.m - mn);
    float ps = 0.f;
#pragma unroll
    for (int kt = 0; kt < 4; ++kt)
#pragma unroll
        for (int r = 0; r < 4; ++r) { const float p = __expf(s[kt][r] - mn); s[kt][r] = p; ps += p; }
    ps += __shfl_xor(ps, 16); ps += __shfl_xor(ps, 32);
    st.l = st.l * alpha + ps; st.m = mn;
#pragma unroll
    for (int c = 0; c < 8; ++c) st.o[c] = st.o[c] * alpha;
    const unsigned g = lane >> 4, q = (lane & 15) >> 2, p = lane & 3, xm = (q << 2) | g;
#pragma unroll
    for (int ks = 0; ks < 2; ++ks) {
        u32x4 pw; pw.x = cvt_pk_bf16(s[2 * ks][0], s[2 * ks][1]); pw.y = cvt_pk_bf16(s[2 * ks][2], s[2 * ks][3]); pw.z = cvt_pk_bf16(s[2 * ks + 1][0], s[2 * ks + 1][1]); pw.w = cvt_pk_bf16(s[2 * ks + 1][2], s[2 * ks + 1][3]);
        const bf16x8 pf = __builtin_bit_cast(bf16x8, pw);
        s16x4 v0[8], v1[8];
#pragma unroll
        for (int c = 0; c < 8; ++c) {
            const unsigned chunk = ((2u * c + (p >> 1)) ^ xm) * 16u + 8u * (p & 1u);
            v0[c] = tr_read(ldsbase + vb + 256u * (32u * ks + 4u * g + q) + chunk);
            v1[c] = tr_read(ldsbase + vb + 256u * (32u * ks + 16u + 4u * g + q) + chunk); }
        asm volatile("s_waitcnt lgkmcnt(0)" : "+v"(v0[0]), "+v"(v0[1]), "+v"(v0[2]), "+v"(v0[3]), "+v"(v0[4]), "+v"(v0[5]), "+v"(v0[6]), "+v"(v0[7]) :: "memory");
        asm volatile("" : "+v"(v1[0]), "+v"(v1[1]), "+v"(v1[2]), "+v"(v1[3]), "+v"(v1[4]), "+v"(v1[5]), "+v"(v1[6]), "+v"(v1[7]) :: "memory");
#pragma unroll
        for (int c = 0; c < 8; ++c) st.o[c] = MFMA16(cat8(v0[c], v1[c]), pf, st.o[c]);
    }
}
#define STAGE_TILE(ldsoff, nrows, ROWPTR) do { for (int _n = F.tid; _n < (nrows) * 16; _n += NTHREADS) { const int _r = _n >> 4, _ch = _n & 15; \
        const u32x4 _v = *(const u32x4*)((const char*)(ROWPTR(_r)) + _ch * 16); *(LAS u32x4*)(F.lds + (ldsoff) + off_b(_r, _ch)) = _v; } } while (0)

__device__ __forceinline__ void dilated_item(const Frame& F, int item) {
    const int br = item >> 10, r10 = item & 1023; const int dil = br == 0 ? 1 : (br == 1 ? 4 : 16), nb = 32 / dil;
    const int b = r10 >> 8, h = (r10 >> 5) & 7, rn = r10 & 31, res = rn / nb, n = rn % nb;
    const bf16_t* proj = (const bf16_t*)(F.ws + WS_PROJ);
    const int lane = F.lane, wave = F.wave, fr = lane & 15, fq = lane >> 4;
    const unsigned ldsbase = (unsigned)(size_t)F.lds;
    constexpr int KOFF = 0, VOFF = 65536, BOFF = 131072;
    const int kfirst = n == 0 ? 128 : 0;
#define DIL_TOK(ki) ((size_t)b * SEQ + (size_t)(128 * (n - 1) + (ki)) * dil + res)
#define DIL_KROW(ki) (proj + DIL_TOK(ki + kfirst) * IN0W + 1024 + 128 * h)
#define DIL_VROW(ki) (proj + DIL_TOK(ki + kfirst) * IN0W + 2048 + 128 * h)
    __syncthreads();
    STAGE_TILE(KOFF + kfirst * 256, 256 - kfirst, DIL_KROW);
    STAGE_TILE(VOFF + kfirst * 256, 256 - kfirst, DIL_VROW);
    if (F.tid < 132) ((LAS float*)(F.lds + BOFF))[F.tid] = ((const float*)(F.ws + WS_BIASREL))[(br * 8 + h) * 132 + F.tid];
    const int qi = 16 * wave + fr; const size_t qtok = (size_t)b * SEQ + (size_t)(128 * n + qi) * dil + res;
    bf16x8 qf[4];
#pragma unroll
    for (int ks = 0; ks < 4; ++ks) qf[ks] = *(const bf16x8*)(proj + qtok * IN0W + 128 * h + 32 * ks + 8 * fq);
    __syncthreads();
    AttnState st; attn_init(st);
    const LAS float* bt = (const LAS float*)(F.lds + BOFF);
#pragma unroll 1
    for (int j = (n == 0 ? 2 : 0); j < 4; ++j) {
        if (64 * j > 16 * wave + 15 + 128 || 64 * j + 63 < 16 * wave) continue;
        f32x4 s[4];
        attn_scores(F.lds, KOFF + j * 16384, qf, s, fr, fq);
#pragma unroll
        for (int kt = 0; kt < 4; ++kt)
#pragma unroll
            for (int r = 0; r < 4; ++r) { const int ki = 64 * j + 16 * kt + 4 * fq + r, rel = qi + 128 - ki; const bool ok = rel >= 0 && rel <= 128; const int rc = ok ? rel : 0;
                s[kt][r] = ok ? s[kt][r] * ATT_SCALE + bt[rc] : -1e30f; }
        attn_update(ldsbase, VOFF + j * 16384, s, st, lane);
    }
    const float inv = 1.0f / st.l; bf16_t* ob = (bf16_t*)(F.ws + WS_OBR) + ((size_t)br * NTOK + qtok) * 1024 + 128 * h;
#pragma unroll
    for (int c = 0; c < 8; ++c) { u32x2 w; w.x = cvt_pk_bf16(st.o[c][0] * inv, st.o[c][1] * inv); w.y = cvt_pk_bf16(st.o[c][2] * inv, st.o[c][3] * inv); *(u32x2*)(ob + 16 * c + 4 * fq) = w; }
    if (fq == 0) ((float*)(F.ws + WS_LSE))[((size_t)br * NTOK + qtok) * 8 + h] = st.m + __logf(st.l);
#undef DIL_TOK
#undef DIL_KROW
#undef DIL_VROW
}
__device__ __forceinline__ void combine_tokens(const Frame& F) {
    const int gw = F.bid * NWAVES + F.wave, NGW = F.G * NWAVES, lane = F.lane, h = lane >> 3;
    const bf16_t* ob = (const bf16_t*)(F.ws + WS_OBR); const float* lse = (const float*)(F.ws + WS_LSE); bf16_t* a2 = (bf16_t*)(F.ws + WS_A2);
    for (int tok = gw; tok < NTOK; tok += NGW) {
        const float l0 = lse[((size_t)0 * NTOK + tok) * 8 + h], l1 = lse[((size_t)1 * NTOK + tok) * 8 + h], l2 = lse[((size_t)2 * NTOK + tok) * 8 + h];
        const float m = fmaxf(l0, fmaxf(l1, l2)); const float e0 = __expf(l0 - m), e1 = __expf(l1 - m), e2 = __expf(l2 - m), inv = 1.0f / (e0 + e1 + e2);
        const float w[3] = {e0 * inv, e1 * inv, e2 * inv};
        float acc[16];
#pragma unroll
        for (int j = 0; j < 16; ++j) acc[j] = 0.f;
#pragma unroll
        for (int b3 = 0; b3 < 3; ++b3) { const u32x4* p = (const u32x4*)(ob + ((size_t)b3 * NTOK + tok) * 1024 + 16 * lane); const u32x4 x0 = p[0], x1 = p[1];
            acc[0] += w[b3] * bf_lo(x0.x); acc[1] += w[b3] * bf_hi(x0.x); acc[2] += w[b3] * bf_lo(x0.y); acc[3] += w[b3] * bf_hi(x0.y);
            acc[4] += w[b3] * bf_lo(x0.z); acc[5] += w[b3] * bf_hi(x0.z); acc[6] += w[b3] * bf_lo(x0.w); acc[7] += w[b3] * bf_hi(x0.w);
            acc[8] += w[b3] * bf_lo(x1.x); acc[9] += w[b3] * bf_hi(x1.x); acc[10] += w[b3] * bf_lo(x1.y); acc[11] += w[b3] * bf_hi(x1.y);
            acc[12] += w[b3] * bf_lo(x1.z); acc[13] += w[b3] * bf_hi(x1.z); acc[14] += w[b3] * bf_lo(x1.w); acc[15] += w[b3] * bf_hi(x1.w); }
        u32x4 o0, o1; o0.x = cvt_pk_bf16(acc[0], acc[1]); o0.y = cvt_pk_bf16(acc[2], acc[3]); o0.z = cvt_pk_bf16(acc[4], acc[5]); o0.w = cvt_pk_bf16(acc[6], acc[7]);
        o1.x = cvt_pk_bf16(acc[8], acc[9]); o1.y = cvt_pk_bf16(acc[10], acc[11]); o1.z = cvt_pk_bf16(acc[12], acc[13]); o1.w = cvt_pk_bf16(acc[14], acc[15]);
        u32x4* d = (u32x4*)(a2 + (size_t)tok * D + 16 * lane); d[0] = o0; d[1] = o1;
    }
}
__device__ __forceinline__ void fox_item(const Frame& F, int item) {
    const int rnd = item >> 8, cc = item & 255, bh = cc & 63, g4 = cc >> 6; const int qb = 31 - (4 * rnd + ((rnd & 1) ? 3 - g4 : g4));
    const int b = bh >> 4, h = bh & 15;
    const bf16_t* proj = (const bf16_t*)(F.ws + WS_PROJ); const float* cbase = (const float*)(F.ws + WS_CC) + (size_t)bh * SEQ;
    const int lane = F.lane, wave = F.wave, fr = lane & 15, fq = lane >> 4;
    const unsigned ldsbase = (unsigned)(size_t)F.lds;
    constexpr int BUFB = 33792;
    const int qrow = 128 * qb + 16 * wave + fr; const size_t qtok = (size_t)b * SEQ + qrow;
    bf16x8 qf[4];
#pragma unroll
    for (int ks = 0; ks < 4; ++ks) qf[ks] = *(const bf16x8*)(proj + qtok * IN1W + 128 * h + 32 * ks + 8 * fq);
    const float cq = cbase[qrow];
    const int j0 = 2 * qb + 1;
    const int sr0 = F.tid >> 4, sch = F.tid & 15;
    u32x4 rk0, rk1, rv0, rv1; float rc = 0.f;
#define FOX_LOAD(j) do { const bf16_t* _p0 = proj + ((size_t)b * SEQ + 64 * (j) + sr0) * IN1W + 128 * h + 8 * sch; const bf16_t* _p1 = _p0 + (size_t)32 * IN1W; \
        rk0 = *(const u32x4*)(_p0 + 2048); rk1 = *(const u32x4*)(_p1 + 2048); rv0 = *(const u32x4*)(_p0 + 4096); rv1 = *(const u32x4*)(_p1 + 4096); if (F.tid < 64) rc = cbase[64 * (j) + F.tid]; } while (0)
#define FOX_WRITE(bufo) do { *(LAS u32x4*)(F.lds + (bufo) + off_b(sr0, sch)) = rk0; *(LAS u32x4*)(F.lds + (bufo) + off_b(sr0 + 32, sch)) = rk1; \
        *(LAS u32x4*)(F.lds + (bufo) + 16384 + off_b(sr0, sch)) = rv0; *(LAS u32x4*)(F.lds + (bufo) + 16384 + off_b(sr0 + 32, sch)) = rv1; if (F.tid < 64) ((LAS float*)(F.lds + (bufo) + 32768))[F.tid] = rc; } while (0)
    __syncthreads();
    FOX_LOAD(j0); FOX_WRITE(0);
    __syncthreads();
    AttnState st; attn_init(st);
    int cur = 0;
#pragma unroll 1
    for (int j = j0; j >= 0; --j) {
        if (j > 0) FOX_LOAD(j - 1);
        const int bufo = cur * BUFB;
        if (64 * j <= 128 * qb + 16 * wave + 15) {
            f32x4 s[4];
            attn_scores(F.lds, bufo, qf, s, fr, fq);
            const LAS float* ck = (const LAS float*)(F.lds + bufo + 32768);
#pragma unroll
            for (int kt = 0; kt < 4; ++kt) { const f32x4 c4 = *(const LAS f32x4*)(ck + 16 * kt + 4 * fq);
#pragma unroll
                for (int r = 0; r < 4; ++r) { const int key = 64 * j + 16 * kt + 4 * fq + r; s[kt][r] = key <= qrow ? s[kt][r] * ATT_SCALE + (cq - c4[r]) : -1e30f; } }
            attn_update(ldsbase, bufo + 16384, s, st, lane);
        }
        if (j > 0) FOX_WRITE((cur ^ 1) * BUFB);
        __syncthreads();
        cur ^= 1;
    }
    const float inv = 1.0f / st.l; bf16_t* ob = (bf16_t*)(F.ws + WS_A2) + qtok * D + 128 * h;
#pragma unroll
    for (int c = 0; c < 8; ++c) { u32x2 w; w.x = cvt_pk_bf16(st.o[c][0] * inv, st.o[c][1] * inv); w.y = cvt_pk_bf16(st.o[c][2] * inv, st.o[c][3] * inv); *(u32x2*)(ob + 16 * c + 4 * fq) = w; }
#undef FOX_LOAD
#undef FOX_WRITE
}
#define HG_PART_OFF 122880
#define HGRN_FRONT(PROJ, T0, H) \
    const int k_ = F.tid & 127, tq_ = F.tid >> 7; const float lbk_ = ((const float*)(F.ws + WS_LB))[128 * (H) + k_]; \
    float a16[16], key16[16]; { float run_ = 0.f; \
    _Pragma("unroll") for (int i = 0; i < 16; ++i) { const float fl_ = bf2f((PROJ)[(size_t)((T0) + 16 * tq_ + i) * IN0W + 4096 + 128 * (H) + k_]); \
        const float fo_ = lbk_ + (1.0f - lbk_) * sigmoidf_(fl_); run_ += __logf(fo_); a16[i] = run_; key16[i] = 1.0f - fo_; } \
    ((LAS float*)(F.lds + HG_PART_OFF))[tq_ * 128 + k_] = run_; } \
    __syncthreads(); \
    float aoff_ = 0.f, atot_ = 0.f; \
    _Pragma("unroll") for (int q = 0; q < 4; ++q) { const float p_ = ((const LAS float*)(F.lds + HG_PART_OFF))[q * 128 + k_]; atot_ += p_; aoff_ += q < tq_ ? p_ : 0.f; } \
    _Pragma("unroll") for (int i = 0; i < 16; ++i) a16[i] += aoff_;

__device__ __forceinline__ void hgrn_a_item(const Frame& F, int it) {
    const int bh = it >> 6, c = it & 63, b = bh >> 3, h = bh & 7, t0 = b * SEQ + 64 * c;
    const bf16_t* proj = (const bf16_t*)(F.ws + WS_PROJ);
    const int lane = F.lane, wave = F.wave, fr = lane & 15, fq = lane >> 4;
    const unsigned ldsbase = (unsigned)(size_t)F.lds;
    constexpr int KD_OFF = 0, VAL_OFF = 20480;
    __syncthreads();
    HGRN_FRONT(proj, t0, h)
    {
        u32x4 w0, w1; float kd[16];
#pragma unroll
        for (int i = 0; i < 16; ++i) kd[i] = key16[i] * __expf(atot_ - a16[i]);
        w0.x = cvt_pk_bf16(kd[0], kd[1]); w0.y = cvt_pk_bf16(kd[2], kd[3]); w0.z = cvt_pk_bf16(kd[4], kd[5]); w0.w = cvt_pk_bf16(kd[6], kd[7]);
        w1.x = cvt_pk_bf16(kd[8], kd[9]); w1.y = cvt_pk_bf16(kd[10], kd[11]); w1.z = cvt_pk_bf16(kd[12], kd[13]); w1.w = cvt_pk_bf16(kd[14], kd[15]);
        *(LAS u32x4*)(F.lds + KD_OFF + k_ * 144 + tq_ * 32) = w0; *(LAS u32x4*)(F.lds + KD_OFF + k_ * 144 + tq_ * 32 + 16) = w1;
        if (tq_ == 0) ((float*)(F.ws + WS_ALAST))[(size_t)it * 128 + k_] = atot_;
    }
#define HG_VROW(r) (proj + (size_t)(t0 + (r)) * IN0W + 5120 + 128 * h)
    STAGE_TILE(VAL_OFF, 64, HG_VROW);
    __syncthreads();
    const unsigned g = lane >> 4, q = (lane & 15) >> 2, p = lane & 3;
    bf16x8 af[2];
    {   s16x4 x0[2], x1[2];
#pragma unroll
        for (int ks = 0; ks < 2; ++ks) { x0[ks] = tr_read(ldsbase + VAL_OFF + off_b(32 * ks + 8 * g + q, 2 * wave + (p >> 1)) + 8 * (p & 1));
            x1[ks] = tr_read(ldsbase + VAL_OFF + off_b(32 * ks + 8 * g + 4 + q, 2 * wave + (p >> 1)) + 8 * (p & 1)); }
        asm volatile("s_waitcnt lgkmcnt(0)" : "+v"(x0[0]), "+v"(x0[1]), "+v"(x1[0]), "+v"(x1[1]) :: "memory");
        af[0] = cat8(x0[0], x1[0]); af[1] = cat8(x0[1], x1[1]); }
    float* lt = (float*)(F.ws + WS_LT) + (size_t)it * 16384;
#pragma unroll
    for (int nt = 0; nt < 8; ++nt) { f32x4 acc = (f32x4){0.f, 0.f, 0.f, 0.f};
#pragma unroll
        for (int ks = 0; ks < 2; ++ks) { const bf16x8 bfr = *(const LAS bf16x8*)(F.lds + KD_OFF + (16 * nt + fr) * 144 + (32 * ks + 8 * fq) * 2); acc = MFMA16(af[ks], bfr, acc); }
#pragma unroll
        for (int r = 0; r < 4; ++r) lt[(size_t)(16 * wave + 4 * fq + r) * 128 + 16 * nt + fr] = acc[r]; }
#undef HG_VROW
}
__device__ __forceinline__ void hgrn_scan(const Frame& F) {
    const int gt = F.bid * NTHREADS + F.tid, GT = F.G * NTHREADS;
    const float* lt = (const float*)(F.ws + WS_LT); const float* al = (const float*)(F.ws + WS_ALAST); bf16_t* st = (bf16_t*)(F.ws + WS_ST);
    for (int e = gt; e < 32 * 128 * 32; e += GT) { const int bh = e >> 12, v = (e >> 5) & 127, k4 = (e & 31) * 4;
        f32x4 s = (f32x4){0.f, 0.f, 0.f, 0.f};
#pragma unroll 4
        for (int c = 0; c < 64; ++c) { const size_t it = (size_t)bh * 64 + c; const size_t o = (it * 128 + v) * 128 + k4;
            u32x2 w; w.x = cvt_pk_bf16(s[0], s[1]); w.y = cvt_pk_bf16(s[2], s[3]); *(u32x2*)(st + o) = w;
            const f32x4 l = *(const f32x4*)(lt + o), a = *(const f32x4*)(al + it * 128 + k4);
            s[0] = __expf(a[0]) * s[0] + l[0]; s[1] = __expf(a[1]) * s[1] + l[1]; s[2] = __expf(a[2]) * s[2] + l[2]; s[3] = __expf(a[3]) * s[3] + l[3]; } }
}
__device__ __forceinline__ void hgrn_c_item(const Frame& F, int it) {
    const int bh = it >> 6, c = it & 63, b = bh >> 3, h = bh & 7, t0 = b * SEQ + 64 * c;
    const bf16_t* proj = (const bf16_t*)(F.ws + WS_PROJ);
    const int lane = F.lane, wave = F.wave, fr = lane & 15, fq = lane >> 4;
    const unsigned ldsbase = (unsigned)(size_t)F.lds;
    constexpr int A_OFF = 0, FQ_OFF = 34816, KEY_OFF = 52224, VAL_OFF = 73728, ST_OFF = 90112, RMS_OFF = 124928;
    __syncthreads();
    HGRN_FRONT(proj, t0, h)
#pragma unroll
    for (int i = 0; i < 16; ++i) { const int t = 16 * tq_ + i; ((LAS float*)(F.lds + A_OFF))[t * 132 + k_] = a16[i];
        const float qv = bf2f(proj[(size_t)(t0 + t) * IN0W + 3072 + 128 * h + k_]);
        ((LAS bf16_t*)(F.lds + FQ_OFF))[t * 136 + k_] = (bf16_t)(cvt_pk_bf16(siluf_(qv), 0.f) & 0xffffu);
        ((LAS bf16_t*)(F.lds + KEY_OFF))[t * 136 + k_] = (bf16_t)(cvt_pk_bf16(key16[i], 0.f) & 0xffffu); }
#define HG_VROW(r) (proj + (size_t)(t0 + (r)) * IN0W + 5120 + 128 * h)
#define HG_SROW(r) ((const bf16_t*)(F.ws + WS_ST) + ((size_t)it * 128 + (r)) * 128)
    STAGE_TILE(VAL_OFF, 64, HG_VROW);
    STAGE_TILE(ST_OFF, 128, HG_SROW);
    __syncthreads();
    const int I = wave & 3, vh = wave >> 2;
    const LAS float* al = (const LAS float*)(F.lds + A_OFF);
    f32x4 o[4];
#pragma unroll
    for (int c4 = 0; c4 < 4; ++c4) o[c4] = (f32x4){0.f, 0.f, 0.f, 0.f};
    bf16x8 qh[4];
#pragma unroll
    for (int ks = 0; ks < 4; ++ks) {
        const int t = 16 * I + fr, k = 32 * ks + 8 * fq;
        const u32x4 fw = *(const LAS u32x4*)(F.lds + FQ_OFF + (t * 136 + k) * 2);
        const f32x4 a0 = *(const LAS f32x4*)(al + t * 132 + k), a1 = *(const LAS f32x4*)(al + t * 132 + k + 4);
        f32x4 r0 = (f32x4){0.f, 0.f, 0.f, 0.f}, r1 = r0;
        if (I > 0) { r0 = *(const LAS f32x4*)(al + (16 * I - 1) * 132 + k); r1 = *(const LAS f32x4*)(al + (16 * I - 1) * 132 + k + 4); }
        const float f0 = bf_lo(fw.x), f1 = bf_hi(fw.x), f2 = bf_lo(fw.y), f3 = bf_hi(fw.y), f4 = bf_lo(fw.z), f5 = bf_hi(fw.z), f6 = bf_lo(fw.w), f7 = bf_hi(fw.w);
        u32x4 qi; qi.x = cvt_pk_bf16(f0 * __expf(a0[0]), f1 * __expf(a0[1])); qi.y = cvt_pk_bf16(f2 * __expf(a0[2]), f3 * __expf(a0[3]));
        qi.z = cvt_pk_bf16(f4 * __expf(a1[0]), f5 * __expf(a1[1])); qi.w = cvt_pk_bf16(f6 * __expf(a1[2]), f7 * __expf(a1[3]));
        u32x4 qr; qr.x = cvt_pk_bf16(f0 * __expf(a0[0] - r0[0]), f1 * __expf(a0[1] - r0[1])); qr.y = cvt_pk_bf16(f2 * __expf(a0[2] - r0[2]), f3 * __expf(a0[3] - r0[3]));
        qr.z = cvt_pk_bf16(f4 * __expf(a1[0] - r1[0]), f5 * __expf(a1[1] - r1[1])); qr.w = cvt_pk_bf16(f6 * __expf(a1[2] - r1[2]), f7 * __expf(a1[3] - r1[3]));
        qh[ks] = __builtin_bit_cast(bf16x8, qr);
        const bf16x8 qib = __builtin_bit_cast(bf16x8, qi);
#pragma unroll
        for (int c4 = 0; c4 < 4; ++c4) { const bf16x8 sf = *(const LAS bf16x8*)(F.lds + ST_OFF + off_b(16 * (4 * vh + c4) + fr, 4 * ks + fq)); o[c4] = MFMA16(sf, qib, o[c4]); }
    }
    f32x4 sc[4];
#pragma unroll
    for (int J = 0; J < 4; ++J) { sc[J] = (f32x4){0.f, 0.f, 0.f, 0.f};
        if (J <= I) {
#pragma unroll
            for (int ks = 0; ks < 4; ++ks) {
                const int s = 16 * J + fr, k = 32 * ks + 8 * fq;
                const u32x4 kw = *(const LAS u32x4*)(F.lds + KEY_OFF + (s * 136 + k) * 2);
                const f32x4 a0 = *(const LAS f32x4*)(al + s * 132 + k), a1 = *(const LAS f32x4*)(al + s * 132 + k + 4);
                f32x4 r0 = (f32x4){0.f, 0.f, 0.f, 0.f}, r1 = r0;
                if (I > 0) { r0 = *(const LAS f32x4*)(al + (16 * I - 1) * 132 + k); r1 = *(const LAS f32x4*)(al + (16 * I - 1) * 132 + k + 4); }
                u32x4 kh; kh.x = cvt_pk_bf16(bf_lo(kw.x) * __expf(r0[0] - a0[0]), bf_hi(kw.x) * __expf(r0[1] - a0[1])); kh.y = cvt_pk_bf16(bf_lo(kw.y) * __expf(r0[2] - a0[2]), bf_hi(kw.y) * __expf(r0[3] - a0[3]));
                kh.z = cvt_pk_bf16(bf_lo(kw.z) * __expf(r1[0] - a1[0]), bf_hi(kw.z) * __expf(r1[1] - a1[1])); kh.w = cvt_pk_bf16(bf_lo(kw.w) * __expf(r1[2] - a1[2]), bf_hi(kw.w) * __expf(r1[3] - a1[3]));
                sc[J] = MFMA16(__builtin_bit_cast(bf16x8, kh), qh[ks], sc[J]);
            }
            if (J == I) {
#pragma unroll
                for (int r = 0; r < 4; ++r) sc[J][r] = (4 * fq + r) <= fr ? sc[J][r] : 0.f;
            }
        }
    }
    const unsigned g = lane >> 4, q = (lane & 15) >> 2, p = lane & 3, xm = (q << 2) | g;
#pragma unroll
    for (int ks = 0; ks < 2; ++ks) {
        if (2 * ks <= I) {
            u32x4 pw; pw.x = cvt_pk_bf16(sc[2 * ks][0], sc[2 * ks][1]); pw.y = cvt_pk_bf16(sc[2 * ks][2], sc[2 * ks][3]); pw.z = cvt_pk_bf16(sc[2 * ks + 1][0], sc[2 * ks + 1][1]); pw.w = cvt_pk_bf16(sc[2 * ks + 1][2], sc[2 * ks + 1][3]);
            const bf16x8 pf = __builtin_bit_cast(bf16x8, pw);
            s16x4 v0[4], v1[4];
#pragma unroll
            for (int c4 = 0; c4 < 4; ++c4) { const unsigned chunk = ((2u * (4 * vh + c4) + (p >> 1)) ^ xm) * 16u + 8u * (p & 1u);
                v0[c4] = tr_read(ldsbase + VAL_OFF + 256u * (32u * ks + 4u * g + q) + chunk);
                v1[c4] = tr_read(ldsbase + VAL_OFF + 256u * (32u * ks + 16u + 4u * g + q) + chunk); }
            asm volatile("s_waitcnt lgkmcnt(0)" : "+v"(v0[0]), "+v"(v0[1]), "+v"(v0[2]), "+v"(v0[3]), "+v"(v1[0]), "+v"(v1[1]), "+v"(v1[2]), "+v"(v1[3]) :: "memory");
#pragma unroll
            for (int c4 = 0; c4 < 4; ++c4) o[c4] = MFMA16(cat8(v0[c4], v1[c4]), pf, o[c4]);
        }
    }
    float ss = 0.f;
#pragma unroll
    for (int c4 = 0; c4 < 4; ++c4)
#pragma unroll
        for (int r = 0; r < 4; ++r) ss += o[c4][r] * o[c4][r];
    ss += __shfl_xor(ss, 16); ss += __shfl_xor(ss, 32);
    if (fq == 0) ((LAS float*)(F.lds + RMS_OFF))[vh * 64 + 16 * I + fr] = ss;
    __syncthreads();
    const float tot = ((const LAS float*)(F.lds + RMS_OFF))[16 * I + fr] + ((const LAS float*)(F.lds + RMS_OFF))[64 + 16 * I + fr];
    const float rstd = 1.0f / sqrtf(tot * (1.0f / 128.0f) + RMS_EPS);
    const size_t tok = (size_t)t0 + 16 * I + fr; const float* gn = F.in[4] + 128 * h; bf16_t* a2 = (bf16_t*)(F.ws + WS_A2) + tok * D + 1024 + 128 * h;
#pragma unroll
    for (int c4 = 0; c4 < 4; ++c4) { const int v = 16 * (4 * vh + c4) + 4 * fq;
        const u32x2 gw = *(const u32x2*)(proj + tok * IN0W + 6144 + 128 * h + v); const f32x4 gg = *(const f32x4*)(gn + v);
        const float g0 = bf_lo(gw.x), g1 = bf_hi(gw.x), g2 = bf_lo(gw.y), g3 = bf_hi(gw.y);
        u32x2 w; w.x = cvt_pk_bf16(o[c4][0] * rstd * gg[0] * siluf_(g0), o[c4][1] * rstd * gg[1] * siluf_(g1)); w.y = cvt_pk_bf16(o[c4][2] * rstd * gg[2] * siluf_(g2), o[c4][3] * rstd * gg[3] * siluf_(g3));
        *(u32x2*)(a2 + v) = w; }
#undef HG_VROW
#undef HG_SROW
}
__device__ __forceinline__ int build_tile_table(const Frame& F, const unsigned* cnt) {
    LAS int* cnts = (LAS int*)(F.lds + LDS_TT); LAS int* tstart = cnts + 72; LAS int* tt = cnts + 256;
    __syncthreads();
    if (F.tid < NEX) { int c = F.tid < NE ? (int)cnt[64 * F.tid] : NTOK; cnts[F.tid] = c > LISTCAP ? LISTCAP : c; }
    __syncthreads();
    if (F.tid == 0) { int acc = 0; for (int e = 0; e < NEX; ++e) { tstart[e] = acc; acc += (cnts[e] + 255) >> 8; } tstart[NEX] = acc; }
    __syncthreads();
    if (F.tid < NEX) { const int n = (cnts[F.tid] + 255) >> 8, s = tstart[F.tid]; for (int ti = 0; ti < n; ++ti) { tt[2 * (s + ti)] = F.tid; tt[2 * (s + ti) + 1] = ti; } }
    __syncthreads();
    return tstart[NEX];
}

struct Args { const float* in[21]; float* out; unsigned char* ws; int ph_lo, ph_hi; };
constexpr int N_PHASES = 18;

__global__ void __launch_bounds__(NTHREADS, 2) hybrid_fwd(Args args) {
    extern __shared__ __attribute__((aligned(16))) unsigned char lds_raw[];
    Frame F;
    F.lds = (LAS unsigned char*)lds_raw; F.tid = threadIdx.x; F.lane = F.tid & 63; F.wave = __builtin_amdgcn_readfirstlane(F.tid >> 6); F.G = gridDim.x; F.bid = blockIdx.x;
    F.in = args.in; F.out = args.out; F.ws = args.ws;
    unsigned char* ws = args.ws;
    unsigned* ctl = (unsigned*)(ws + WS_CTL);
    volatile LAS unsigned* MISC = (volatile LAS unsigned*)(F.lds + LDS_MISC);
    if (F.tid < 64) MISC[F.tid] = 0u;
    __syncthreads();
    const int lo = args.ph_lo, hi = args.ph_hi;
    XcdBarrier bar; bar.bar = ctl + CW_BAR; bar.x = 0; bar.st = MISC + 8;
    if (hi - lo > 1) bar = xcd_barrier_post(ctl + CW_BAR, MISC + 8);
#ifndef DBG_MASK
#define DBG_MASK 0x3ffff
#endif
#define IN(k) (((DBG_MASK >> (k)) & 1) && lo <= (k) && (k) < hi)
#define SEAM(k) do { if (lo <= (k) && (k) + 1 < hi) xcd_barrier(bar); } while (0)

    if (IN(0)) { phase_prologue(F); SEAM(0); }
#define PH_INPROJ(pid, layer) if (IN(pid)) { \
        pg8::ProbPlain P{(const char*)(ws + WS_XA), (const char*)(ws + ((layer) ? WS_WIN1 : WS_WIN0)), D, NTOK / 256, (layer) ? IN1W / 256 : IN0W / 256, F.G, F.bid}; \
        pg8::EpiBf16 E{(bf16_t*)(ws + WS_PROJ), (layer) ? IN1W : IN0W}; pg8::gemm_phase(F.lds, P, E); SEAM(pid); }
#define PH_OUTPROJ(pid, layer) if (IN(pid)) { \
        pg8::ProbPlain P{(const char*)(ws + WS_A2), (const char*)(ws + ((layer) ? WS_WOUT1 : WS_WOUT0)), D, NTOK / 256, D / 256, F.G, F.bid}; \
        pg8::EpiResF32 E{(layer) ? (const float*)(ws + WS_X2F) : F.in[0], (float*)(ws + WS_YF), D, DN_ALPHA}; pg8::gemm_phase(F.lds, P, E); SEAM(pid); }
#define PH_ROUTER(pid, layer) if (IN(pid)) { \
        RowArgs a{(const float*)(ws + WS_YF), nullptr, F.in[9] + (layer) * D, F.in[10] + (layer) * D, (float*)(ws + WS_X1F), (bf16_t*)(ws + WS_X1B), \
                  (const bf16_t*)(ws + WS_RT) + (size_t)((layer) * 2 + 0) * 64 * D, (const bf16_t*)(ws + WS_RT) + (size_t)((layer) * 2 + 1) * 64 * D, F.in[14] + (layer) * 64, ctl + CW_CNT + (layer) * 66 * 64, \
                  (int*)(ws + WS_LISTS), (float*)(ws + WS_WTS), nullptr}; \
        phase_rows<0, 4>(F, a); SEAM(pid); }
#define PH_GATEUP(pid, layer) if (IN(pid)) { \
        const int ntiles = build_tile_table(F, ctl + CW_CNT + (layer) * 66 * 64); \
        pg8::ProbMoE P{(const char*)(ws + WS_X1B), (const char*)(ws + WS_WGU), D, ntiles, 4, F.G, F.bid, (const int*)(ws + WS_LISTS), (const LAS int*)(F.lds + LDS_TT) + 256, (const LAS int*)(F.lds + LDS_TT), 1}; \
        pg8::EpiSwiGLU E{(bf16_t*)(ws + WS_H)}; pg8::gemm_phase(F.lds, P, E); SEAM(pid); }
#define PH_DOWN(pid, layer) if (IN(pid)) { \
        const int ntiles = build_tile_table(F, ctl + CW_CNT + (layer) * 66 * 64); \
        pg8::ProbMoE P{(const char*)(ws + WS_H), (const char*)(ws + WS_WD), EDIM, ntiles, 8, F.G, F.bid, (const int*)(ws + WS_LISTS), (const LAS int*)(F.lds + LDS_TT) + 256, (const LAS int*)(F.lds + LDS_TT), 0}; \
        pg8::EpiDown E{(bf16_t*)(ws + WS_Y), (const int*)(ws + WS_LISTS), (const float*)(ws + WS_WTS)}; pg8::gemm_phase(F.lds, P, E); SEAM(pid); }
    PH_INPROJ(1, 0)
    if (IN(2)) { for (int it = F.bid; it < 3072 + 2048; it += F.G) { if (it < 3072) dilated_item(F, it); else hgrn_a_item(F, it - 3072); } SEAM(2); }
    if (IN(3)) { hgrn_scan(F); SEAM(3); }
    if (IN(4)) { for (int it = F.bid; it < 2048; it += F.G) hgrn_c_item(F, it); combine_tokens(F); SEAM(4); }
    PH_OUTPROJ(5, 0)
    PH_ROUTER(6, 0)
    PH_GATEUP(7, 0)
    PH_DOWN(8, 0)
    if (IN(9)) {
        RowArgs a{(const float*)(ws + WS_X1F), (const bf16_t*)(ws + WS_Y), F.in[11], F.in[12], (float*)(ws + WS_X2F), (bf16_t*)(ws + WS_XA),
                  (const bf16_t*)(ws + WS_FGHI), (const bf16_t*)(ws + WS_FGLO), nullptr, nullptr, nullptr, nullptr, (float*)(ws + WS_FLOG)};
        phase_rows<1, 1>(F, a); SEAM(9); }
    if (IN(10)) { phase_convert_l1(F); SEAM(10); }
    PH_INPROJ(11, 1)
    if (IN(12)) { for (int it = F.bid; it < 2048; it += F.G) fox_item(F, it); SEAM(12); }
    PH_OUTPROJ(13, 1)
    PH_ROUTER(14, 1)
    PH_GATEUP(15, 1)
    PH_DOWN(16, 1)
    if (IN(17)) {
        RowArgs a{(const float*)(ws + WS_X1F), (const bf16_t*)(ws + WS_Y), F.in[11] + D, F.in[12] + D, F.out, (bf16_t*)(ws + WS_XA),
                  nullptr, nullptr, nullptr, nullptr, nullptr, nullptr, nullptr};
        phase_rows<1, 0>(F, a); }
#undef IN
#undef SEAM
}

#ifndef MK_N_LAUNCHES
#define MK_N_LAUNCHES 1
#endif
extern "C" void kernel_launch(void* const* d_in, const int* in_sizes, int n_in, void* d_out, int out_size, void* d_ws, size_t ws_size, hipStream_t stream) {
    static int grid = 0;
    if (grid == 0) {
        if (n_in != 21 || out_size != NTOK * D || ws_size < WS_END) { fprintf(stderr, "kernel_launch: unexpected shapes (n_in %d, out %d, ws %zu < %zu)\n", n_in, out_size, ws_size, (size_t)WS_END); grid = -1; return; }
        int dev = 0, cus = 0, per_cu = 0;
        if (hipGetDevice(&dev) != hipSuccess || hipDeviceGetAttribute(&cus, hipDeviceAttributeMultiprocessorCount, dev) != hipSuccess) { grid = -1; return; }
        if (hipFuncSetAttribute((const void*)hybrid_fwd, hipFuncAttributeMaxDynamicSharedMemorySize, LDS_BYTES) != hipSuccess) { fprintf(stderr, "kernel_launch: hipFuncSetAttribute failed\n"); grid = -1; return; }
        if (hipOccupancyMaxActiveBlocksPerMultiprocessor(&per_cu, (const void*)hybrid_fwd, NTHREADS, LDS_BYTES) != hipSuccess || per_cu < 1) { fprintf(stderr, "kernel_launch: occupancy query says %d\n", per_cu); }
        (void)hipGetLastError();
        grid = cus;
    }
    if (grid < 0) return;
    (void)in_sizes;
    if (hipMemsetAsync((char*)d_ws + WS_CTL, 0, CTL_ZERO_BYTES, stream) != hipSuccess) return;
    Args a{};
    for (int i = 0; i < 21; ++i) a.in[i] = (const float*)d_in[i];
    a.out = (float*)d_out; a.ws = (unsigned char*)d_ws;
    if (MK_N_LAUNCHES == 1) { a.ph_lo = 0; a.ph_hi = N_PHASES; hipLaunchKernelGGL(hybrid_fwd, dim3(grid), dim3(NTHREADS), LDS_BYTES, stream, a); }
    else for (int p = 0; p < N_PHASES; ++p) { a.ph_lo = p; a.ph_hi = p + 1; hipLaunchKernelGGL(hybrid_fwd, dim3(grid), dim3(NTHREADS), LDS_BYTES, stream, a); }
}
```

```cpp
#include <hip/hip_runtime.h>
#include <cstdio>
#include <cstdint>

#define LAS __attribute__((address_space(3)))
#define GAS __attribute__((address_space(1)))
typedef unsigned short bf16_t;
typedef short bf16x8 __attribute__((ext_vector_type(8)));
typedef short s16x4 __attribute__((ext_vector_type(4)));
typedef float f32x4 __attribute__((ext_vector_type(4)));
typedef float f32x2 __attribute__((ext_vector_type(2)));
typedef unsigned u32x4 __attribute__((ext_vector_type(4)));
typedef unsigned u32x2 __attribute__((ext_vector_type(2)));

constexpr int D = 2048, NTOK = 16384, SEQ = 4096, NBATCH = 4;
constexpr int IN0W = 7168, IN1W = 6144, IN1FULL = 6160;
constexpr int NE = 64, NEX = 65  , EDIM = 512, LISTCAP = 16384;
constexpr float LN_EPS = 1e-5f, RMS_EPS = 1e-6f;
constexpr float DN_ALPHA = 1.4142135623730951f;
constexpr float ATT_SCALE = 0.08838834764831845f;
constexpr int NWAVES = 8, NTHREADS = 512;

constexpr size_t MiB = 1u << 20;
constexpr size_t WS_CTL = 0, CTL_ZERO_BYTES = 1 * MiB;
constexpr size_t WS_LB = 1 * MiB;
constexpr size_t WS_BIASREL = 1 * MiB + 16384;
constexpr size_t WS_FGHI = 1 * MiB + 65536;
constexpr size_t WS_FGLO = 1 * MiB + 131072;
constexpr size_t WS_RT = 2 * MiB;
constexpr size_t WS_WTS = 3 * MiB;
constexpr size_t WS_FLOG = 4 * MiB;
constexpr size_t WS_CC = 5 * MiB;
constexpr size_t WS_LSE = 6 * MiB;
constexpr size_t WS_ALAST = 8 * MiB;
constexpr size_t WS_LISTS = 9 * MiB;
constexpr size_t WS_WIN0 = 16 * MiB, WS_WOUT0 = 44 * MiB, WS_WIN1 = 52 * MiB, WS_WOUT1 = 76 * MiB;
constexpr size_t WS_WGU = 84 * MiB;
constexpr size_t WS_WD = 344 * MiB;
constexpr size_t WS_XA = 474 * MiB;
constexpr size_t WS_X1B = 538 * MiB;
constexpr size_t WS_A2 = 602 * MiB;
constexpr size_t WS_YF = 666 * MiB;
constexpr size_t WS_X1F = 794 * MiB;
constexpr size_t WS_X2F = 922 * MiB;
constexpr size_t WS_H = 1050 * MiB;
constexpr size_t WS_Y = 1210 * MiB;
constexpr size_t WS_PROJ = 1210 * MiB;
constexpr size_t WS_LT = 1434 * MiB;
constexpr size_t WS_ST = 1562 * MiB;
constexpr size_t WS_OBR = 1626 * MiB;
constexpr size_t WS_END = 1786 * MiB;
constexpr int CW_BAR = 4096;
constexpr int CW_CNT = 16384;
constexpr int CW_KN = 32768;
constexpr float FOX_T = 30.0f;

__device__ __forceinline__ unsigned cvt_pk_bf16(float lo, float hi) { unsigned r; asm volatile("v_cvt_pk_bf16_f32 %0, %1, %2" : "=v"(r) : "v"(lo), "v"(hi)); return r; }
__device__ __forceinline__ float bf_lo(unsigned w) { return __uint_as_float(w << 16); }
__device__ __forceinline__ float bf_hi(unsigned w) { return __uint_as_float(w & 0xffff0000u); }
__device__ __forceinline__ float bf2f(bf16_t b) { return __uint_as_float(((unsigned)b) << 16); }
__device__ __forceinline__ float sigmoidf_(float x) { return 1.0f / (1.0f + __expf(-x)); }
__device__ __forceinline__ float siluf_(float x) { return x / (1.0f + __expf(-x)); }
__device__ __forceinline__ float wave_sum(float v) {
#pragma unroll
    for (int o = 1; o < 64; o <<= 1) v += __shfl_xor(v, o);
    return v;
}
#define MFMA16(a, b, c) __builtin_amdgcn_mfma_f32_16x16x32_bf16((a), (b), (c), 0, 0, 0)
#define LDS_WAIT() asm volatile("s_waitcnt lgkmcnt(0)" ::: "memory")
#define VM_WAIT() asm volatile("s_waitcnt vmcnt(0)" ::: "memory")
__device__ __forceinline__ unsigned off_b(unsigned row, unsigned ch) { return 256u * row + 16u * (ch ^ (((row & 3u) << 2) | ((row >> 2) & 3u))); }
__device__ __forceinline__ s16x4 tr_read(unsigned addr) { s16x4 r; asm volatile("ds_read_b64_tr_b16 %0, %1" : "=v"(r) : "v"(addr) : "memory"); return r; }
__device__ __forceinline__ bf16x8 cat8(s16x4 a, s16x4 b) { return __builtin_shufflevector(a, b, 0, 1, 2, 3, 4, 5, 6, 7); }

#define XB_TMO      128
#define XB_XCNT(j)  (256  + 64 * (j))
#define XB_XSUB(j)  (1280 + 64 * (j))
#define XB_XGEN(j)  (2304 + 64 * (j))
#define XB_TOP      3328
#define XB_TOPGEN   3392
#define XCD_BAR_WORDS 3456
#define XB_SPIN_CAP (1u << 22)
__device__ __forceinline__ unsigned xb_ld(unsigned* p)              { return __hip_atomic_load(p, __ATOMIC_RELAXED, __HIP_MEMORY_SCOPE_AGENT); }
__device__ __forceinline__ unsigned xb_add(unsigned* p, unsigned v) { return __hip_atomic_fetch_add(p, v, __ATOMIC_RELAXED, __HIP_MEMORY_SCOPE_AGENT); }
__device__ __forceinline__ unsigned xb_xcc_id() { return (unsigned)__builtin_amdgcn_s_getreg((3 << 11) | 20) & 0xFu; }
#define XB_SPIN(cond, bar) do { unsigned _sp = 0; while (cond) { __builtin_amdgcn_s_sleep(1); \
    if ((++_sp & 255u) == 0u) { if (xb_ld(&(bar)[XB_TMO])) break; if (_sp > XB_SPIN_CAP) { atomicAdd(&(bar)[XB_TMO], 1u); break; } } } } while (0)
struct XcdBarrier { unsigned* bar; unsigned x; volatile LAS unsigned* st; };
__device__ __forceinline__ XcdBarrier xcd_barrier_post(unsigned* bar, volatile LAS unsigned* st) {
    XcdBarrier b; b.bar = bar; b.x = xb_xcc_id(); b.st = st;
    if (threadIdx.x == 0) (void)xb_add(&bar[XB_XCNT(b.x)], 1u);
    return b;
}
__device__ __forceinline__ void xcd_barrier_complete(unsigned* bar, unsigned x, unsigned& nloc, unsigned& nx) {
    const unsigned G = gridDim.x * gridDim.y * gridDim.z;
    unsigned sum, cnt, mine, sp = 0u;
    for (;;) {
        sum = 0u; cnt = 0u; mine = 0u;
#pragma unroll
        for (unsigned j = 0; j < 16; ++j) { const unsigned c = xb_ld(&bar[XB_XCNT(j)]); sum += c; cnt += (c > 0u) ? 1u : 0u; mine = (j == x) ? c : mine; }
        if (sum == G) break;
        __builtin_amdgcn_s_sleep(1);
        if ((++sp & 255u) == 0u) { if (xb_ld(&bar[XB_TMO])) break; if (sp > XB_SPIN_CAP) { atomicAdd(&bar[XB_TMO], 1u); break; } }
    }
    nloc = mine > 0u ? mine : 1u; nx = cnt > 0u ? cnt : 1u;
}
__device__ __forceinline__ void xcd_barrier(const XcdBarrier& b) {
    asm volatile("s_waitcnt vmcnt(0)" ::: "memory");
    __syncthreads();
    if (threadIdx.x == 0) {
        unsigned* bar = b.bar;
        __builtin_amdgcn_s_waitcnt(0);
        unsigned nloc = b.st[0], nx = b.st[1];
        if (nloc == 0u) { xcd_barrier_complete(bar, b.x, nloc, nx); b.st[0] = nloc; b.st[1] = nx; }
        const unsigned old = xb_add(&bar[XB_XSUB(b.x)], 1u);
        const unsigned gen = old / nloc;
        if (old + 1u == (gen + 1u) * nloc) {
            __builtin_amdgcn_fence(__ATOMIC_RELEASE, "agent");
            asm volatile("s_waitcnt vmcnt(0)" ::: "memory");
            const unsigned og = xb_add(&bar[XB_TOP], 1u);
            const unsigned tg = og / nx;
            if (og + 1u == (tg + 1u) * nx) xb_add(&bar[XB_TOPGEN], 1u);
            else XB_SPIN(xb_ld(&bar[XB_TOPGEN]) == tg, bar);
            __builtin_amdgcn_fence(__ATOMIC_ACQUIRE, "agent");
            xb_add(&bar[XB_XGEN(b.x)], 1u);
            asm volatile("s_waitcnt vmcnt(0)" ::: "memory");
        } else {
            XB_SPIN(xb_ld(&bar[XB_XGEN(b.x)]) == gen, bar);
            __builtin_amdgcn_fence(__ATOMIC_ACQUIRE, "agent");
            asm volatile("s_waitcnt vmcnt(0)" ::: "memory");
        }
    }
    __syncthreads();
}
namespace pg8 {
constexpr int BM = 256, BK = 64, HALF = 128, HTB = HALF * BK * 2, STAGE_BYTES = 8 * HTB, NXCD = 8, WGM = 8;
__host__ __device__ __forceinline__ int lds_byte(int r, int c) { const int st = (r >> 4) * 2 + (c >> 5), rr = r & 15, cc = c & 31, ob = rr * 64 + cc * 2; return st * 1024 + (ob ^ (((ob >> 9) & 1) << 5)); }
__host__ __device__ __forceinline__ void stage_rc(int b, int& R, int& C) { const int st = b / 1024, sb = b % 1024, swz = sb ^ (((sb >> 9) & 1) << 5); R = (st >> 1) * 16 + swz / 64; C = (st & 1) * 32 + (swz % 64) / 2; }
__host__ __device__ __forceinline__ int perm32(int rho) { const int n = rho >> 4, i = rho & 15; return 8 * (i >> 2) + 4 * n + (i & 3); }

struct Unit { int pm, pn, e, nrows, lbase; };

__device__ __forceinline__ bool enum_unit(int i, int nM, int nN, int G, int c, int& pm, int& pn) {
    const int nwg = nM * nN; const long L = (long)i * G + c; if (L >= nwg) return false;
    int wgid = (int)L; { const int q = nwg / NXCD, r = nwg % NXCD, xcd = wgid % NXCD, off = wgid / NXCD; wgid = (xcd < r ? xcd * (q + 1) : r * (q + 1) + (xcd - r) * q) + off; }
    const int nig = WGM * nN, gid = wgid / nig, fm = gid * WGM, gsz = (nM - fm) < WGM ? (nM - fm) : WGM;
    pm = fm + ((wgid % nig) % gsz); pn = (wgid % nig) / gsz; return true;
}

struct ProbPlain {
    const char* A; const char* Bt; int K, nM, nN, G, c;
    __device__ __forceinline__ bool next(int i, Unit& u) const { u.e = 0; u.nrows = 256; u.lbase = 0; return enum_unit(i, nM, nN, G, c, u.pm, u.pn); }
    __device__ __forceinline__ const char* a_base() const { return A; }
    __device__ __forceinline__ unsigned a_rowoff(const Unit& u, int r) const { return (unsigned)(u.pm * BM + r) * (unsigned)(K * 2); }
    __device__ __forceinline__ const char* b_base(const Unit& u) const { return Bt + (size_t)u.pn * BM * K * 2; }
};
struct ProbMoE {
    const char* A; const char* Bt; int K, nM, nN, G, c; const int* list; const LAS int* tt; const LAS int* cnts; int gather;
    __device__ __forceinline__ bool next(int i, Unit& u) const {
        if (!enum_unit(i, nM, nN, G, c, u.pm, u.pn)) return false;
        const int e = tt[2 * u.pm], ti = tt[2 * u.pm + 1]; u.e = e; const int rem = cnts[e] - ti * BM; u.nrows = rem < BM ? rem : BM; u.lbase = e * LISTCAP + ti * BM; return true;
    }
    __device__ __forceinline__ const char* a_base() const { return A; }
    __device__ __forceinline__ unsigned a_rowoff(const Unit& u, int r) const {
        if (gather) { const int rr = r < u.nrows ? r : u.nrows - 1; const int v = list[u.lbase + rr]; return (unsigned)(v >> 4) * (unsigned)(K * 2); }
        return (unsigned)(u.pm * BM + r) * (unsigned)(K * 2);
    }
    __device__ __forceinline__ const char* b_base(const Unit& u) const { return Bt + ((size_t)u.e * nN + u.pn) * BM * K * 2; }
};

struct EpiBf16 {
    static constexpr bool PERM = true;
    bf16_t* O; int ldc; unsigned* kn; int kn_lo, kn_hi;
    __device__ __forceinline__ void operator()(const f32x4 (&acc)[2][2][4][2], const Unit& u, int wr, int wc, int fr, int fq) const {
        const int row0 = u.pm * BM + wr * 64 + fr, col0 = u.pn * BM + wc * 32 + 8 * fq;
        float kmx[2] = {0.f, 0.f};
#pragma unroll
        for (int ai = 0; ai < 2; ++ai)
#pragma unroll
            for (int m = 0; m < 4; ++m) { bf16_t* rowp = O + (size_t)(row0 + ai * HALF + m * 16) * ldc + col0;
#pragma unroll
                for (int bj = 0; bj < 2; ++bj) { const f32x4 v0 = acc[ai][bj][m][0], v1 = acc[ai][bj][m][1];
                    u32x4 w; w.x = cvt_pk_bf16(v0[0], v0[1]); w.y = cvt_pk_bf16(v0[2], v0[3]); w.z = cvt_pk_bf16(v1[0], v1[1]); w.w = cvt_pk_bf16(v1[2], v1[3]);
                    *(u32x4*)(rowp + bj * HALF) = w;
                    if (kn) { float ss = bf_lo(w.x) * bf_lo(w.x) + bf_hi(w.x) * bf_hi(w.x) + bf_lo(w.y) * bf_lo(w.y) + bf_hi(w.y) * bf_hi(w.y)
                                       + bf_lo(w.z) * bf_lo(w.z) + bf_hi(w.z) * bf_hi(w.z) + bf_lo(w.w) * bf_lo(w.w) + bf_hi(w.w) * bf_hi(w.w);
                        ss += __shfl_xor(ss, 16); ss += __shfl_xor(ss, 32); kmx[bj] = fmaxf(kmx[bj], ss); } } }
        if (kn && u.pn >= kn_lo && u.pn < kn_hi) {
#pragma unroll
            for (int bj = 0; bj < 2; ++bj) { float v = kmx[bj];
#pragma unroll
                for (int o = 1; o < 16; o <<= 1) v = fmaxf(v, __shfl_xor(v, o));
                if ((threadIdx.x & 63) == 0) atomicMax(kn + (((u.pm * BM) / SEQ) * 16 + 2 * (u.pn - kn_lo) + bj) * 4 + wc, __float_as_uint(v)); }
        }
    }
};
struct EpiResF32 {
    static constexpr bool PERM = false;
    const float* res; float* out; int ldc; float alpha;
    __device__ __forceinline__ void operator()(const f32x4 (&acc)[2][2][4][2], const Unit& u, int wr, int wc, int fr, int fq) const {
        const int row0 = u.pm * BM + wr * 64 + fr, col0 = u.pn * BM + wc * 32 + 4 * fq;
#pragma unroll
        for (int ai = 0; ai < 2; ++ai)
#pragma unroll
            for (int m = 0; m < 4; ++m) { const size_t off = (size_t)(row0 + ai * HALF + m * 16) * ldc + col0;
#pragma unroll
                for (int bj = 0; bj < 2; ++bj)
#pragma unroll
                    for (int n = 0; n < 2; ++n) { const f32x4 r = *(const f32x4*)(res + off + bj * HALF + n * 16); *(f32x4*)(out + off + bj * HALF + n * 16) = r * alpha + acc[ai][bj][m][n]; }
                asm volatile("" ::: "memory"); }
    }
};
struct EpiSwiGLU {
    static constexpr bool PERM = true;
    bf16_t* H;
    __device__ __forceinline__ void operator()(const f32x4 (&acc)[2][2][4][2], const Unit& u, int wr, int wc, int fr, int fq) const {
        const int row0 = u.pm * BM + wr * 64 + fr, col0 = u.pn * HALF + wc * 32 + 8 * fq;
#pragma unroll
        for (int ai = 0; ai < 2; ++ai)
#pragma unroll
            for (int m = 0; m < 4; ++m) { bf16_t* rowp = H + (size_t)(row0 + ai * HALF + m * 16) * EDIM + col0;
                float h[8];
#pragma unroll
                for (int n = 0; n < 2; ++n)
#pragma unroll
                    for (int j = 0; j < 4; ++j) { const float g = acc[ai][0][m][n][j], up = acc[ai][1][m][n][j]; h[n * 4 + j] = g / (1.0f + __expf(-g)) * up; }
                u32x4 w; w.x = cvt_pk_bf16(h[0], h[1]); w.y = cvt_pk_bf16(h[2], h[3]); w.z = cvt_pk_bf16(h[4], h[5]); w.w = cvt_pk_bf16(h[6], h[7]);
                *(u32x4*)rowp = w; }
    }
};
struct EpiDown {
    static constexpr bool PERM = true;
    bf16_t* Y; const int* list; const float* wts;
    __device__ __forceinline__ void operator()(const f32x4 (&acc)[2][2][4][2], const Unit& u, int wr, int wc, int fr, int fq) const {
        const int col0 = u.pn * BM + wc * 32 + 8 * fq;
#pragma unroll
        for (int ai = 0; ai < 2; ++ai)
#pragma unroll
            for (int m = 0; m < 4; ++m) { const int r = ai * HALF + wr * 64 + m * 16 + fr; const bool ok = r < u.nrows; const int rr = ok ? r : u.nrows - 1;
                const int v = list[u.lbase + rr]; const int tok = v >> 4, slot = v & 15; const float wq = wts[tok * 8 + (slot & 7)]; const float w = slot == 8 ? 1.0f : wq;
                bf16_t* rowp = Y + (size_t)(tok * 9 + slot) * D + col0;
#pragma unroll
                for (int bj = 0; bj < 2; ++bj) { const f32x4 v0 = acc[ai][bj][m][0] * w, v1 = acc[ai][bj][m][1] * w;
                    u32x4 o; o.x = cvt_pk_bf16(v0[0], v0[1]); o.y = cvt_pk_bf16(v0[2], v0[3]); o.z = cvt_pk_bf16(v1[0], v1[1]); o.w = cvt_pk_bf16(v1[2], v1[3]);
                    if (ok) *(u32x4*)(rowp + bj * HALF) = o; } }
    }
};

template <class Prob, class Epi>
__device__ __forceinline__ void gemm_phase(LAS unsigned char* lds, const Prob& P, const Epi& E) {
    const int tid = threadIdx.x, wid = __builtin_amdgcn_readfirstlane(tid >> 6), lane = tid & 63, wr = wid >> 2, wc = wid & 3, fr = lane & 15, fq = lane >> 4;
    const int K = P.K, nt = K / BK;
    int Rst[2]; unsigned Cst2[2], voffB[2];
#pragma unroll
    for (int i = 0; i < 2; ++i) { int R, C; stage_rc(tid * 16 + i * 8192, R, C); const int Rb = Epi::PERM ? ((R & ~31) + perm32(R & 31)) : R;
        Rst[i] = R; Cst2[i] = (unsigned)C * 2u; voffB[i] = (unsigned)(Rb * K + C) * 2u; }
    const size_t kstep = (size_t)(BK * 2);
    const size_t hstep = (size_t)HALF * K * 2;
    const unsigned ldsw = (unsigned)wid * 1024u;
    const int aoff = lds_byte(wr * 64 + fr, fq * 8), boff = lds_byte(wc * 32 + fr, fq * 8);
#define PG8_SA(b, h) (((b) * 2 + (h)) * HTB)
#define PG8_SB(b, h) ((4 + (b) * 2 + (h)) * HTB)
#define PG8_STAGE(bufoff, gbase, voff) do { _Pragma("unroll") for (int _i = 0; _i < 2; ++_i) \
        __builtin_amdgcn_global_load_lds((const unsigned*)((const char*)(gbase) + (voff)[_i]), (LAS unsigned*)(lds + (bufoff) + ldsw + _i * 8192), 16, 0, 0); } while (0)
#define PG8_LDA(dst, b, h) do { _Pragma("unroll") for (int m = 0; m < 4; ++m) _Pragma("unroll") for (int k = 0; k < 2; ++k) dst[m][k] = *(const LAS bf16x8*)(lds + PG8_SA(b, h) + aoff + m * 2048 + k * 1024); } while (0)
#define PG8_LDB(dst, b, h) do { _Pragma("unroll") for (int n = 0; n < 2; ++n) _Pragma("unroll") for (int k = 0; k < 2; ++k) dst[n][k] = *(const LAS bf16x8*)(lds + PG8_SB(b, h) + boff + n * 2048 + k * 1024); } while (0)
#define PG8_MMA(ai, bj, At, Bt) do { __builtin_amdgcn_s_setprio(1); _Pragma("unroll") for (int m = 0; m < 4; ++m) _Pragma("unroll") for (int n = 0; n < 2; ++n) _Pragma("unroll") for (int k = 0; k < 2; ++k) \
        acc[ai][bj][m][n] = __builtin_amdgcn_mfma_f32_16x16x32_bf16(Bt[n][k], At[m][k], acc[ai][bj][m][n], 0, 0, 0); __builtin_amdgcn_s_setprio(0); } while (0)
#define PG8_WAIT_V(n) asm volatile("s_waitcnt vmcnt(" #n ")" ::: "memory")
#define PG8_WAIT_L(n) asm volatile("s_waitcnt lgkmcnt(" #n ")" ::: "memory")
#define PG8_BAR __builtin_amdgcn_s_barrier()
#define PG8_SCHED __builtin_amdgcn_sched_barrier(0)
    Unit cur, nxt; int ui = 0;
    if (!P.next(0, cur)) return;
    f32x4 acc[2][2][4][2];
#pragma unroll
    for (int a = 0; a < 2; ++a)
#pragma unroll
        for (int b = 0; b < 2; ++b)
#pragma unroll
            for (int m = 0; m < 4; ++m)
#pragma unroll
                for (int n = 0; n < 2; ++n) acc[a][b][m][n] = (f32x4){0.f, 0.f, 0.f, 0.f};
    bf16x8 At[4][2], B0[2][2], B1[2][2];
    const char* aB = P.a_base();
    unsigned voAc[2][2], voAn[2][2];
#pragma unroll
    for (int h = 0; h < 2; ++h)
#pragma unroll
        for (int i = 0; i < 2; ++i) voAc[h][i] = P.a_rowoff(cur, h * HALF + Rst[i]) + Cst2[i];
    const char* cB = P.b_base(cur);
    PG8_STAGE(PG8_SB(0, 0), cB, voffB); PG8_STAGE(PG8_SB(0, 1), cB + hstep, voffB); PG8_STAGE(PG8_SA(0, 0), aB, voAc[0]); PG8_STAGE(PG8_SA(0, 1), aB, voAc[1]);
    if (wr == 1) PG8_BAR;
    PG8_WAIT_V(2); PG8_BAR;
    PG8_STAGE(PG8_SB(1, 0), cB + kstep, voffB); PG8_STAGE(PG8_SA(1, 0), aB + kstep, voAc[0]); PG8_STAGE(PG8_SB(1, 1), cB + hstep + kstep, voffB);
    PG8_WAIT_V(6); PG8_BAR;
    for (;;) {
        const bool has_next = P.next(ui + 1, nxt);
        const char* nB = cB;
#pragma unroll
        for (int h = 0; h < 2; ++h)
#pragma unroll
            for (int i = 0; i < 2; ++i) voAn[h][i] = voAc[h][i];
        if (has_next) { nB = P.b_base(nxt);
#pragma unroll
            for (int h = 0; h < 2; ++h)
#pragma unroll
                for (int i = 0; i < 2; ++i) voAn[h][i] = P.a_rowoff(nxt, h * HALF + Rst[i]) + Cst2[i]; }
        for (int t = 0; t < nt; t += 2) {
            const bool last = (t == nt - 2);
            const char* a1 = aB + (size_t)(t + 1) * kstep;
            const char* a2 = last ? aB : aB + (size_t)(t + 2) * kstep; const char* b2 = last ? nB : cB + (size_t)(t + 2) * kstep;
            const char* a3 = a2 + kstep; const char* b3 = b2 + kstep;
            unsigned vo2[2][2];
#pragma unroll
            for (int h = 0; h < 2; ++h)
#pragma unroll
                for (int i = 0; i < 2; ++i) vo2[h][i] = last ? voAn[h][i] : voAc[h][i];
            PG8_LDB(B0, 0, 0); PG8_LDB(B1, 0, 1); PG8_SCHED; PG8_LDA(At, 0, 0); PG8_STAGE(PG8_SA(1, 1), a1, voAc[1]);
            PG8_WAIT_V(8); PG8_WAIT_L(0); PG8_BAR; PG8_MMA(0, 0, At, B0); PG8_MMA(0, 1, At, B1); PG8_BAR; PG8_SCHED;
            PG8_LDA(At, 0, 1); PG8_STAGE(PG8_SB(0, 0), b2, voffB); PG8_STAGE(PG8_SB(0, 1), b2 + hstep, voffB); PG8_STAGE(PG8_SA(0, 0), a2, vo2[0]);
            PG8_WAIT_V(8); PG8_WAIT_L(0); PG8_BAR; PG8_MMA(1, 0, At, B0); PG8_MMA(1, 1, At, B1); PG8_BAR; PG8_SCHED;
            PG8_LDB(B0, 1, 0); PG8_LDB(B1, 1, 1); PG8_SCHED; PG8_LDA(At, 1, 0); PG8_STAGE(PG8_SA(0, 1), a2, vo2[1]);
            PG8_WAIT_V(8); PG8_WAIT_L(0); PG8_BAR; PG8_MMA(0, 0, At, B0); PG8_MMA(0, 1, At, B1); PG8_BAR; PG8_SCHED;
            PG8_LDA(At, 1, 1); PG8_STAGE(PG8_SB(1, 0), b3, voffB); PG8_STAGE(PG8_SB(1, 1), b3 + hstep, voffB); PG8_STAGE(PG8_SA(1, 0), a3, vo2[0]);
            PG8_WAIT_V(8); PG8_WAIT_L(0); PG8_BAR; PG8_MMA(1, 0, At, B0); PG8_MMA(1, 1, At, B1); PG8_BAR; PG8_SCHED;
        }
        if (wr == 0) PG8_BAR;
        E(acc, cur, wr, wc, fr, fq);
        if (!has_next) break;
#pragma unroll
        for (int a = 0; a < 2; ++a)
#pragma unroll
            for (int b = 0; b < 2; ++b)
#pragma unroll
                for (int m = 0; m < 4; ++m)
#pragma unroll
                    for (int n = 0; n < 2; ++n) acc[a][b][m][n] = (f32x4){0.f, 0.f, 0.f, 0.f};
        cur = nxt; cB = nB; ++ui;
#pragma unroll
        for (int h = 0; h < 2; ++h)
#pragma unroll
            for (int i = 0; i < 2; ++i) voAc[h][i] = voAn[h][i];
        if (wr == 1) PG8_BAR;
    }
    PG8_WAIT_V(0);
    PG8_BAR;
#undef PG8_SA
#undef PG8_SB
#undef PG8_STAGE
#undef PG8_LDA
#undef PG8_LDB
#undef PG8_MMA
#undef PG8_WAIT_V
#undef PG8_WAIT_L
#undef PG8_BAR
#undef PG8_SCHED
}
}
constexpr int LDS_BYTES = 147456;
constexpr int LDS_MISC = 143360;
constexpr int LDS_TT = 131072;
struct Frame {
    LAS unsigned char* lds; int tid, lane, wave, G, bid;
    const float* const* in; float* out; unsigned char* ws;
};

__device__ __forceinline__ void p0_transpose_item(const float* W, int ldw, int K, int k0, int n0, bf16_t* WT, int dest_row0, LAS float* scr, int lane) {
#pragma unroll 8
    for (int i = 0; i < 32; ++i) { const int kk = 2 * i + (lane >> 5); scr[kk * 33 + (lane & 31)] = W[(size_t)(k0 + kk) * ldw + n0 + (lane & 31)]; }
    LDS_WAIT(); asm volatile("" ::: "memory");
    const int c = lane & 7;
#pragma unroll
    for (int j = 0; j < 4; ++j) { const int n = (lane >> 3) + 8 * j; const LAS float* s = scr + (8 * c) * 33 + n;
        u32x4 o; o.x = cvt_pk_bf16(s[0 * 33], s[1 * 33]); o.y = cvt_pk_bf16(s[2 * 33], s[3 * 33]); o.z = cvt_pk_bf16(s[4 * 33], s[5 * 33]); o.w = cvt_pk_bf16(s[6 * 33], s[7 * 33]);
        *(u32x4*)(WT + (size_t)(dest_row0 + n) * K + k0 + 8 * c) = o; }
    LDS_WAIT(); asm volatile("" ::: "memory");
}
__device__ __forceinline__ void p0_matrix_item(const float* W, int ldw, int K, int N, bf16_t* WT, int item, LAS float* scr, int lane) {
    const int nblk = N / 32, kb = item / nblk, nb = item % nblk;
    p0_transpose_item(W, ldw, K, 64 * kb, 32 * nb, WT, 32 * nb, scr, lane);
}
__device__ __forceinline__ void p0_expert_item(const Frame& F, int layer, int item, LAS float* scr, int lane) {
    const int e = item / 1536, r = item % 1536, which = r / 512, it = r % 512;
    bf16_t* WGU = (bf16_t*)(F.ws + WS_WGU) + (size_t)e * 1024 * D; bf16_t* WDt = (bf16_t*)(F.ws + WS_WD) + (size_t)e * D * EDIM;
    if (which < 2) {
        const float* W = e < NE ? F.in[15 + which] + ((size_t)layer * NE + e) * D * EDIM : F.in[18 + which] + (size_t)layer * D * EDIM;
        const int kb = it / 16, nb = it % 16, n0 = 32 * nb;
        const int dest = (n0 >> 7) * 256 + which * 128 + (n0 & 127);
        p0_transpose_item(W, EDIM, D, 64 * kb, n0, WGU, dest, scr, lane);
    } else {
        const float* W = e < NE ? F.in[17] + ((size_t)layer * NE + e) * EDIM * D : F.in[20] + (size_t)layer * EDIM * D;
        const int kb = it / 64, nb = it % 64;
        p0_transpose_item(W, D, EDIM, 64 * kb, 32 * nb, WDt, 32 * nb, scr, lane);
    }
}
__device__ __forceinline__ int t5_bucket(int dist) {
    if (dist < 16) return dist;
    const double v = log((double)dist / 16.0) / log(2048.0 / 16.0) * 16.0;
    int b = 16 + (int)v; return b > 31 ? 31 : b;
}
__device__ __forceinline__ void phase_prologue(const Frame& F) {
    LAS float* scr = (LAS float*)(F.lds + F.wave * 16384);
    const int gw = F.bid * NWAVES + F.wave, NGW = F.G * NWAVES, lane = F.lane;
    constexpr int I0 = (D / 64) * (IN0W / 32), I1 = (D / 64) * (D / 32), I2 = (D / 64) * (IN1W / 32), I3 = I1, I4 = NEX * 1536;
    for (int it = gw; it < I0 + I1 + I2 + I3 + I4; it += NGW) {
        int r = it;
        if (r < I0) { p0_matrix_item(F.in[3], IN0W, D, IN0W, (bf16_t*)(F.ws + WS_WIN0), r, scr, lane); continue; } r -= I0;
        if (r < I1) { p0_matrix_item(F.in[5], D, D, D, (bf16_t*)(F.ws + WS_WOUT0), r, scr, lane); continue; } r -= I1;
        if (r < I2) { p0_matrix_item(F.in[6], IN1FULL, D, IN1W, (bf16_t*)(F.ws + WS_WIN1), r, scr, lane); continue; } r -= I2;
        if (r < I3) { p0_matrix_item(F.in[8], D, D, D, (bf16_t*)(F.ws + WS_WOUT1), r, scr, lane); continue; } r -= I3;
        p0_expert_item(F, 0, r, scr, lane);
    }
    { const size_t gt = (size_t)F.bid * NTHREADS + F.tid, GT = (size_t)F.G * NTHREADS; const float* x = F.in[0]; bf16_t* xa = (bf16_t*)(F.ws + WS_XA);
      for (size_t i = gt; i < (size_t)NTOK * D / 8; i += GT) { const f32x4 a = *(const f32x4*)(x + i * 8), b = *(const f32x4*)(x + i * 8 + 4);
          u32x4 w; w.x = cvt_pk_bf16(a[0], a[1]); w.y = cvt_pk_bf16(a[2], a[3]); w.z = cvt_pk_bf16(b[0], b[1]); w.w = cvt_pk_bf16(b[2], b[3]); *(u32x4*)(xa + i * 8) = w; } }
    { const int gt = F.bid * NTHREADS + F.tid, GT = F.G * NTHREADS;
      bf16_t* rt = (bf16_t*)(F.ws + WS_RT);
      for (int i = gt; i < 2 * 64 * D; i += GT) { const int layer = i / (64 * D), e = (i / D) % 64, k = i % D; const float w = F.in[13][((size_t)layer * D + k) * 64 + e];
          const unsigned hi = cvt_pk_bf16(w, 0.f) & 0xffffu; const float lo = w - __uint_as_float(hi << 16);
          rt[((size_t)(layer * 2 + 0) * 64 + e) * D + k] = (bf16_t)hi; rt[((size_t)(layer * 2 + 1) * 64 + e) * D + k] = (bf16_t)(cvt_pk_bf16(lo, 0.f) & 0xffffu); }
      bf16_t* fh = (bf16_t*)(F.ws + WS_FGHI); bf16_t* fl = (bf16_t*)(F.ws + WS_FGLO);
      for (int i = gt; i < 16 * D; i += GT) { const int j = i / D, k = i % D; const float w = F.in[6][(size_t)k * IN1FULL + IN1W + j];
          const unsigned hi = cvt_pk_bf16(w, 0.f) & 0xffffu; const float lo = w - __uint_as_float(hi << 16);
          fh[(size_t)j * D + k] = (bf16_t)hi; fl[(size_t)j * D + k] = (bf16_t)(cvt_pk_bf16(lo, 0.f) & 0xffffu); }
      float* lb = (float*)(F.ws + WS_LB);
      for (int i = gt; i < 1024; i += GT) { const float a = F.in[2][i], b = F.in[2][1024 + i], c = F.in[2][2048 + i]; const float m = fmaxf(a, fmaxf(b, c));
          const float ea = expf(a - m), eb = expf(b - m), ec = expf(c - m); lb[i] = ea / (ea + eb + ec); }
      float* br = (float*)(F.ws + WS_BIASREL);
      for (int i = gt; i < 3 * 8 * 132; i += GT) { const int b3 = i / (8 * 132), h = (i / 132) % 8, rel = i % 132; const int dil = b3 == 0 ? 1 : (b3 == 1 ? 4 : 16);
          br[i] = rel <= 128 ? F.in[1][t5_bucket(rel * dil) * 8 + h] : 0.f; } }
}
__device__ __forceinline__ void phase_convert_l1(const Frame& F) {
    LAS float* scr = (LAS float*)(F.lds + F.wave * 16384);
    const int gw = F.bid * NWAVES + F.wave, NGW = F.G * NWAVES, lane = F.lane;
    if (gw < 64) { const int b = gw >> 4, h = gw & 15; const float* fl = (const float*)(F.ws + WS_FLOG); float* cc = (float*)(F.ws + WS_CC) + (size_t)gw * SEQ; const float bf = F.in[7][h];
        float run = 0.f;
        for (int blk = 0; blk < SEQ / 64; ++blk) { const int t = blk * 64 + lane; const float z = fl[((size_t)b * SEQ + t) * 16 + h] + bf;
            float v = fminf(z, 0.f) - log1pf(__expf(-fabsf(z)));
#pragma unroll
            for (int o = 1; o < 64; o <<= 1) { const float u = __shfl_up(v, o); if (lane >= o) v += u; }
            cc[t] = run + v; run += __shfl(v, 63); } }
    for (int it = gw; it < NEX * 1536; it += NGW) p0_expert_item(F, 1, it, scr, lane);
}
struct RowArgs {
    const float* vin; const bf16_t* Y; const float* gam; const float* bet; float* xo; bf16_t* xob;
    const bf16_t* whi; const bf16_t* wlo; const float* rbias; unsigned* cnt; int* lists; float* wts; float* flog;
};
template <int MODE, int NT>
__device__ __forceinline__ void phase_rows(const Frame& F, const RowArgs& a) {
    const int lane = F.lane, wave = F.wave, fr = lane & 15, fq = lane >> 4;
    LAS float* xch = (LAS float*)(F.lds);
    LAS float* scb = (LAS float*)(F.lds + 16384);
    for (int base = F.bid * 4; base < NTOK / 16; base += F.G * 4) {
        for (int i = 0; i < 8; ++i) {
            const int tok = (base + (wave >> 1)) * 16 + (wave & 1) * 8 + i;
            f32x4 v[8];
            const f32x4* src = (const f32x4*)(a.vin + (size_t)tok * D) + lane;
#pragma unroll
            for (int j = 0; j < 8; ++j) v[j] = src[64 * j];
            if (MODE == 1) {
#pragma unroll
                for (int j = 0; j < 8; ++j) v[j] = v[j] * DN_ALPHA;
#pragma unroll
                for (int s = 0; s < 9; ++s) { const u32x2* ys = (const u32x2*)(a.Y + ((size_t)tok * 9 + s) * D) + lane;
#pragma unroll
                    for (int j = 0; j < 8; ++j) { const u32x2 w = ys[64 * j]; v[j][0] += bf_lo(w.x); v[j][1] += bf_hi(w.x); v[j][2] += bf_lo(w.y); v[j][3] += bf_hi(w.y); } }
            }
            float s1 = 0.f;
#pragma unroll
            for (int j = 0; j < 8; ++j) s1 += (v[j][0] + v[j][1]) + (v[j][2] + v[j][3]);
            const float mean = wave_sum(s1) * (1.0f / D); float s2 = 0.f;
#pragma unroll
            for (int j = 0; j < 8; ++j) { v[j] = v[j] - mean; s2 += (v[j][0] * v[j][0] + v[j][1] * v[j][1]) + (v[j][2] * v[j][2] + v[j][3] * v[j][3]); }
            const float rstd = 1.0f / sqrtf(wave_sum(s2) * (1.0f / D) + LN_EPS);
            f32x4* dst = (f32x4*)(a.xo + (size_t)tok * D) + lane; u32x2* dstb = (u32x2*)(a.xob + (size_t)tok * D) + lane;
#pragma unroll
            for (int j = 0; j < 8; ++j) { const f32x4 g = *((const f32x4*)a.gam + lane + 64 * j), b = *((const f32x4*)a.bet + lane + 64 * j);
                const f32x4 o = v[j] * rstd * g + b; dst[64 * j] = o; u32x2 w; w.x = cvt_pk_bf16(o[0], o[1]); w.y = cvt_pk_bf16(o[2], o[3]); dstb[64 * j] = w; }
        }
        if (NT == 0) continue;
        VM_WAIT(); __syncthreads();
        const int task = base + (wave & 3), kh = wave >> 2;
        f32x4 acc[NT > 0 ? NT : 1];
#pragma unroll
        for (int n = 0; n < NT; ++n) acc[n] = (f32x4){0.f, 0.f, 0.f, 0.f};
        const float* xr = a.xo + (size_t)(task * 16 + fr) * D + 8 * fq;
#pragma unroll 4
        for (int kb = kh * 32; kb < kh * 32 + 32; ++kb) {
            const f32x4 x0 = *(const f32x4*)(xr + 32 * kb), x1 = *(const f32x4*)(xr + 32 * kb + 4);
            u32x4 hi; hi.x = cvt_pk_bf16(x0[0], x0[1]); hi.y = cvt_pk_bf16(x0[2], x0[3]); hi.z = cvt_pk_bf16(x1[0], x1[1]); hi.w = cvt_pk_bf16(x1[2], x1[3]);
            u32x4 lo; lo.x = cvt_pk_bf16(x0[0] - bf_lo(hi.x), x0[1] - bf_hi(hi.x)); lo.y = cvt_pk_bf16(x0[2] - bf_lo(hi.y), x0[3] - bf_hi(hi.y));
            lo.z = cvt_pk_bf16(x1[0] - bf_lo(hi.z), x1[1] - bf_hi(hi.z)); lo.w = cvt_pk_bf16(x1[2] - bf_lo(hi.w), x1[3] - bf_hi(hi.w));
            const bf16x8 ah = __builtin_bit_cast(bf16x8, hi), al = __builtin_bit_cast(bf16x8, lo);
#pragma unroll
            for (int n = 0; n < NT; ++n) { const size_t wo = (size_t)(16 * n + fr) * D + 32 * kb + 8 * fq;
                const bf16x8 bh = *(const bf16x8*)(a.whi + wo), bl = *(const bf16x8*)(a.wlo + wo);
                acc[n] = MFMA16(ah, bh, acc[n]); acc[n] = MFMA16(al, bh, acc[n]); acc[n] = MFMA16(ah, bl, acc[n]); }
        }
        if (kh == 1) {
#pragma unroll
            for (int n = 0; n < NT; ++n) *(LAS f32x4*)(xch + (((wave & 3) * 4 + n) * 64 + lane) * 4) = acc[n];
        }
        __syncthreads();
        if (kh == 0) {
#pragma unroll
            for (int n = 0; n < NT; ++n) acc[n] = acc[n] + *(const LAS f32x4*)(xch + (((wave & 3) * 4 + n) * 64 + lane) * 4);
            if (NT == 1) {
#pragma unroll
                for (int r = 0; r < 4; ++r) a.flog[(size_t)(task * 16 + 4 * fq + r) * 16 + fr] = acc[0][r];
            } else {
                LAS float* sc = scb + (wave & 3) * (2 * 16 * 68); LAS float* sl = sc + 16 * 68;
#pragma unroll
                for (int n = 0; n < NT; ++n)
#pragma unroll
                    for (int r = 0; r < 4; ++r) { const int e = 16 * n + fr; const float s = 1.0f / (1.0f + expf(-acc[n][r])); sc[(4 * fq + r) * 68 + e] = s; sl[(4 * fq + r) * 68 + e] = s + a.rbias[e]; }
                LDS_WAIT(); asm volatile("" ::: "memory");
                if (lane < 16) {
                    const int tok = task * 16 + lane; const LAS float* ms = sc + lane * 68; LAS float* ml = sl + lane * 68;
                    float gs[8];
#pragma unroll
                    for (int g = 0; g < 8; ++g) { float m1 = -3e38f, m2 = -3e38f;
#pragma unroll
                        for (int j = 0; j < 8; ++j) { const float x = ml[8 * g + j]; if (x > m1) { m2 = m1; m1 = x; } else if (x > m2) m2 = x; }
                        gs[g] = m1 + m2; }
                    unsigned gmask = 0u;
#pragma unroll
                    for (int rnd = 0; rnd < 4; ++rnd) { float best = -3e38f; int bi = 0;
#pragma unroll
                        for (int g = 0; g < 8; ++g) { const bool ok = !((gmask >> g) & 1u) && gs[g] > best; best = ok ? gs[g] : best; bi = ok ? g : bi; }
                        gmask |= 1u << bi; }
                    int eid[8]; float ew[8]; float wsum = 0.f;
#pragma unroll
                    for (int rnd = 0; rnd < 8; ++rnd) { float best = -3e38f; int bi = 0;
#pragma unroll 1
                        for (int e = 0; e < 64; ++e) { const float x = ml[e]; const bool ok = ((gmask >> (e >> 3)) & 1u) && x > best; best = ok ? x : best; bi = ok ? e : bi; }
                        eid[rnd] = bi; ew[rnd] = ms[bi]; wsum += ms[bi]; ml[bi] = -3e38f; }
                    const float inv = 2.5f / wsum;
#pragma unroll
                    for (int j = 0; j < 8; ++j) { const unsigned pos = atomicAdd(a.cnt + 64 * eid[j], 1u); a.lists[(size_t)eid[j] * LISTCAP + pos] = tok * 16 + j; a.wts[tok * 8 + j] = ew[j] * inv; }
                    a.lists[(size_t)NE * LISTCAP + tok] = tok * 16 + 8;
                }
            }
        }
        __syncthreads();
    }
}
struct AttnState { float m, l; f32x4 o[8]; };
__device__ __forceinline__ void attn_init(AttnState& st) { st.m = -1e30f; st.l = 0.f;
#pragma unroll
    for (int c = 0; c < 8; ++c) st.o[c] = (f32x4){0.f, 0.f, 0.f, 0.f}; }
__device__ __forceinline__ void attn_scores(const LAS unsigned char* lds, unsigned kb, const bf16x8 (&qf)[4], f32x4 (&s)[4], int fr, int fq) {
#pragma unroll
    for (int kt = 0; kt < 4; ++kt) { s[kt] = (f32x4){0.f, 0.f, 0.f, 0.f};
#pragma unroll
        for (int ks = 0; ks < 4; ++ks) { const bf16x8 kf = *(const LAS bf16x8*)(lds + kb + off_b(16 * kt + fr, 4 * ks + fq)); s[kt] = MFMA16(kf, qf[ks], s[kt]); } }
}
__device__ __forceinline__ void attn_update(unsigned ldsbase, unsigned vb, f32x4 (&s)[4], AttnState& st, int lane) {
    float mx = -1e30f;
#pragma unroll
    for (int kt = 0; kt < 4; ++kt)
#pragma unroll
        for (int r = 0; r < 4; ++r) mx = fmaxf(mx, s[kt][r]);
    mx = fmaxf(mx, __shfl_xor(mx, 16)); mx = fmaxf(mx, __shfl_xor(mx, 32));
    const float mn = fmaxf(st.m, mx), alpha = __expf(st.m - mn);
    float ps = 0.f;
#pragma unroll
    for (int kt = 0; kt < 4; ++kt)
#pragma unroll
        for (int r = 0; r < 4; ++r) { const float p = __expf(s[kt][r] - mn); s[kt][r] = p; ps += p; }
    ps += __shfl_xor(ps, 16); ps += __shfl_xor(ps, 32);
    st.l = st.l * alpha + ps; st.m = mn;
#pragma unroll
    for (int c = 0; c < 8; ++c) st.o[c] = st.o[c] * alpha;
    const unsigned g = lane >> 4, q = (lane & 15) >> 2, p = lane & 3, xm = (q << 2) | g;
#pragma unroll
    for (int ks = 0; ks < 2; ++ks) {
        u32x4 pw; pw.x = cvt_pk_bf16(s[2 * ks][0], s[2 * ks][1]); pw.y = cvt_pk_bf16(s[2 * ks][2], s[2 * ks][3]); pw.z = cvt_pk_bf16(s[2 * ks + 1][0], s[2 * ks + 1][1]); pw.w = cvt_pk_bf16(s[2 * ks + 1][2], s[2 * ks + 1][3]);
        const bf16x8 pf = __builtin_bit_cast(bf16x8, pw);
        s16x4 v0[8], v1[8];
#pragma unroll
        for (int c = 0; c < 8; ++c) {
            const unsigned chunk = ((2u * c + (p >> 1)) ^ xm) * 16u + 8u * (p & 1u);
            v0[c] = tr_read(ldsbase + vb + 256u * (32u * ks + 4u * g + q) + chunk);
            v1[c] = tr_read(ldsbase + vb + 256u * (32u * ks + 16u + 4u * g + q) + chunk); }
        asm volatile("s_waitcnt lgkmcnt(0)" : "+v"(v0[0]), "+v"(v0[1]), "+v"(v0[2]), "+v"(v0[3]), "+v"(v0[4]), "+v"(v0[5]), "+v"(v0[6]), "+v"(v0[7]) :: "memory");
        asm volatile("" : "+v"(v1[0]), "+v"(v1[1]), "+v"(v1[2]), "+v"(v1[3]), "+v"(v1[4]), "+v"(v1[5]), "+v"(v1[6]), "+v"(v1[7]) :: "memory");
#pragma unroll
        for (int c = 0; c < 8; ++c) st.o[c] = MFMA16(cat8(v0[c], v1[c]), pf, st.o[c]);
    }
}
#define STAGE_TILE(ldsoff, nrows, ROWPTR) do { for (int _n = F.tid; _n < (nrows) * 16; _n += NTHREADS) { const int _r = _n >> 4, _ch = _n & 15; \
        const u32x4 _v = *(const u32x4*)((const char*)(ROWPTR(_r)) + _ch * 16); *(LAS u32x4*)(F.lds + (ldsoff) + off_b(_r, _ch)) = _v; } } while (0)

__device__ __forceinline__ void dilated_item(const Frame& F, int item) {
    const int br = item >> 10, r10 = item & 1023; const int dil = br == 0 ? 1 : (br == 1 ? 4 : 16), nb = 32 / dil;
    const int b = r10 >> 8, h = (r10 >> 5) & 7, rn = r10 & 31, res = rn / nb, n = rn % nb;
    const bf16_t* proj = (const bf16_t*)(F.ws + WS_PROJ);
    const int lane = F.lane, wave = F.wave, fr = lane & 15, fq = lane >> 4;
    const unsigned ldsbase = (unsigned)(size_t)F.lds;
    constexpr int KOFF = 0, VOFF = 65536, BOFF = 131072;
    const int kfirst = n == 0 ? 128 : 0;
#define DIL_TOK(ki) ((size_t)b * SEQ + (size_t)(128 * (n - 1) + (ki)) * dil + res)
#define DIL_KROW(ki) (proj + DIL_TOK(ki + kfirst) * IN0W + 1024 + 128 * h)
#define DIL_VROW(ki) (proj + DIL_TOK(ki + kfirst) * IN0W + 2048 + 128 * h)
    __syncthreads();
    STAGE_TILE(KOFF + kfirst * 256, 256 - kfirst, DIL_KROW);
    STAGE_TILE(VOFF + kfirst * 256, 256 - kfirst, DIL_VROW);
    if (F.tid < 132) ((LAS float*)(F.lds + BOFF))[F.tid] = ((const float*)(F.ws + WS_BIASREL))[(br * 8 + h) * 132 + F.tid];
    const int qi = 16 * wave + fr; const size_t qtok = (size_t)b * SEQ + (size_t)(128 * n + qi) * dil + res;
    bf16x8 qf[4];
#pragma unroll
    for (int ks = 0; ks < 4; ++ks) qf[ks] = *(const bf16x8*)(proj + qtok * IN0W + 128 * h + 32 * ks + 8 * fq);
    __syncthreads();
    AttnState st; attn_init(st);
    const LAS float* bt = (const LAS float*)(F.lds + BOFF);
#pragma unroll 1
    for (int j = (n == 0 ? 2 : 0); j < 4; ++j) {
        if (64 * j > 16 * wave + 15 + 128 || 64 * j + 63 < 16 * wave) continue;
        f32x4 s[4];
        attn_scores(F.lds, KOFF + j * 16384, qf, s, fr, fq);
#pragma unroll
        for (int kt = 0; kt < 4; ++kt)
#pragma unroll
            for (int r = 0; r < 4; ++r) { const int ki = 64 * j + 16 * kt + 4 * fq + r, rel = qi + 128 - ki; const bool ok = rel >= 0 && rel <= 128; const int rc = ok ? rel : 0;
                s[kt][r] = ok ? s[kt][r] * ATT_SCALE + bt[rc] : -1e30f; }
        attn_update(ldsbase, VOFF + j * 16384, s, st, lane);
    }
    const float inv = 1.0f / st.l; bf16_t* ob = (bf16_t*)(F.ws + WS_OBR) + ((size_t)br * NTOK + qtok) * 1024 + 128 * h;
#pragma unroll
    for (int c = 0; c < 8; ++c) { u32x2 w; w.x = cvt_pk_bf16(st.o[c][0] * inv, st.o[c][1] * inv); w.y = cvt_pk_bf16(st.o[c][2] * inv, st.o[c][3] * inv); *(u32x2*)(ob + 16 * c + 4 * fq) = w; }
    if (fq == 0) ((float*)(F.ws + WS_LSE))[((size_t)br * NTOK + qtok) * 8 + h] = st.m + __logf(st.l);
#undef DIL_TOK
#undef DIL_KROW
#undef DIL_VROW
}
__device__ __forceinline__ void combine_tokens(const Frame& F) {
    const int gw = F.bid * NWAVES + F.wave, NGW = F.G * NWAVES, lane = F.lane, h = lane >> 3;
    const bf16_t* ob = (const bf16_t*)(F.ws + WS_OBR); const float* lse = (const float*)(F.ws + WS_LSE); bf16_t* a2 = (bf16_t*)(F.ws + WS_A2);
    for (int tok = gw; tok < NTOK; tok += NGW) {
        const float l0 = lse[((size_t)0 * NTOK + tok) * 8 + h], l1 = lse[((size_t)1 * NTOK + tok) * 8 + h], l2 = lse[((size_t)2 * NTOK + tok) * 8 + h];
        const float m = fmaxf(l0, fmaxf(l1, l2)); const float e0 = __expf(l0 - m), e1 = __expf(l1 - m), e2 = __expf(l2 - m), inv = 1.0f / (e0 + e1 + e2);
        const float w[3] = {e0 * inv, e1 * inv, e2 * inv};
        float acc[16];
#pragma unroll
        for (int j = 0; j < 16; ++j) acc[j] = 0.f;
#pragma unroll
        for (int b3 = 0; b3 < 3; ++b3) { const u32x4* p = (const u32x4*)(ob + ((size_t)b3 * NTOK + tok) * 1024 + 16 * lane); const u32x4 x0 = p[0], x1 = p[1];
            acc[0] += w[b3] * bf_lo(x0.x); acc[1] += w[b3] * bf_hi(x0.x); acc[2] += w[b3] * bf_lo(x0.y); acc[3] += w[b3] * bf_hi(x0.y);
            acc[4] += w[b3] * bf_lo(x0.z); acc[5] += w[b3] * bf_hi(x0.z); acc[6] += w[b3] * bf_lo(x0.w); acc[7] += w[b3] * bf_hi(x0.w);
            acc[8] += w[b3] * bf_lo(x1.x); acc[9] += w[b3] * bf_hi(x1.x); acc[10] += w[b3] * bf_lo(x1.y); acc[11] += w[b3] * bf_hi(x1.y);
            acc[12] += w[b3] * bf_lo(x1.z); acc[13] += w[b3] * bf_hi(x1.z); acc[14] += w[b3] * bf_lo(x1.w); acc[15] += w[b3] * bf_hi(x1.w); }
        u32x4 o0, o1; o0.x = cvt_pk_bf16(acc[0], acc[1]); o0.y = cvt_pk_bf16(acc[2], acc[3]); o0.z = cvt_pk_bf16(acc[4], acc[5]); o0.w = cvt_pk_bf16(acc[6], acc[7]);
        o1.x = cvt_pk_bf16(acc[8], acc[9]); o1.y = cvt_pk_bf16(acc[10], acc[11]); o1.z = cvt_pk_bf16(acc[12], acc[13]); o1.w = cvt_pk_bf16(acc[14], acc[15]);
        u32x4* d = (u32x4*)(a2 + (size_t)tok * D + 16 * lane); d[0] = o0; d[1] = o1;
    }
}
__device__ __forceinline__ void fox_item(const Frame& F, int item) {
    const int rnd = item >> 8, cc = item & 255, bh = cc & 63, g4 = cc >> 6; const int qb = 31 - (4 * rnd + ((rnd & 1) ? 3 - g4 : g4));
    const int b = bh >> 4, h = bh & 15;
    const bf16_t* proj = (const bf16_t*)(F.ws + WS_PROJ); const float* cbase = (const float*)(F.ws + WS_CC) + (size_t)bh * SEQ;
    const int lane = F.lane, wave = F.wave, fr = lane & 15, fq = lane >> 4;
    const unsigned ldsbase = (unsigned)(size_t)F.lds;
    constexpr int BUFB = 33792;
    const int qrow = 128 * qb + 16 * wave + fr; const size_t qtok = (size_t)b * SEQ + qrow;
    bf16x8 qf[4];
#pragma unroll
    for (int ks = 0; ks < 4; ++ks) qf[ks] = *(const bf16x8*)(proj + qtok * IN1W + 128 * h + 32 * ks + 8 * fq);
    const float cq = cbase[qrow];
    const int j0 = 2 * qb + 1;
    float qk;
    { const unsigned* kn = (const unsigned*)(F.ws + WS_CTL) + CW_KN + bh * 4; const float kmax = sqrtf(__uint_as_float(kn[0]) + __uint_as_float(kn[1]) + __uint_as_float(kn[2]) + __uint_as_float(kn[3]));
      float qs = 0.f;
#pragma unroll
      for (int ks = 0; ks < 4; ++ks) { const u32x4 w = __builtin_bit_cast(u32x4, qf[ks]);
          qs += bf_lo(w.x) * bf_lo(w.x) + bf_hi(w.x) * bf_hi(w.x) + bf_lo(w.y) * bf_lo(w.y) + bf_hi(w.y) * bf_hi(w.y) + bf_lo(w.z) * bf_lo(w.z) + bf_hi(w.z) * bf_hi(w.z) + bf_lo(w.w) * bf_lo(w.w) + bf_hi(w.w) * bf_hi(w.w); }
      qs += __shfl_xor(qs, 16); qs += __shfl_xor(qs, 32); qk = sqrtf(qs) * kmax * ATT_SCALE; }
    LAS unsigned* pflag = (LAS unsigned*)(F.lds + 2 * BUFB);
    const int sr0 = F.tid >> 4, sch = F.tid & 15;
    u32x4 rk0, rk1, rv0, rv1; float rc = 0.f;
#define FOX_LOAD(j) do { const bf16_t* _p0 = proj + ((size_t)b * SEQ + 64 * (j) + sr0) * IN1W + 128 * h + 8 * sch; const bf16_t* _p1 = _p0 + (size_t)32 * IN1W; \
        rk0 = *(const u32x4*)(_p0 + 2048); rk1 = *(const u32x4*)(_p1 + 2048); rv0 = *(const u32x4*)(_p0 + 4096); rv1 = *(const u32x4*)(_p1 + 4096); if (F.tid < 64) rc = cbase[64 * (j) + F.tid]; } while (0)
#define FOX_WRITE(bufo) do { *(LAS u32x4*)(F.lds + (bufo) + off_b(sr0, sch)) = rk0; *(LAS u32x4*)(F.lds + (bufo) + off_b(sr0 + 32, sch)) = rk1; \
        *(LAS u32x4*)(F.lds + (bufo) + 16384 + off_b(sr0, sch)) = rv0; *(LAS u32x4*)(F.lds + (bufo) + 16384 + off_b(sr0 + 32, sch)) = rv1; if (F.tid < 64) ((LAS float*)(F.lds + (bufo) + 32768))[F.tid] = rc; } while (0)
    __syncthreads();
    FOX_LOAD(j0); FOX_WRITE(0);
    __syncthreads();
    AttnState st; attn_init(st);
    int cur = 0;
#pragma unroll 1
    for (int j = j0; j >= 0; --j) {
        if (j > 0) FOX_LOAD(j - 1);
        const int bufo = cur * BUFB;
        if (64 * j <= 128 * qb + 16 * wave + 15) {
            f32x4 s[4];
            attn_scores(F.lds, bufo, qf, s, fr, fq);
            const LAS float* ck = (const LAS float*)(F.lds + bufo + 32768);
#pragma unroll
            for (int kt = 0; kt < 4; ++kt) { const f32x4 c4 = *(const LAS f32x4*)(ck + 16 * kt + 4 * fq);
#pragma unroll
                for (int r = 0; r < 4; ++r) { const int key = 64 * j + 16 * kt + 4 * fq + r; s[kt][r] = key <= qrow ? s[kt][r] * ATT_SCALE + (cq - c4[r]) : -1e30f; } }
            attn_update(ldsbase, bufo + 16384, s, st, lane);
        }
        if (j > 0) { const float cend = cbase[64 * j - 1];
            const bool need = qk + (cq - cend) - st.m >= -FOX_T;
            const bool anyneed = __any(need);
            if (lane == 0) pflag[cur * 8 + wave] = anyneed ? 1u : 0u;
            FOX_WRITE((cur ^ 1) * BUFB); }
        __syncthreads();
        if (j > 0) { const u32x4 f0 = *(const LAS u32x4*)(pflag + cur * 8), f1 = *(const LAS u32x4*)(pflag + cur * 8 + 4);
            if ((f0.x | f0.y | f0.z | f0.w | f1.x | f1.y | f1.z | f1.w) == 0u) break; }
        cur ^= 1;
    }
    const float inv = 1.0f / st.l; bf16_t* ob = (bf16_t*)(F.ws + WS_A2) + qtok * D + 128 * h;
#pragma unroll
    for (int c = 0; c < 8; ++c) { u32x2 w; w.x = cvt_pk_bf16(st.o[c][0] * inv, st.o[c][1] * inv); w.y = cvt_pk_bf16(st.o[c][2] * inv, st.o[c][3] * inv); *(u32x2*)(ob + 16 * c + 4 * fq) = w; }
#undef FOX_LOAD
#undef FOX_WRITE
}
#define HG_PART_OFF 122880
#define HGRN_FRONT(PROJ, T0, H) \
    const int k_ = F.tid & 127, tq_ = F.tid >> 7; const float lbk_ = ((const float*)(F.ws + WS_LB))[128 * (H) + k_]; \
    float a16[16], key16[16]; { float run_ = 0.f; \
    _Pragma("unroll") for (int i = 0; i < 16; ++i) { const float fl_ = bf2f((PROJ)[(size_t)((T0) + 16 * tq_ + i) * IN0W + 4096 + 128 * (H) + k_]); \
        const float fo_ = lbk_ + (1.0f - lbk_) * sigmoidf_(fl_); run_ += __logf(fo_); a16[i] = run_; key16[i] = 1.0f - fo_; } \
    ((LAS float*)(F.lds + HG_PART_OFF))[tq_ * 128 + k_] = run_; } \
    __syncthreads(); \
    float aoff_ = 0.f, atot_ = 0.f; \
    _Pragma("unroll") for (int q = 0; q < 4; ++q) { const float p_ = ((const LAS float*)(F.lds + HG_PART_OFF))[q * 128 + k_]; atot_ += p_; aoff_ += q < tq_ ? p_ : 0.f; } \
    _Pragma("unroll") for (int i = 0; i < 16; ++i) a16[i] += aoff_;

__device__ __forceinline__ void hgrn_a_item(const Frame& F, int it) {
    const int bh = it >> 6, c = it & 63, b = bh >> 3, h = bh & 7, t0 = b * SEQ + 64 * c;
    const bf16_t* proj = (const bf16_t*)(F.ws + WS_PROJ);
    const int lane = F.lane, wave = F.wave, fr = lane & 15, fq = lane >> 4;
    const unsigned ldsbase = (unsigned)(size_t)F.lds;
    constexpr int KD_OFF = 0, VAL_OFF = 20480;
    __syncthreads();
    HGRN_FRONT(proj, t0, h)
    {
        u32x4 w0, w1; float kd[16];
#pragma unroll
        for (int i = 0; i < 16; ++i) kd[i] = key16[i] * __expf(atot_ - a16[i]);
        w0.x = cvt_pk_bf16(kd[0], kd[1]); w0.y = cvt_pk_bf16(kd[2], kd[3]); w0.z = cvt_pk_bf16(kd[4], kd[5]); w0.w = cvt_pk_bf16(kd[6], kd[7]);
        w1.x = cvt_pk_bf16(kd[8], kd[9]); w1.y = cvt_pk_bf16(kd[10], kd[11]); w1.z = cvt_pk_bf16(kd[12], kd[13]); w1.w = cvt_pk_bf16(kd[14], kd[15]);
        *(LAS u32x4*)(F.lds + KD_OFF + k_ * 144 + tq_ * 32) = w0; *(LAS u32x4*)(F.lds + KD_OFF + k_ * 144 + tq_ * 32 + 16) = w1;
        if (tq_ == 0) ((float*)(F.ws + WS_ALAST))[(size_t)it * 128 + k_] = atot_;
    }
#define HG_VROW(r) (proj + (size_t)(t0 + (r)) * IN0W + 5120 + 128 * h)
    STAGE_TILE(VAL_OFF, 64, HG_VROW);
    __syncthreads();
    const unsigned g = lane >> 4, q = (lane & 15) >> 2, p = lane & 3;
    bf16x8 af[2];
    {   s16x4 x0[2], x1[2];
#pragma unroll
        for (int ks = 0; ks < 2; ++ks) { x0[ks] = tr_read(ldsbase + VAL_OFF + off_b(32 * ks + 8 * g + q, 2 * wave + (p >> 1)) + 8 * (p & 1));
            x1[ks] = tr_read(ldsbase + VAL_OFF + off_b(32 * ks + 8 * g + 4 + q, 2 * wave + (p >> 1)) + 8 * (p & 1)); }
        asm volatile("s_waitcnt lgkmcnt(0)" : "+v"(x0[0]), "+v"(x0[1]), "+v"(x1[0]), "+v"(x1[1]) :: "memory");
        af[0] = cat8(x0[0], x1[0]); af[1] = cat8(x0[1], x1[1]); }
    float* lt = (float*)(F.ws + WS_LT) + (size_t)it * 16384;
#pragma unroll
    for (int nt = 0; nt < 8; ++nt) { f32x4 acc = (f32x4){0.f, 0.f, 0.f, 0.f};
#pragma unroll
        for (int ks = 0; ks < 2; ++ks) { const bf16x8 bfr = *(const LAS bf16x8*)(F.lds + KD_OFF + (16 * nt + fr) * 144 + (32 * ks + 8 * fq) * 2); acc = MFMA16(af[ks], bfr, acc); }
#pragma unroll
        for (int r = 0; r < 4; ++r) lt[(size_t)(16 * wave + 4 * fq + r) * 128 + 16 * nt + fr] = acc[r]; }
#undef HG_VROW
}
__device__ __forceinline__ void hgrn_scan(const Frame& F) {
    const int gt = F.bid * NTHREADS + F.tid, GT = F.G * NTHREADS;
    const float* lt = (const float*)(F.ws + WS_LT); const float* al = (const float*)(F.ws + WS_ALAST); bf16_t* st = (bf16_t*)(F.ws + WS_ST);
    for (int e = gt; e < 32 * 128 * 32; e += GT) { const int bh = e >> 12, v = (e >> 5) & 127, k4 = (e & 31) * 4;
        f32x4 s = (f32x4){0.f, 0.f, 0.f, 0.f};
#pragma unroll 4
        for (int c = 0; c < 64; ++c) { const size_t it = (size_t)bh * 64 + c; const size_t o = (it * 128 + v) * 128 + k4;
            u32x2 w; w.x = cvt_pk_bf16(s[0], s[1]); w.y = cvt_pk_bf16(s[2], s[3]); *(u32x2*)(st + o) = w;
            const f32x4 l = *(const f32x4*)(lt + o), a = *(const f32x4*)(al + it * 128 + k4);
            s[0] = __expf(a[0]) * s[0] + l[0]; s[1] = __expf(a[1]) * s[1] + l[1]; s[2] = __expf(a[2]) * s[2] + l[2]; s[3] = __expf(a[3]) * s[3] + l[3]; } }
}
__device__ __forceinline__ void hgrn_c_item(const Frame& F, int it) {
    const int bh = it >> 6, c = it & 63, b = bh >> 3, h = bh & 7, t0 = b * SEQ + 64 * c;
    const bf16_t* proj = (const bf16_t*)(F.ws + WS_PROJ);
    const int lane = F.lane, wave = F.wave, fr = lane & 15, fq = lane >> 4;
    const unsigned ldsbase = (unsigned)(size_t)F.lds;
    constexpr int A_OFF = 0, FQ_OFF = 34816, KEY_OFF = 52224, VAL_OFF = 73728, ST_OFF = 90112, RMS_OFF = 124928;
    __syncthreads();
    HGRN_FRONT(proj, t0, h)
#pragma unroll
    for (int i = 0; i < 16; ++i) { const int t = 16 * tq_ + i; ((LAS float*)(F.lds + A_OFF))[t * 132 + k_] = a16[i];
        const float qv = bf2f(proj[(size_t)(t0 + t) * IN0W + 3072 + 128 * h + k_]);
        ((LAS bf16_t*)(F.lds + FQ_OFF))[t * 136 + k_] = (bf16_t)(cvt_pk_bf16(siluf_(qv), 0.f) & 0xffffu);
        ((LAS bf16_t*)(F.lds + KEY_OFF))[t * 136 + k_] = (bf16_t)(cvt_pk_bf16(key16[i], 0.f) & 0xffffu); }
#define HG_VROW(r) (proj + (size_t)(t0 + (r)) * IN0W + 5120 + 128 * h)
#define HG_SROW(r) ((const bf16_t*)(F.ws + WS_ST) + ((size_t)it * 128 + (r)) * 128)
    STAGE_TILE(VAL_OFF, 64, HG_VROW);
    STAGE_TILE(ST_OFF, 128, HG_SROW);
    __syncthreads();
    const int I = wave & 3, vh = wave >> 2;
    const LAS float* al = (const LAS float*)(F.lds + A_OFF);
    f32x4 o[4];
#pragma unroll
    for (int c4 = 0; c4 < 4; ++c4) o[c4] = (f32x4){0.f, 0.f, 0.f, 0.f};
    bf16x8 qh[4];
#pragma unroll
    for (int ks = 0; ks < 4; ++ks) {
        const int t = 16 * I + fr, k = 32 * ks + 8 * fq;
        const u32x4 fw = *(const LAS u32x4*)(F.lds + FQ_OFF + (t * 136 + k) * 2);
        const f32x4 a0 = *(const LAS f32x4*)(al + t * 132 + k), a1 = *(const LAS f32x4*)(al + t * 132 + k + 4);
        f32x4 r0 = (f32x4){0.f, 0.f, 0.f, 0.f}, r1 = r0;
        if (I > 0) { r0 = *(const LAS f32x4*)(al + (16 * I - 1) * 132 + k); r1 = *(const LAS f32x4*)(al + (16 * I - 1) * 132 + k + 4); }
        const float f0 = bf_lo(fw.x), f1 = bf_hi(fw.x), f2 = bf_lo(fw.y), f3 = bf_hi(fw.y), f4 = bf_lo(fw.z), f5 = bf_hi(fw.z), f6 = bf_lo(fw.w), f7 = bf_hi(fw.w);
        u32x4 qi; qi.x = cvt_pk_bf16(f0 * __expf(a0[0]), f1 * __expf(a0[1])); qi.y = cvt_pk_bf16(f2 * __expf(a0[2]), f3 * __expf(a0[3]));
        qi.z = cvt_pk_bf16(f4 * __expf(a1[0]), f5 * __expf(a1[1])); qi.w = cvt_pk_bf16(f6 * __expf(a1[2]), f7 * __expf(a1[3]));
        u32x4 qr; qr.x = cvt_pk_bf16(f0 * __expf(a0[0] - r0[0]), f1 * __expf(a0[1] - r0[1])); qr.y = cvt_pk_bf16(f2 * __expf(a0[2] - r0[2]), f3 * __expf(a0[3] - r0[3]));
        qr.z = cvt_pk_bf16(f4 * __expf(a1[0] - r1[0]), f5 * __expf(a1[1] - r1[1])); qr.w = cvt_pk_bf16(f6 * __expf(a1[2] - r1[2]), f7 * __expf(a1[3] - r1[3]));
        qh[ks] = __builtin_bit_cast(bf16x8, qr);
        const bf16x8 qib = __builtin_bit_cast(bf16x8, qi);
#pragma unroll
        for (int c4 = 0; c4 < 4; ++c4) { const bf16x8 sf = *(const LAS bf16x8*)(F.lds + ST_OFF + off_b(16 * (4 * vh + c4) + fr, 4 * ks + fq)); o[c4] = MFMA16(sf, qib, o[c4]); }
    }
    f32x4 sc[4];
#pragma unroll
    for (int J = 0; J < 4; ++J) { sc[J] = (f32x4){0.f, 0.f, 0.f, 0.f};
        if (J <= I) {
#pragma unroll
            for (int ks = 0; ks < 4; ++ks) {
                const int s = 16 * J + fr, k = 32 * ks + 8 * fq;
                const u32x4 kw = *(const LAS u32x4*)(F.lds + KEY_OFF + (s * 136 + k) * 2);
                const f32x4 a0 = *(const LAS f32x4*)(al + s * 132 + k), a1 = *(const LAS f32x4*)(al + s * 132 + k + 4);
                f32x4 r0 = (f32x4){0.f, 0.f, 0.f, 0.f}, r1 = r0;
                if (I > 0) { r0 = *(const LAS f32x4*)(al + (16 * I - 1) * 132 + k); r1 = *(const LAS f32x4*)(al + (16 * I - 1) * 132 + k + 4); }
                u32x4 kh; kh.x = cvt_pk_bf16(bf_lo(kw.x) * __expf(r0[0] - a0[0]), bf_hi(kw.x) * __expf(r0[1] - a0[1])); kh.y = cvt_pk_bf16(bf_lo(kw.y) * __expf(r0[2] - a0[2]), bf_hi(kw.y) * __expf(r0[3] - a0[3]));
                kh.z = cvt_pk_bf16(bf_lo(kw.z) * __expf(r1[0] - a1[0]), bf_hi(kw.z) * __expf(r1[1] - a1[1])); kh.w = cvt_pk_bf16(bf_lo(kw.w) * __expf(r1[2] - a1[2]), bf_hi(kw.w) * __expf(r1[3] - a1[3]));
                sc[J] = MFMA16(__builtin_bit_cast(bf16x8, kh), qh[ks], sc[J]);
            }
            if (J == I) {
#pragma unroll
                for (int r = 0; r < 4; ++r) sc[J][r] = (4 * fq + r) <= fr ? sc[J][r] : 0.f;
            }
        }
    }
    const unsigned g = lane >> 4, q = (lane & 15) >> 2, p = lane & 3, xm = (q << 2) | g;
#pragma unroll
    for (int ks = 0; ks < 2; ++ks) {
        if (2 * ks <= I) {
            u32x4 pw; pw.x = cvt_pk_bf16(sc[2 * ks][0], sc[2 * ks][1]); pw.y = cvt_pk_bf16(sc[2 * ks][2], sc[2 * ks][3]); pw.z = cvt_pk_bf16(sc[2 * ks + 1][0], sc[2 * ks + 1][1]); pw.w = cvt_pk_bf16(sc[2 * ks + 1][2], sc[2 * ks + 1][3]);
            const bf16x8 pf = __builtin_bit_cast(bf16x8, pw);
            s16x4 v0[4], v1[4];
#pragma unroll
            for (int c4 = 0; c4 < 4; ++c4) { const unsigned chunk = ((2u * (4 * vh + c4) + (p >> 1)) ^ xm) * 16u + 8u * (p & 1u);
                v0[c4] = tr_read(ldsbase + VAL_OFF + 256u * (32u * ks + 4u * g + q) + chunk);
                v1[c4] = tr_read(ldsbase + VAL_OFF + 256u * (32u * ks + 16u + 4u * g + q) + chunk); }
            asm volatile("s_waitcnt lgkmcnt(0)" : "+v"(v0[0]), "+v"(v0[1]), "+v"(v0[2]), "+v"(v0[3]), "+v"(v1[0]), "+v"(v1[1]), "+v"(v1[2]), "+v"(v1[3]) :: "memory");
#pragma unroll
            for (int c4 = 0; c4 < 4; ++c4) o[c4] = MFMA16(cat8(v0[c4], v1[c4]), pf, o[c4]);
        }
    }
    float ss = 0.f;
#pragma unroll
    for (int c4 = 0; c4 < 4; ++c4)
#pragma unroll
        for (int r = 0; r < 4; ++r) ss += o[c4][r] * o[c4][r];
    ss += __shfl_xor(ss, 16); ss += __shfl_xor(ss, 32);
    if (fq == 0) ((LAS float*)(F.lds + RMS_OFF))[vh * 64 + 16 * I + fr] = ss;
    __syncthreads();
    const float tot = ((const LAS float*)(F.lds + RMS_OFF))[16 * I + fr] + ((const LAS float*)(F.lds + RMS_OFF))[64 + 16 * I + fr];
    const float rstd = 1.0f / sqrtf(tot * (1.0f / 128.0f) + RMS_EPS);
    const size_t tok = (size_t)t0 + 16 * I + fr; const float* gn = F.in[4] + 128 * h; bf16_t* a2 = (bf16_t*)(F.ws + WS_A2) + tok * D + 1024 + 128 * h;
#pragma unroll
    for (int c4 = 0; c4 < 4; ++c4) { const int v = 16 * (4 * vh + c4) + 4 * fq;
        const u32x2 gw = *(const u32x2*)(proj + tok * IN0W + 6144 + 128 * h + v); const f32x4 gg = *(const f32x4*)(gn + v);
        const float g0 = bf_lo(gw.x), g1 = bf_hi(gw.x), g2 = bf_lo(gw.y), g3 = bf_hi(gw.y);
        u32x2 w; w.x = cvt_pk_bf16(o[c4][0] * rstd * gg[0] * siluf_(g0), o[c4][1] * rstd * gg[1] * siluf_(g1)); w.y = cvt_pk_bf16(o[c4][2] * rstd * gg[2] * siluf_(g2), o[c4][3] * rstd * gg[3] * siluf_(g3));
        *(u32x2*)(a2 + v) = w; }
#undef HG_VROW
#undef HG_SROW
}
__device__ __forceinline__ int build_tile_table(const Frame& F, const unsigned* cnt) {
    LAS int* cnts = (LAS int*)(F.lds + LDS_TT); LAS int* tstart = cnts + 72; LAS int* tt = cnts + 256;
    __syncthreads();
    if (F.tid < NEX) { int c = F.tid < NE ? (int)cnt[64 * F.tid] : NTOK; cnts[F.tid] = c > LISTCAP ? LISTCAP : c; }
    __syncthreads();
    if (F.tid == 0) { int acc = 0; for (int e = 0; e < NEX; ++e) { tstart[e] = acc; acc += (cnts[e] + 255) >> 8; } tstart[NEX] = acc; }
    __syncthreads();
    if (F.tid < NEX) { const int n = (cnts[F.tid] + 255) >> 8, s = tstart[F.tid]; for (int ti = 0; ti < n; ++ti) { tt[2 * (s + ti)] = F.tid; tt[2 * (s + ti) + 1] = ti; } }
    __syncthreads();
    return tstart[NEX];
}

struct Args { const float* in[21]; float* out; unsigned char* ws; int ph_lo, ph_hi; };
constexpr int N_PHASES = 18;

__global__ void __launch_bounds__(NTHREADS, 2) hybrid_fwd(Args args) {
    extern __shared__ __attribute__((aligned(16))) unsigned char lds_raw[];
    Frame F;
    F.lds = (LAS unsigned char*)lds_raw; F.tid = threadIdx.x; F.lane = F.tid & 63; F.wave = __builtin_amdgcn_readfirstlane(F.tid >> 6); F.G = gridDim.x; F.bid = blockIdx.x;
    F.in = args.in; F.out = args.out; F.ws = args.ws;
    unsigned char* ws = args.ws;
    unsigned* ctl = (unsigned*)(ws + WS_CTL);
    volatile LAS unsigned* MISC = (volatile LAS unsigned*)(F.lds + LDS_MISC);
    if (F.tid < 64) MISC[F.tid] = 0u;
    __syncthreads();
    const int lo = args.ph_lo, hi = args.ph_hi;
    XcdBarrier bar; bar.bar = ctl + CW_BAR; bar.x = 0; bar.st = MISC + 8;
    if (hi - lo > 1) bar = xcd_barrier_post(ctl + CW_BAR, MISC + 8);
#ifndef PROBE_MASK
#define PROBE_MASK 0
#endif
#define REPS(k) ((((PROBE_MASK) >> (k)) & 1) ? 2 : 1)
#ifndef DBG_MASK
#define DBG_MASK 0x3ffff
#endif
#define IN(k) (((DBG_MASK >> (k)) & 1) && lo <= (k) && (k) < hi)
#define SEAM(k) do { if (lo <= (k) && (k) + 1 < hi) xcd_barrier(bar); } while (0)

    if (IN(0)) { for (int rep_ = 0; rep_ < REPS(0); ++rep_) phase_prologue(F); SEAM(0); }
#define PH_INPROJ(pid, layer) if (IN(pid)) { \
        pg8::ProbPlain P{(const char*)(ws + WS_XA), (const char*)(ws + ((layer) ? WS_WIN1 : WS_WIN0)), D, NTOK / 256, (layer) ? IN1W / 256 : IN0W / 256, F.G, F.bid}; \
        pg8::EpiBf16 E{(bf16_t*)(ws + WS_PROJ), (layer) ? IN1W : IN0W, (layer) ? ctl + CW_KN : nullptr, 8, 16}; for (int rep_ = 0; rep_ < REPS(pid); ++rep_) pg8::gemm_phase(F.lds, P, E); SEAM(pid); }
#define PH_OUTPROJ(pid, layer) if (IN(pid)) { \
        pg8::ProbPlain P{(const char*)(ws + WS_A2), (const char*)(ws + ((layer) ? WS_WOUT1 : WS_WOUT0)), D, NTOK / 256, D / 256, F.G, F.bid}; \
        pg8::EpiResF32 E{(layer) ? (const float*)(ws + WS_X2F) : F.in[0], (float*)(ws + WS_YF), D, DN_ALPHA}; for (int rep_ = 0; rep_ < REPS(pid); ++rep_) pg8::gemm_phase(F.lds, P, E); SEAM(pid); }
#define PH_ROUTER(pid, layer) if (IN(pid)) { \
        RowArgs a{(const float*)(ws + WS_YF), nullptr, F.in[9] + (layer) * D, F.in[10] + (layer) * D, (float*)(ws + WS_X1F), (bf16_t*)(ws + WS_X1B), \
                  (const bf16_t*)(ws + WS_RT) + (size_t)((layer) * 2 + 0) * 64 * D, (const bf16_t*)(ws + WS_RT) + (size_t)((layer) * 2 + 1) * 64 * D, F.in[14] + (layer) * 64, ctl + CW_CNT + (layer) * 66 * 64, \
                  (int*)(ws + WS_LISTS), (float*)(ws + WS_WTS), nullptr}; \
        phase_rows<0, 4>(F, a); SEAM(pid); }
#define PH_GATEUP(pid, layer) if (IN(pid)) { \
        const int ntiles = build_tile_table(F, ctl + CW_CNT + (layer) * 66 * 64); \
        pg8::ProbMoE P{(const char*)(ws + WS_X1B), (const char*)(ws + WS_WGU), D, ntiles, 4, F.G, F.bid, (const int*)(ws + WS_LISTS), (const LAS int*)(F.lds + LDS_TT) + 256, (const LAS int*)(F.lds + LDS_TT), 1}; \
        pg8::EpiSwiGLU E{(bf16_t*)(ws + WS_H)}; for (int rep_ = 0; rep_ < REPS(pid); ++rep_) pg8::gemm_phase(F.lds, P, E); SEAM(pid); }
#define PH_DOWN(pid, layer) if (IN(pid)) { \
        const int ntiles = build_tile_table(F, ctl + CW_CNT + (layer) * 66 * 64); \
        pg8::ProbMoE P{(const char*)(ws + WS_H), (const char*)(ws + WS_WD), EDIM, ntiles, 8, F.G, F.bid, (const int*)(ws + WS_LISTS), (const LAS int*)(F.lds + LDS_TT) + 256, (const LAS int*)(F.lds + LDS_TT), 0}; \
        pg8::EpiDown E{(bf16_t*)(ws + WS_Y), (const int*)(ws + WS_LISTS), (const float*)(ws + WS_WTS)}; for (int rep_ = 0; rep_ < REPS(pid); ++rep_) pg8::gemm_phase(F.lds, P, E); SEAM(pid); }
    PH_INPROJ(1, 0)
    if (IN(2)) { for (int rep_ = 0; rep_ < REPS(2); ++rep_) for (int it = F.bid; it < 3072 + 2048; it += F.G) { if (it < 3072) dilated_item(F, it); else hgrn_a_item(F, it - 3072); } SEAM(2); }
    if (IN(3)) { for (int rep_ = 0; rep_ < REPS(3); ++rep_) hgrn_scan(F); SEAM(3); }
    if (IN(4)) { for (int rep_ = 0; rep_ < REPS(4); ++rep_) { for (int it = F.bid; it < 2048; it += F.G) hgrn_c_item(F, it); combine_tokens(F); } SEAM(4); }
    PH_OUTPROJ(5, 0)
    PH_ROUTER(6, 0)
    PH_GATEUP(7, 0)
    PH_DOWN(8, 0)
    if (IN(9)) {
        RowArgs a{(const float*)(ws + WS_X1F), (const bf16_t*)(ws + WS_Y), F.in[11], F.in[12], (float*)(ws + WS_X2F), (bf16_t*)(ws + WS_XA),
                  (const bf16_t*)(ws + WS_FGHI), (const bf16_t*)(ws + WS_FGLO), nullptr, nullptr, nullptr, nullptr, (float*)(ws + WS_FLOG)};
        for (int rep_ = 0; rep_ < REPS(9); ++rep_) phase_rows<1, 1>(F, a); SEAM(9); }
    if (IN(10)) { for (int rep_ = 0; rep_ < REPS(10); ++rep_) phase_convert_l1(F); SEAM(10); }
    PH_INPROJ(11, 1)
    if (IN(12)) { for (int rep_ = 0; rep_ < REPS(12); ++rep_) for (int it = F.bid; it < 2048; it += F.G) fox_item(F, it); SEAM(12); }
    PH_OUTPROJ(13, 1)
    PH_ROUTER(14, 1)
    PH_GATEUP(15, 1)
    PH_DOWN(16, 1)
    if (IN(17)) {
        RowArgs a{(const float*)(ws + WS_X1F), (const bf16_t*)(ws + WS_Y), F.in[11] + D, F.in[12] + D, F.out, (bf16_t*)(ws + WS_XA),
                  nullptr, nullptr, nullptr, nullptr, nullptr, nullptr, nullptr};
        for (int rep_ = 0; rep_ < REPS(17); ++rep_) phase_rows<1, 0>(F, a); }
#undef IN
#undef SEAM
}

#ifndef MK_N_LAUNCHES
#define MK_N_LAUNCHES 1
#endif
extern "C" void kernel_launch(void* const* d_in, const int* in_sizes, int n_in, void* d_out, int out_size, void* d_ws, size_t ws_size, hipStream_t stream) {
    static int grid = 0;
    if (grid == 0) {
        if (n_in != 21 || out_size != NTOK * D || ws_size < WS_END) { fprintf(stderr, "kernel_launch: unexpected shapes (n_in %d, out %d, ws %zu < %zu)\n", n_in, out_size, ws_size, (size_t)WS_END); grid = -1; return; }
        int dev = 0, cus = 0, per_cu = 0;
        if (hipGetDevice(&dev) != hipSuccess || hipDeviceGetAttribute(&cus, hipDeviceAttributeMultiprocessorCount, dev) != hipSuccess) { grid = -1; return; }
        if (hipFuncSetAttribute((const void*)hybrid_fwd, hipFuncAttributeMaxDynamicSharedMemorySize, LDS_BYTES) != hipSuccess) { fprintf(stderr, "kernel_launch: hipFuncSetAttribute failed\n"); grid = -1; return; }
        if (hipOccupancyMaxActiveBlocksPerMultiprocessor(&per_cu, (const void*)hybrid_fwd, NTHREADS, LDS_BYTES) != hipSuccess || per_cu < 1) { fprintf(stderr, "kernel_launch: occupancy query says %d\n", per_cu); }
        (void)hipGetLastError();
        grid = cus;
    }
    if (grid < 0) return;
    (void)in_sizes;
    if (hipMemsetAsync((char*)d_ws + WS_CTL, 0, CTL_ZERO_BYTES, stream) != hipSuccess) return;
    Args a{};
    for (int i = 0; i < 21; ++i) a.in[i] = (const float*)d_in[i];
    a.out = (float*)d_out; a.ws = (unsigned char*)d_ws;
    if (MK_N_LAUNCHES == 1) { a.ph_lo = 0; a.ph_hi = N_PHASES; hipLaunchKernelGGL(hybrid_fwd, dim3(grid), dim3(NTHREADS), LDS_BYTES, stream, a); }
    else for (int p = 0; p < N_PHASES; ++p) { a.ph_lo = p; a.ph_hi = p + 1; hipLaunchKernelGGL(hybrid_fwd, dim3(grid), dim3(NTHREADS), LDS_BYTES, stream, a); }
}
```

```cpp
#include <hip/hip_runtime.h>
#include <cstdio>
#include <cstdint>

#define LAS __attribute__((address_space(3)))
#define GAS __attribute__((address_space(1)))
typedef unsigned short bf16_t;
typedef short bf16x8 __attribute__((ext_vector_type(8)));
typedef short s16x4 __attribute__((ext_vector_type(4)));
typedef float f32x4 __attribute__((ext_vector_type(4)));
typedef float f32x2 __attribute__((ext_vector_type(2)));
typedef unsigned u32x4 __attribute__((ext_vector_type(4)));
typedef unsigned u32x2 __attribute__((ext_vector_type(2)));
typedef int i32x4 __attribute__((ext_vector_type(4)));
typedef int i32x8 __attribute__((ext_vector_type(8)));

constexpr int D = 2048, NTOK = 16384, SEQ = 4096, NBATCH = 4;
constexpr int IN0W = 7168, IN1W = 6144, IN1FULL = 6160;
constexpr int NE = 64, NEX = 65  , EDIM = 512, LISTCAP = 16384;
constexpr float LN_EPS = 1e-5f, RMS_EPS = 1e-6f;
constexpr float DN_ALPHA = 1.4142135623730951f;
constexpr float ATT_SCALE = 0.08838834764831845f;
constexpr int NWAVES = 8, NTHREADS = 512;

constexpr size_t MiB = 1u << 20;
constexpr size_t WS_CTL = 0, CTL_ZERO_BYTES = 1 * MiB;
constexpr size_t WS_LB = 1 * MiB;
constexpr size_t WS_BIASREL = 1 * MiB + 16384;
constexpr size_t WS_FGHI = 1 * MiB + 65536;
constexpr size_t WS_FGLO = 1 * MiB + 131072;
constexpr size_t WS_RGB = 1 * MiB + 196608;
constexpr size_t WS_RT = 2 * MiB;
constexpr size_t WS_YPOS = 3 * MiB;
constexpr size_t WS_FLOG = 4 * MiB;
constexpr size_t WS_CC = 5 * MiB;
constexpr size_t WS_LSE = 6 * MiB;
constexpr size_t WS_ALAST = 8 * MiB;
constexpr size_t WS_WIN0 = 16 * MiB, WS_WOUT0 = 44 * MiB, WS_WIN1 = 52 * MiB, WS_WOUT1 = 76 * MiB;
constexpr size_t WS_WGU = 84 * MiB;
constexpr size_t WS_WD = 604 * MiB;
constexpr size_t WGU_LAYER = 260 * MiB, WD_LAYER = 130 * MiB;
constexpr size_t WS_XA = 864 * MiB;
constexpr size_t WS_X1B = 928 * MiB;
constexpr size_t WS_A2 = 992 * MiB;
constexpr size_t WS_YF = 1056 * MiB;
constexpr size_t WS_X2F = 1120 * MiB;
constexpr size_t WS_H = 1248 * MiB;
constexpr size_t WS_Y = 1408 * MiB;
constexpr size_t WS_PROJ = 1408 * MiB;
constexpr size_t WS_LT = 1632 * MiB;
constexpr size_t WS_ST = 1760 * MiB;
constexpr size_t WS_OBR = 1824 * MiB;
constexpr size_t WS_LISTS = 1920 * MiB;
constexpr size_t WS_X1Q = 1930 * MiB;
constexpr size_t WS_XQ = 1962 * MiB;
constexpr size_t WS_A2Q = 1994 * MiB;
constexpr size_t WS_WIN0Q = WS_WIN0;
constexpr size_t WS_WSH = 2026 * MiB;
constexpr size_t WSH_LAYER = 6 * MiB;
constexpr size_t WS_HSH = WS_YF;
constexpr size_t WS_YSH = WS_A2;
constexpr size_t WS_END = 2044 * MiB;
constexpr int CW_BAR = 4096;
constexpr int CW_CNT = 16384;
constexpr int CW_KN = 32768;
#ifndef CONVERTERS
#define CONVERTERS 0
#endif
constexpr int P0_EXPERT_ITEMS = 0;
constexpr float W8_SCALE = 64.0f;
constexpr int W8_SCALE_E8M0 = 0x7c7c7c7c, ONE_E8M0 = 0x7c7c7c7c;
constexpr float Y_SCALE = 16.0f;
constexpr float FOX_T = 30.0f;

#ifndef F8_FGATE
#define F8_FGATE 1
#endif
#ifndef PRB_HA
#define PRB_HA 1
#define PRB_HC 1
#define PRB_DIL 1
#endif
#ifndef CONV_F2
#define CONV_F2 380
#define CONV_F3 510
#endif
__device__ __forceinline__ unsigned cvt_pk_bf16(float lo, float hi) { unsigned r; asm volatile("v_cvt_pk_bf16_f32 %0, %1, %2" : "=v"(r) : "v"(lo), "v"(hi)); return r; }
__device__ __forceinline__ float clamp8(float v) { return __builtin_amdgcn_fmed3f(v, -448.0f, 448.0f); }
__device__ __forceinline__ unsigned cvt_pk4_fp8(float a, float b, float c, float d) { a = clamp8(a); b = clamp8(b); c = clamp8(c); d = clamp8(d); int o = 0; o = __builtin_amdgcn_cvt_pk_fp8_f32(a, b, o, false); o = __builtin_amdgcn_cvt_pk_fp8_f32(c, d, o, true); return (unsigned)o; }
__device__ __forceinline__ float bf_lo(unsigned w) { return __uint_as_float(w << 16); }
__device__ __forceinline__ float bf_hi(unsigned w) { return __uint_as_float(w & 0xffff0000u); }
__device__ __forceinline__ float bf2f(bf16_t b) { return __uint_as_float(((unsigned)b) << 16); }
__device__ __forceinline__ float sigmoidf_(float x) { return 1.0f / (1.0f + __expf(-x)); }
__device__ __forceinline__ float siluf_(float x) { return x / (1.0f + __expf(-x)); }
__device__ __forceinline__ float wave_sum(float v) {
#pragma unroll
    for (int o = 1; o < 64; o <<= 1) v += __shfl_xor(v, o);
    return v;
}
#define MFMA16(a, b, c) __builtin_amdgcn_mfma_f32_16x16x32_bf16((a), (b), (c), 0, 0, 0)
#define LDS_WAIT() asm volatile("s_waitcnt lgkmcnt(0)" ::: "memory")
#define VM_WAIT() asm volatile("s_waitcnt vmcnt(0)" ::: "memory")
__device__ __forceinline__ unsigned off_b(unsigned row, unsigned ch) { return 256u * row + 16u * (ch ^ (((row & 3u) << 2) | ((row >> 2) & 3u))); }
__device__ __forceinline__ s16x4 tr_read(unsigned addr) { s16x4 r; asm volatile("ds_read_b64_tr_b16 %0, %1" : "=v"(r) : "v"(addr) : "memory"); return r; }
__device__ __forceinline__ bf16x8 cat8(s16x4 a, s16x4 b) { return __builtin_shufflevector(a, b, 0, 1, 2, 3, 4, 5, 6, 7); }

#define XB_TMO      128
#define XB_XCNT(j)  (256  + 64 * (j))
#define XB_XSUB(j)  (1280 + 64 * (j))
#define XB_XGEN(j)  (2304 + 64 * (j))
#define XB_TOP      3328
#define XB_TOPGEN   3392
#define XCD_BAR_WORDS 3456
#define XB_SPIN_CAP (1u << 22)
__device__ __forceinline__ unsigned xb_ld(unsigned* p)              { return __hip_atomic_load(p, __ATOMIC_RELAXED, __HIP_MEMORY_SCOPE_AGENT); }
__device__ __forceinline__ unsigned xb_add(unsigned* p, unsigned v) { return __hip_atomic_fetch_add(p, v, __ATOMIC_RELAXED, __HIP_MEMORY_SCOPE_AGENT); }
__device__ __forceinline__ unsigned xb_xcc_id() { return (unsigned)__builtin_amdgcn_s_getreg((3 << 11) | 20) & 0xFu; }
#define XB_SPIN(cond, bar) do { unsigned _sp = 0; while (cond) { __builtin_amdgcn_s_sleep(1); \
    if ((++_sp & 255u) == 0u) { if (xb_ld(&(bar)[XB_TMO])) break; if (_sp > XB_SPIN_CAP) { atomicAdd(&(bar)[XB_TMO], 1u); break; } } } } while (0)
__device__ __forceinline__ int lane_id_() { int l; asm volatile("v_mbcnt_lo_u32_b32 %0, -1, 0\n\tv_mbcnt_hi_u32_b32 %0, -1, %0" : "=v"(l)); return l; }
struct XcdBarrier { unsigned* bar; unsigned x; volatile LAS unsigned* st; int w0; };
__device__ __forceinline__ XcdBarrier xcd_barrier_post(unsigned* bar, volatile LAS unsigned* st, int w0) {
    XcdBarrier b; b.bar = bar; b.x = xb_xcc_id(); b.st = st; b.w0 = w0;
    if (w0 == 0 && lane_id_() == 0) (void)xb_add(&bar[XB_XCNT(b.x)], 1u);
    return b;
}
__device__ __forceinline__ void xcd_barrier_complete(unsigned* bar, unsigned x, unsigned& nloc, unsigned& nx) {
    const unsigned G = gridDim.x * gridDim.y * gridDim.z;
    unsigned sum, cnt, mine, sp = 0u;
    for (;;) {
        sum = 0u; cnt = 0u; mine = 0u;
#pragma unroll
        for (unsigned j = 0; j < 16; ++j) { const unsigned c = xb_ld(&bar[XB_XCNT(j)]); sum += c; cnt += (c > 0u) ? 1u : 0u; mine = (j == x) ? c : mine; }
        if (sum == G) break;
        __builtin_amdgcn_s_sleep(1);
        if ((++sp & 255u) == 0u) { if (xb_ld(&bar[XB_TMO])) break; if (sp > XB_SPIN_CAP) { atomicAdd(&bar[XB_TMO], 1u); break; } }
    }
    nloc = mine > 0u ? mine : 1u; nx = cnt > 0u ? cnt : 1u;
}
__device__ __forceinline__ void xcd_barrier(const XcdBarrier& b) {
    asm volatile("s_waitcnt vmcnt(0)" ::: "memory");
    __syncthreads();
    if (b.w0 == 0 && lane_id_() == 0) {
        unsigned* bar = b.bar;
        __builtin_amdgcn_s_waitcnt(0);
        unsigned nloc = b.st[0], nx = b.st[1];
        if (nloc == 0u) { xcd_barrier_complete(bar, b.x, nloc, nx); b.st[0] = nloc; b.st[1] = nx; }
        const unsigned old = xb_add(&bar[XB_XSUB(b.x)], 1u);
        const unsigned gen = old / nloc;
        if (old + 1u == (gen + 1u) * nloc) {
            __builtin_amdgcn_fence(__ATOMIC_RELEASE, "agent");
            asm volatile("s_waitcnt vmcnt(0)" ::: "memory");
            const unsigned og = xb_add(&bar[XB_TOP], 1u);
            const unsigned tg = og / nx;
            if (og + 1u == (tg + 1u) * nx) xb_add(&bar[XB_TOPGEN], 1u);
            else XB_SPIN(xb_ld(&bar[XB_TOPGEN]) == tg, bar);
            __builtin_amdgcn_fence(__ATOMIC_ACQUIRE, "agent");
            xb_add(&bar[XB_XGEN(b.x)], 1u);
            asm volatile("s_waitcnt vmcnt(0)" ::: "memory");
        } else {
            XB_SPIN(xb_ld(&bar[XB_XGEN(b.x)]) == gen, bar);
            __builtin_amdgcn_fence(__ATOMIC_ACQUIRE, "agent");
            asm volatile("s_waitcnt vmcnt(0)" ::: "memory");
        }
    }
    __syncthreads();
}
struct XbTicket { unsigned gen, tg; int role; };
__device__ __forceinline__ XbTicket xcd_barrier_arrive(const XcdBarrier& b) {
    XbTicket t; t.gen = 0u; t.tg = 0u; t.role = 0;
    asm volatile("s_waitcnt vmcnt(0)" ::: "memory");
    __syncthreads();
    if (b.w0 == 0 && lane_id_() == 0) {
        unsigned* bar = b.bar;
        __builtin_amdgcn_s_waitcnt(0);
        unsigned nloc = b.st[0], nx = b.st[1];
        if (nloc == 0u) { xcd_barrier_complete(bar, b.x, nloc, nx); b.st[0] = nloc; b.st[1] = nx; }
        const unsigned old = xb_add(&bar[XB_XSUB(b.x)], 1u);
        t.gen = old / nloc;
        if (old + 1u == (t.gen + 1u) * nloc) {
            __builtin_amdgcn_fence(__ATOMIC_RELEASE, "agent");
            asm volatile("s_waitcnt vmcnt(0)" ::: "memory");
            const unsigned og = xb_add(&bar[XB_TOP], 1u);
            t.tg = og / nx;
            if (og + 1u == (t.tg + 1u) * nx) { xb_add(&bar[XB_TOPGEN], 1u); t.role = 2; } else t.role = 1;
        }
    }
    return t;
}
__device__ __forceinline__ void xcd_barrier_wait(const XcdBarrier& b, const XbTicket& t) {
    asm volatile("s_waitcnt vmcnt(0)" ::: "memory");
    if (b.w0 == 0 && lane_id_() == 0) {
        unsigned* bar = b.bar;
        if (t.role != 0) {
            if (t.role == 1) XB_SPIN(xb_ld(&bar[XB_TOPGEN]) == t.tg, bar);
            __builtin_amdgcn_fence(__ATOMIC_ACQUIRE, "agent");
            xb_add(&bar[XB_XGEN(b.x)], 1u);
            asm volatile("s_waitcnt vmcnt(0)" ::: "memory");
        } else {
            XB_SPIN(xb_ld(&bar[XB_XGEN(b.x)]) == t.gen, bar);
            __builtin_amdgcn_fence(__ATOMIC_ACQUIRE, "agent");
            asm volatile("s_waitcnt vmcnt(0)" ::: "memory");
        }
    }
    __syncthreads();
}
constexpr int LDS_BYTES = 163840;
constexpr int LDS_REC = 147456;
constexpr int LDS_MISC = 143360;
constexpr int LDS_TT = 131072;
namespace pg8 {
constexpr int BM = 256, BK = 64, HALF = 128, HTB = HALF * BK * 2, STAGE_BYTES = 8 * HTB, NXCD = 8, WGM = 8;
__host__ __device__ __forceinline__ int lds_byte(int r, int c) { const int st = (r >> 4) * 2 + (c >> 5), rr = r & 15, cc = c & 31, ob = rr * 64 + cc * 2; return st * 1024 + (ob ^ (((ob >> 9) & 1) << 5)); }
__host__ __device__ __forceinline__ void stage_rc(int b, int& R, int& C) { const int st = b / 1024, sb = b % 1024, swz = sb ^ (((sb >> 9) & 1) << 5); R = (st >> 1) * 16 + swz / 64; C = (st & 1) * 32 + (swz % 64) / 2; }
__host__ __device__ __forceinline__ int perm32(int rho) { const int n = rho >> 4, i = rho & 15; return 8 * (i >> 2) + 4 * n + (i & 3); }

struct Unit { int pm, pn, e, nrows, lbase, ord; };

__device__ __forceinline__ bool enum_unit(int i, int nM, int nN, int G, int c, int& pm, int& pn) {
    const int nwg = nM * nN; const long L = (long)i * G + c; if (L >= nwg) return false;
    int wgid = (int)L; { const int q = nwg / NXCD, r = nwg % NXCD, xcd = wgid % NXCD, off = wgid / NXCD; wgid = (xcd < r ? xcd * (q + 1) : r * (q + 1) + (xcd - r) * q) + off; }
    const int nig = WGM * nN, gid = wgid / nig, fm = gid * WGM, gsz = (nM - fm) < WGM ? (nM - fm) : WGM;
    pm = fm + ((wgid % nig) % gsz); pn = (wgid % nig) / gsz; return true;
}

struct ProbPlain {
    static constexpr bool GATHER = false, FP8 = false; static constexpr int NTC = 0;
    const char* A; const char* Bt; int K, nM, nN, G, c;
    __device__ __forceinline__ bool next(int i, Unit& u) const { u.e = 0; u.nrows = 256; u.lbase = 0; u.ord = i; return enum_unit(i, nM, nN, G, c, u.pm, u.pn); }
    __device__ __forceinline__ const char* a_base() const { return A; }
    __device__ __forceinline__ unsigned a_rowoff(const Unit& u, int r) const { return (unsigned)(u.pm * BM + r) * (unsigned)(K * 2); }
    __device__ __forceinline__ const char* b_base(const Unit& u) const { return Bt + (size_t)u.pn * BM * K * 2; }
};
struct ProbPlain8 {
    static constexpr bool GATHER = false, FP8 = true; static constexpr int NTC = 0;
    const char* A; const char* Bt; int K, nM, nN, G, c;
    __device__ __forceinline__ bool next(int i, Unit& u) const { u.e = 0; u.nrows = 256; u.lbase = 0; u.ord = i; return enum_unit(i, nM, nN, G, c, u.pm, u.pn); }
    __device__ __forceinline__ const char* a_base() const { return A; }
    __device__ __forceinline__ unsigned a_rowoff(const Unit& u, int r) const { return (unsigned)(u.pm * BM + r) * (unsigned)K; }
    __device__ __forceinline__ const char* b_base(const Unit& u) const { return Bt + (size_t)u.pn * BM * K; }
};
template <bool GATHER_> struct ProbMoE {
    static constexpr bool GATHER = GATHER_, FP8 = true; static constexpr int NTC = GATHER_ ? 0 : 4;
    const char* A; const char* Bt; int K, nM, nN, G, c; const int* list; const LAS int* tt; const LAS int* cnts; const LAS unsigned short* tokc;
    __device__ __forceinline__ bool next(int i, Unit& u) const {
        if (!enum_unit(i, nM, nN, G, c, u.pm, u.pn)) return false;
        u.ord = i;
        const int e = tt[2 * u.pm], ti = tt[2 * u.pm + 1]; u.e = e; const int rem = cnts[e] - ti * BM; u.nrows = rem < BM ? rem : BM; u.lbase = e * LISTCAP + ti * BM; return true;
    }
    __device__ __forceinline__ const char* a_base() const { return A; }
    __device__ __forceinline__ unsigned a_rowoff(const Unit& u, int r) const {
        if (GATHER) return (unsigned)tokc[u.ord * BM + r] * (unsigned)K;
        return (unsigned)(u.pm * BM + r) * (unsigned)K;
    }
    __device__ __forceinline__ const char* b_base(const Unit& u) const { return Bt + ((size_t)u.e * nN + u.pn) * BM * K; }
};

template <class Prob> __device__ __forceinline__ void fill_tok_cache(const Prob& P, LAS unsigned short* tokc, int tid) {
    Unit u;
    for (int i = 0; i < 11 && P.next(i, u); ++i)
        if (tid < BM) { const int rr = tid < u.nrows ? tid : u.nrows - 1; tokc[i * BM + tid] = (unsigned short)(P.list[2 * (u.lbase + rr)] >> 4); }
    __syncthreads();
}
struct NoPre {};
struct EpiBf16 {
    static constexpr bool PERM = true, PERM16 = true; typedef NoPre Pre;
    static constexpr int NST = 16;
    bf16_t* O; int ldc; unsigned* kn; int kn_lo, kn_hi;
    __device__ __forceinline__ Pre prefetch(const Unit&, int, int) const { return Pre{}; }
    __device__ __forceinline__ void operator()(const f32x4 (&acc)[2][2][4][2], const Unit& u, int wr, int wc, int fr, int fq, const Pre&) const {
        const int row0 = u.pm * BM + wr * 64 + fr, col0 = u.pn * BM + wc * 64 + 16 * fq;
        float kmx = 0.f;
#pragma unroll
        for (int ai = 0; ai < 2; ++ai)
#pragma unroll
            for (int m = 0; m < 4; ++m) { bf16_t* rowp = O + (size_t)(row0 + ai * HALF + m * 16) * ldc + col0;
                const f32x4 a0 = acc[ai][0][m][0], a1 = acc[ai][0][m][1], b0 = acc[ai][1][m][0], b1 = acc[ai][1][m][1];
                u32x4 w0, w1; w0.x = cvt_pk_bf16(a0[0], a0[1]); w0.y = cvt_pk_bf16(a0[2], a0[3]); w0.z = cvt_pk_bf16(a1[0], a1[1]); w0.w = cvt_pk_bf16(a1[2], a1[3]);
                w1.x = cvt_pk_bf16(b0[0], b0[1]); w1.y = cvt_pk_bf16(b0[2], b0[3]); w1.z = cvt_pk_bf16(b1[0], b1[1]); w1.w = cvt_pk_bf16(b1[2], b1[3]);
                *(u32x4*)rowp = w0; *(u32x4*)(rowp + 8) = w1;
                if (kn) { float ss = 0.f;
#pragma unroll
                    for (int q = 0; q < 4; ++q) { const unsigned x0 = q == 0 ? w0.x : q == 1 ? w0.y : q == 2 ? w0.z : w0.w, x1 = q == 0 ? w1.x : q == 1 ? w1.y : q == 2 ? w1.z : w1.w;
                        ss += bf_lo(x0) * bf_lo(x0) + bf_hi(x0) * bf_hi(x0) + bf_lo(x1) * bf_lo(x1) + bf_hi(x1) * bf_hi(x1); }
                    ss += __shfl_xor(ss, 16); ss += __shfl_xor(ss, 32); kmx = fmaxf(kmx, ss); } }
        if (kn && u.pn >= kn_lo && u.pn < kn_hi) {
            float v = kmx;
#pragma unroll
            for (int o = 1; o < 16; o <<= 1) v = fmaxf(v, __shfl_xor(v, o));
            if (fr == 0 && fq == 0) atomicMax(kn + (((u.pm * BM) / SEQ) * 16 + 2 * (u.pn - kn_lo) + (wc >> 1)) * 4 + (wc & 1), __float_as_uint(v));
        }
    }
};
struct EpiResF32 {
    static constexpr bool PERM = false, PERM16 = false; typedef NoPre Pre; static constexpr int NST = 0;
    const float* res; float* out; int ldc; float alpha;
    __device__ __forceinline__ Pre prefetch(const Unit&, int, int) const { return Pre{}; }
    __device__ __forceinline__ void operator()(const f32x4 (&acc)[2][2][4][2], const Unit& u, int wr, int wc, int fr, int fq, const Pre&) const {
        const int row0 = u.pm * BM + wr * 64 + fr, col0 = u.pn * BM + wc * 32 + 4 * fq;
#pragma unroll
        for (int ai = 0; ai < 2; ++ai)
#pragma unroll
            for (int m = 0; m < 4; ++m) { const size_t off = (size_t)(row0 + ai * HALF + m * 16) * ldc + col0;
#pragma unroll
                for (int bj = 0; bj < 2; ++bj)
#pragma unroll
                    for (int n = 0; n < 2; ++n) { const f32x4 r = *(const f32x4*)(res + off + bj * HALF + n * 16); *(f32x4*)(out + off + bj * HALF + n * 16) = r * alpha + acc[ai][bj][m][n]; }
                asm volatile("" ::: "memory"); }
    }
};
struct EpiSwiGLU {
    static constexpr bool PERM = true, PERM16 = false; typedef NoPre Pre; static constexpr int NST = 8;
    unsigned char* H;
    __device__ __forceinline__ Pre prefetch(const Unit&, int, int) const { return Pre{}; }
    __device__ __forceinline__ void operator()(const f32x4 (&acc)[2][2][4][2], const Unit& u, int wr, int wc, int fr, int fq, const Pre&) const {
        const int row0 = u.pm * BM + wr * 64 + fr, col0 = u.pn * HALF + wc * 32 + 8 * fq;
#pragma unroll
        for (int ai = 0; ai < 2; ++ai)
#pragma unroll
            for (int m = 0; m < 4; ++m) { unsigned char* rowp = H + (size_t)(row0 + ai * HALF + m * 16) * EDIM + col0;
                float h[8];
#pragma unroll
                for (int n = 0; n < 2; ++n)
#pragma unroll
                    for (int j = 0; j < 4; ++j) { const float g = acc[ai][0][m][n][j], up = acc[ai][1][m][n][j]; h[n * 4 + j] = fminf(fmaxf(g * __builtin_amdgcn_rcpf(1.0f + __expf(-g)) * up, -440.f), 440.f); }
                int o0 = 0, o1 = 0; o0 = __builtin_amdgcn_cvt_pk_fp8_f32(h[0], h[1], o0, false); o0 = __builtin_amdgcn_cvt_pk_fp8_f32(h[2], h[3], o0, true);
                o1 = __builtin_amdgcn_cvt_pk_fp8_f32(h[4], h[5], o1, false); o1 = __builtin_amdgcn_cvt_pk_fp8_f32(h[6], h[7], o1, true);
                u32x2 w; w.x = (unsigned)o0; w.y = (unsigned)o1; *(u32x2*)rowp = w; }
    }
};
struct EpiSwiGLU16 {
    static constexpr bool PERM = true, PERM16 = false; typedef NoPre Pre; static constexpr int NST = 8;
    bf16_t* H;
    __device__ __forceinline__ Pre prefetch(const Unit&, int, int) const { return Pre{}; }
    __device__ __forceinline__ void operator()(const f32x4 (&acc)[2][2][4][2], const Unit& u, int wr, int wc, int fr, int fq, const Pre&) const {
        const int row0 = u.pm * BM + wr * 64 + fr, col0 = u.pn * HALF + wc * 32 + 8 * fq;
#pragma unroll
        for (int ai = 0; ai < 2; ++ai)
#pragma unroll
            for (int m = 0; m < 4; ++m) { bf16_t* rowp = H + (size_t)(row0 + ai * HALF + m * 16) * EDIM + col0;
                float h[8];
#pragma unroll
                for (int n = 0; n < 2; ++n)
#pragma unroll
                    for (int j = 0; j < 4; ++j) { const float g = acc[ai][0][m][n][j], up = acc[ai][1][m][n][j]; h[n * 4 + j] = g * __builtin_amdgcn_rcpf(1.0f + __expf(-g)) * up; }
                u32x4 w; w.x = cvt_pk_bf16(h[0], h[1]); w.y = cvt_pk_bf16(h[2], h[3]); w.z = cvt_pk_bf16(h[4], h[5]); w.w = cvt_pk_bf16(h[6], h[7]);
                *(u32x4*)rowp = w; }
    }
};
struct EpiDown {
    static constexpr bool PERM = true, PERM16 = true;
    typedef NoPre Pre; static constexpr int NST = 8;
    unsigned char* Y; LAS unsigned char* lds;
    static __device__ __forceinline__ int rec_off(int ord) { return ord < 16 ? LDS_REC + ord * 1024 : LDS_TT + 6656 + (ord - 16) * 1024; }
    __device__ __forceinline__ Pre prefetch(const Unit&, int, int) const { return Pre{}; }
    __device__ __forceinline__ void operator()(const f32x4 (&acc)[2][2][4][2], const Unit& u, int wr, int wc, int fr, int fq, const Pre&) const {
        const int col0 = u.pn * BM + wc * 64 + 16 * fq;
        const LAS unsigned* rec = (const LAS unsigned*)(lds + rec_off(u.ord));
        unsigned info[2][4];
#pragma unroll
        for (int ai = 0; ai < 2; ++ai)
#pragma unroll
            for (int m = 0; m < 4; ++m) info[ai][m] = rec[ai * HALF + wr * 64 + m * 16 + fr];
#pragma unroll
        for (int ai = 0; ai < 2; ++ai)
#pragma unroll
            for (int m = 0; m < 4; ++m) { const int r = ai * HALF + wr * 64 + m * 16 + fr; const bool ok = r < u.nrows;
                const unsigned v = info[ai][m]; const int tok = (int)(v >> 18), slot = (int)((v >> 14) & 15u); const float w = (float)(v & 16383u) * (2.5f / 16383.0f) * Y_SCALE;
                unsigned char* rowp = Y + (size_t)(ok ? tok * 9 + slot : NTOK * 9) * D + col0;
                u32x4 o;
                { const f32x4 a0 = acc[ai][0][m][0] * w, a1 = acc[ai][0][m][1] * w, b0 = acc[ai][1][m][0] * w, b1 = acc[ai][1][m][1] * w;
                  o.x = cvt_pk4_fp8(a0[0], a0[1], a0[2], a0[3]); o.y = cvt_pk4_fp8(a1[0], a1[1], a1[2], a1[3]); o.z = cvt_pk4_fp8(b0[0], b0[1], b0[2], b0[3]); o.w = cvt_pk4_fp8(b1[0], b1[1], b1[2], b1[3]); }
                *(u32x4*)rowp = o; }
    }
};
template <class Prob> __device__ __forceinline__ void fill_rec_cache(const Prob& P, LAS unsigned char* lds, int tid) {
    Unit u;
    for (int i = tid >> 8; i < 21 && P.next(i, u); i += 2) { const int r = tid & 255, rr = r < u.nrows ? r : u.nrows - 1;
        ((LAS unsigned*)(lds + EpiDown::rec_off(i)))[r] = (unsigned)P.list[2 * (size_t)(u.lbase + rr) + 1]; }
    __syncthreads();
}

template <class Prob, class Epi>
__device__ __forceinline__ void gemm_phase(LAS unsigned char* lds, const Prob& P, const Epi& E, int wave_s) {
    int tid_ = (wave_s << 6) + lane_id_(); asm volatile("" : "+v"(tid_));
    const int tid = tid_, wid = __builtin_amdgcn_readfirstlane(tid >> 6), lane = tid & 63, wr = wid >> 2, wc = wid & 3, fr = lane & 15, fq = lane >> 4;
    constexpr int ESZ = Prob::FP8 ? 1 : 2;
    const int K = P.K, nt = K * ESZ / (BK * 2);
    int Rst[2]; unsigned Cst2[2], voffB[2], voffBh[2][2];
#pragma unroll
    for (int i = 0; i < 2; ++i) { int R, C; stage_rc(tid * 16 + i * 8192, R, C); const int Rb = Epi::PERM ? ((R & ~31) + perm32(R & 31)) : R;
        Rst[i] = R; Cst2[i] = (unsigned)C * 2u; voffB[i] = (unsigned)(Rb * K) * (unsigned)ESZ + (unsigned)C * 2u;
        if constexpr (Epi::PERM16) { const int r16 = 64 * (R >> 5) + 16 * ((R & 15) >> 2) + 4 * ((R >> 4) & 1) + (R & 3);
            voffBh[0][i] = (unsigned)(r16 * K) * (unsigned)ESZ + (unsigned)C * 2u; voffBh[1][i] = (unsigned)((r16 + 8) * K) * (unsigned)ESZ + (unsigned)C * 2u; } }
    const size_t kstep = (size_t)(BK * 2);
    const size_t hstep = (size_t)HALF * K * ESZ;
    const unsigned ldsw = (unsigned)wid * 1024u;
    const int aoff = lds_byte(wr * 64 + fr, fq * 8), boff = lds_byte(wc * 32 + fr, fq * 8);
#define PG8_SA(b, h) (((b) * 2 + (h)) * HTB)
#define PG8_SB(b, h) ((4 + (b) * 2 + (h)) * HTB)
#define PG8_STAGE(bufoff, gbase, voff) do { _Pragma("unroll") for (int _i = 0; _i < 2; ++_i) \
        __builtin_amdgcn_global_load_lds((const unsigned*)((const char*)(gbase) + (voff)[_i]), (LAS unsigned*)(lds + (bufoff) + ldsw + _i * 8192), 16, 0, 0); } while (0)
#define PG8_LD2(dst, addr) do { const i32x4 _lo = *(const LAS i32x4*)(addr), _hi = *(const LAS i32x4*)((addr) + 1024); dst = __builtin_shufflevector(_lo, _hi, 0, 1, 2, 3, 4, 5, 6, 7); } while (0)
#define PG8_LDA(dst, b, h) do { _Pragma("unroll") for (int m = 0; m < 4; ++m) PG8_LD2(dst[m], lds + PG8_SA(b, h) + aoff + m * 2048); } while (0)
#define PG8_LDB(dst, b, h) do { _Pragma("unroll") for (int n = 0; n < 2; ++n) PG8_LD2(dst[n], lds + PG8_SB(b, h) + boff + n * 2048); } while (0)
#define PG8_LO(x) __builtin_bit_cast(bf16x8, __builtin_shufflevector(x, x, 0, 1, 2, 3))
#define PG8_HI(x) __builtin_bit_cast(bf16x8, __builtin_shufflevector(x, x, 4, 5, 6, 7))
#define PG8_MMA(ai, bj, At, Bt) do { __builtin_amdgcn_s_setprio(1); \
        if constexpr (Prob::FP8) { _Pragma("unroll") for (int m = 0; m < 4; ++m) _Pragma("unroll") for (int n = 0; n < 2; ++n) \
            asm volatile("v_mfma_scale_f32_16x16x128_f8f6f4 %0, %1, %2, %0, %3, %3 op_sel_hi:[0,0,0]" : "+v"(acc[ai][bj][m][n]) : "v"(Bt[n]), "v"(At[m]), "v"(mxscale)); } \
        else { _Pragma("unroll") for (int m = 0; m < 4; ++m) _Pragma("unroll") for (int n = 0; n < 2; ++n) { \
            acc[ai][bj][m][n] = __builtin_amdgcn_mfma_f32_16x16x32_bf16(PG8_LO(Bt[n]), PG8_LO(At[m]), acc[ai][bj][m][n], 0, 0, 0); \
            acc[ai][bj][m][n] = __builtin_amdgcn_mfma_f32_16x16x32_bf16(PG8_HI(Bt[n]), PG8_HI(At[m]), acc[ai][bj][m][n], 0, 0, 0); } } \
        __builtin_amdgcn_s_setprio(0); } while (0)
#define PG8_WAIT_V(n) asm volatile("s_waitcnt vmcnt(" #n ")" ::: "memory")
#define PG8_WAIT_R() do { if (relax) asm volatile("s_waitcnt vmcnt(%0)" :: "n"(8 + Epi::NST) : "memory"); else asm volatile("s_waitcnt vmcnt(8)" ::: "memory"); } while (0)
#define PG8_WAIT_L(n) asm volatile("s_waitcnt lgkmcnt(" #n ")" ::: "memory")
#define PG8_BAR __builtin_amdgcn_s_barrier()
#define PG8_SCHED __builtin_amdgcn_sched_barrier(0)
    Unit cur, nxt; int ui = 0;
    if (!P.next(0, cur)) return;
    f32x4 acc[2][2][4][2];
#pragma unroll
    for (int a = 0; a < 2; ++a)
#pragma unroll
        for (int b = 0; b < 2; ++b)
#pragma unroll
            for (int m = 0; m < 4; ++m)
#pragma unroll
                for (int n = 0; n < 2; ++n) acc[a][b][m][n] = (f32x4){0.f, 0.f, 0.f, 0.f};
    int mxscale = W8_SCALE_E8M0; asm volatile("" : "+v"(mxscale));
    i32x8 At[4], B0[2], B1[2];
    const char* aB = P.a_base();
    unsigned voAc[2][2], voAn[2][2], voffA[2]; const char* cAu = aB; const char* nAu = aB;
    if constexpr (Prob::GATHER) {
#pragma unroll
        for (int h = 0; h < 2; ++h)
#pragma unroll
            for (int i = 0; i < 2; ++i) voAc[h][i] = P.a_rowoff(cur, h * HALF + Rst[i]) + Cst2[i];
    } else {
#pragma unroll
        for (int i = 0; i < 2; ++i) voffA[i] = (unsigned)(Rst[i] * K) * (unsigned)ESZ + Cst2[i];
        cAu = aB + P.a_rowoff(cur, 0);
    }
#define PG8_STAGE_B(bufoff, ptr, h) do { if constexpr (Epi::PERM16) { PG8_STAGE(bufoff, ptr, voffBh[h]); } else { PG8_STAGE(bufoff, (ptr) + (h) * hstep, voffB); } } while (0)
#define PG8_STAGE_A(bufoff, ptr, h, SEL) do { if constexpr (Prob::GATHER) { if (SEL) { unsigned _vs[2] = {last ? voAn[h][0] : voAc[h][0], last ? voAn[h][1] : voAc[h][1]}; PG8_STAGE(bufoff, ptr, _vs); } else { PG8_STAGE(bufoff, ptr, voAc[h]); } } else { PG8_STAGE(bufoff, (ptr) + (h) * hstep, voffA); } } while (0)
    const char* cB = P.b_base(cur);
    { const char* p0 = Prob::GATHER ? aB : cAu; const bool last = false; (void)last;
    PG8_STAGE_B(PG8_SB(0, 0), cB, 0); PG8_STAGE_B(PG8_SB(0, 1), cB, 1); PG8_STAGE_A(PG8_SA(0, 0), p0, 0, 0); PG8_STAGE_A(PG8_SA(0, 1), p0, 1, 0);
    if (wr == 1) PG8_BAR;
    PG8_WAIT_V(2); PG8_BAR;
    PG8_STAGE_B(PG8_SB(1, 0), cB + kstep, 0); PG8_STAGE_A(PG8_SA(1, 0), p0 + kstep, 0, 0); PG8_STAGE_B(PG8_SB(1, 1), cB + kstep, 1);
    if constexpr (Prob::FP8) PG8_WAIT_V(0); else PG8_WAIT_V(6);
    PG8_BAR; }
    for (;;) {
        const typename Epi::Pre pre = E.prefetch(cur, wr, fr);
        const bool has_next = P.next(ui + 1, nxt);
        const char* nB = cB; nAu = cAu;
        if constexpr (Prob::GATHER) {
#pragma unroll
            for (int h = 0; h < 2; ++h)
#pragma unroll
                for (int i = 0; i < 2; ++i) voAn[h][i] = voAc[h][i];
        }
        if (has_next) { nB = P.b_base(nxt);
            if constexpr (Prob::GATHER) {
#pragma unroll
                for (int h = 0; h < 2; ++h)
#pragma unroll
                    for (int i = 0; i < 2; ++i) voAn[h][i] = P.a_rowoff(nxt, h * HALF + Rst[i]) + Cst2[i];
            } else nAu = aB + P.a_rowoff(nxt, 0); }
        const char* curA = Prob::GATHER ? aB : cAu; const char* nxtA = Prob::GATHER ? aB : nAu;
#define PG8_BODY() do { \
            const char* a1 = curA + (size_t)(t + 1) * kstep; \
            const char* a2 = last ? nxtA : curA + (size_t)(t + 2) * kstep; const char* b2 = last ? nB : cB + (size_t)(t + 2) * kstep; \
            const char* a3 = a2 + kstep; const char* b3 = b2 + kstep; \
              \
            PG8_LDB(B0, 0, 0); PG8_LDB(B1, 0, 1); PG8_SCHED; PG8_LDA(At, 0, 0); PG8_STAGE_A(PG8_SA(1, 1), a1, 1, 0); \
            PG8_WAIT_R(); PG8_WAIT_L(0); PG8_BAR; PG8_MMA(0, 0, At, B0); PG8_MMA(0, 1, At, B1); PG8_BAR; PG8_SCHED; \
              \
            PG8_LDA(At, 0, 1); PG8_STAGE_B(PG8_SB(0, 0), b2, 0); PG8_STAGE_B(PG8_SB(0, 1), b2, 1); PG8_STAGE_A(PG8_SA(0, 0), a2, 0, 1); \
            PG8_WAIT_R(); PG8_WAIT_L(0); PG8_BAR; PG8_MMA(1, 0, At, B0); PG8_MMA(1, 1, At, B1); PG8_BAR; PG8_SCHED; \
              \
            PG8_LDB(B0, 1, 0); PG8_LDB(B1, 1, 1); PG8_SCHED; PG8_LDA(At, 1, 0); PG8_STAGE_A(PG8_SA(0, 1), a2, 1, 1); \
            PG8_WAIT_V(8); PG8_WAIT_L(0); PG8_BAR; PG8_MMA(0, 0, At, B0); PG8_MMA(0, 1, At, B1); PG8_BAR; PG8_SCHED; \
              \
            PG8_LDA(At, 1, 1); PG8_STAGE_B(PG8_SB(1, 0), b3, 0); PG8_STAGE_B(PG8_SB(1, 1), b3, 1); PG8_STAGE_A(PG8_SA(1, 0), a3, 0, 1); \
            PG8_WAIT_V(8); PG8_WAIT_L(0); PG8_BAR; PG8_MMA(1, 0, At, B0); PG8_MMA(1, 1, At, B1); PG8_BAR; PG8_SCHED; \
        } while (0)
        if constexpr (Prob::NTC > 0) {
            _Pragma("unroll") for (int t = 0; t < Prob::NTC; t += 2) { const bool last = (t == Prob::NTC - 2); const bool relax = (t == 0); PG8_BODY(); }
        } else {
            if constexpr (Prob::FP8) { constexpr int t = 0; constexpr bool last = false, relax = true; PG8_BODY(); }
            for (int t = Prob::FP8 ? 2 : 0; t < nt; t += 2) { const bool last = (t == nt - 2); constexpr bool relax = false; PG8_BODY(); }
        }
#undef PG8_BODY
        if constexpr (Prob::FP8) asm volatile("s_nop 15\n\ts_nop 15" ::: "memory");
        if (wr == 0) PG8_BAR;
        E(acc, cur, wr, wc, fr, fq, pre);
        if (!has_next) break;
#pragma unroll
        for (int a = 0; a < 2; ++a)
#pragma unroll
            for (int b = 0; b < 2; ++b)
#pragma unroll
                for (int m = 0; m < 4; ++m)
#pragma unroll
                    for (int n = 0; n < 2; ++n) acc[a][b][m][n] = (f32x4){0.f, 0.f, 0.f, 0.f};
        cur = nxt; cB = nB; cAu = nAu; ++ui;
        if constexpr (Prob::GATHER) {
#pragma unroll
            for (int h = 0; h < 2; ++h)
#pragma unroll
                for (int i = 0; i < 2; ++i) voAc[h][i] = voAn[h][i];
        }
        if (wr == 1) PG8_BAR;
    }
    PG8_WAIT_V(0);
    PG8_BAR;
#undef PG8_SA
#undef PG8_SB
#undef PG8_STAGE
#undef PG8_STAGE_A
#undef PG8_STAGE_B
#undef PG8_LDA
#undef PG8_LDB
#undef PG8_MMA
#undef PG8_LD2
#undef PG8_LO
#undef PG8_HI
#undef PG8_WAIT_V
#undef PG8_WAIT_R
#undef PG8_WAIT_L
#undef PG8_BAR
#undef PG8_SCHED
}
}
struct Frame {
    LAS unsigned char* lds; int tid, lane, wave, G, bid;
    const float* const* in; float* out; unsigned char* ws;
};

constexpr int EXP_ITEMS = 768;
constexpr int CONV_SCR = 17408;
struct ConvItem { const float* src; unsigned char* dst; int ldw, K, fp8; };
__device__ __forceinline__ ConvItem conv_matrix(const float* W, int ldw, int K, int N, bf16_t* WT, int item, int fp8 = 0) {
    const int nblk = N / 32, kb = item / nblk, nb = item % nblk; ConvItem c; c.src = W + (size_t)(128 * kb) * ldw + 32 * nb; c.dst = (unsigned char*)WT + ((size_t)(32 * nb) * K + 128 * kb) * (fp8 ? 1 : 2); c.ldw = ldw; c.K = K; c.fp8 = fp8; return c;
}
struct ConvSrc { const float* g; const float* u; const float* d; const float* sg; const float* su; const float* sd; unsigned char* ws; };
__device__ __forceinline__ ConvSrc conv_src(const Frame& F) { ConvSrc c; c.g = F.in[15]; c.u = F.in[16]; c.d = F.in[17]; c.sg = F.in[18]; c.su = F.in[19]; c.sd = F.in[20]; c.ws = F.ws; return c; }
__device__ __forceinline__ ConvItem conv_expert(const ConvSrc& S, int layer, int item) {
    const int e = item / EXP_ITEMS, r = item % EXP_ITEMS, which = r / 256, it = r % 256; ConvItem c;
    if (which < 2) {
        const float* W = e < NE ? (which ? S.u : S.g) + ((size_t)layer * NE + e) * D * EDIM : (which ? S.su : S.sg) + (size_t)layer * D * EDIM;
        const int kb = it / 16, nb = it % 16, n0 = 32 * nb;
        const int dest = (n0 >> 7) * 256 + which * 128 + (n0 & 127);
        c.src = W + (size_t)(128 * kb) * EDIM + n0; c.ldw = EDIM; c.K = D;
        if (e < NE) { c.dst = (S.ws + WS_WGU + (size_t)layer * WGU_LAYER) + ((size_t)e * 1024 + dest) * D + 128 * kb; c.fp8 = 1; }
        else { c.dst = (S.ws + WS_WSH + (size_t)layer * WSH_LAYER) + ((size_t)dest * D + 128 * kb); c.fp8 = 1; }
    } else {
        const float* W = e < NE ? S.d + ((size_t)layer * NE + e) * EDIM * D : S.sd + (size_t)layer * EDIM * D;
        const int kb = it / 64, nb = it % 64;
        c.src = W + (size_t)(128 * kb) * D + 32 * nb; c.ldw = D; c.K = EDIM;
        if (e < NE) { c.dst = (S.ws + WS_WD + (size_t)layer * WD_LAYER) + ((size_t)e * D + 32 * nb) * EDIM + 128 * kb; c.fp8 = 1; }
        else { c.dst = (S.ws + WS_WSH + (size_t)layer * WSH_LAYER + 4 * MiB) + ((size_t)(32 * nb) * EDIM + 128 * kb) * 2; c.fp8 = 0; }
    }
    return c;
}
constexpr int CI0 = (D / 128) * (IN0W / 32), CI1 = (D / 128) * (D / 32), CI2 = (D / 128) * (IN1W / 32), CI3 = CI1;
__device__ __forceinline__ ConvItem conv_prologue(const Frame& F, int it) {
    int r = it;
    if (r < CI0) { const int nb_ = r % (IN0W / 32); if (F8_FGATE || nb_ < 128 || nb_ >= 160) return conv_matrix(F.in[3], IN0W, D, IN0W, (bf16_t*)(F.ws + WS_WIN0Q), r, 1); return conv_matrix(F.in[3], IN0W, D, IN0W, (bf16_t*)(F.ws + WS_WIN0), r); } r -= CI0;
    if (r < CI1) return conv_matrix(F.in[5], D, D, D, (bf16_t*)(F.ws + WS_WOUT0), r, 1); r -= CI1;
    if (r < CI2) return conv_matrix(F.in[6], IN1FULL, D, IN1W, (bf16_t*)(F.ws + WS_WIN1), r, 1); r -= CI2;
    if (r < CI3) return conv_matrix(F.in[8], D, D, D, (bf16_t*)(F.ws + WS_WOUT1), r, 1); r -= CI3;
    return conv_expert(conv_src(F), 0, r);
}
__device__ __forceinline__ void conv_load(const ConvItem& c, u32x4 (&t)[16], int lane) {
#pragma unroll
    for (int i = 0; i < 16; ++i) t[i] = __builtin_nontemporal_load((const u32x4*)(c.src + (size_t)(8 * i + (lane >> 3)) * c.ldw + 4 * (lane & 7)));
}
__device__ __forceinline__ void conv_store(const ConvItem& c, const u32x4 (&t)[16], LAS float* scr, int lane) {
#pragma unroll
    for (int i = 0; i < 16; ++i) { LAS unsigned* d = (LAS unsigned*)scr + (8 * i + (lane >> 3)) * 33 + 4 * (lane & 7); d[0] = t[i].x; d[1] = t[i].y; d[2] = t[i].z; d[3] = t[i].w; }
    LDS_WAIT(); asm volatile("" ::: "memory");
    const int cc = lane & 7;
#pragma unroll
    for (int j = 0; j < 4; ++j) { const int n = (lane >> 3) + 8 * j; const LAS float* sp = scr + (16 * cc) * 33 + n;
        if (c.fp8) {
            u32x4 o; o.x = cvt_pk4_fp8(sp[0 * 33] * W8_SCALE, sp[1 * 33] * W8_SCALE, sp[2 * 33] * W8_SCALE, sp[3 * 33] * W8_SCALE); o.y = cvt_pk4_fp8(sp[4 * 33] * W8_SCALE, sp[5 * 33] * W8_SCALE, sp[6 * 33] * W8_SCALE, sp[7 * 33] * W8_SCALE);
            o.z = cvt_pk4_fp8(sp[8 * 33] * W8_SCALE, sp[9 * 33] * W8_SCALE, sp[10 * 33] * W8_SCALE, sp[11 * 33] * W8_SCALE); o.w = cvt_pk4_fp8(sp[12 * 33] * W8_SCALE, sp[13 * 33] * W8_SCALE, sp[14 * 33] * W8_SCALE, sp[15 * 33] * W8_SCALE);
            __builtin_nontemporal_store(o, (u32x4*)(c.dst + (size_t)n * c.K + 16 * cc)); }
        else { u32x4 o, p; o.x = cvt_pk_bf16(sp[0 * 33], sp[1 * 33]); o.y = cvt_pk_bf16(sp[2 * 33], sp[3 * 33]); o.z = cvt_pk_bf16(sp[4 * 33], sp[5 * 33]); o.w = cvt_pk_bf16(sp[6 * 33], sp[7 * 33]);
            p.x = cvt_pk_bf16(sp[8 * 33], sp[9 * 33]); p.y = cvt_pk_bf16(sp[10 * 33], sp[11 * 33]); p.z = cvt_pk_bf16(sp[12 * 33], sp[13 * 33]); p.w = cvt_pk_bf16(sp[14 * 33], sp[15 * 33]);
            u32x4* dp = (u32x4*)(c.dst + ((size_t)n * c.K + 16 * cc) * 2); dp[0] = o; dp[1] = p; } }
    LDS_WAIT(); asm volatile("" ::: "memory");
}
template <int SPACE>
__device__ __forceinline__ void convert_items(const Frame& F, int layer, int i0, int i1, int cw, int nw) {
    LAS float* scr = (LAS float*)(F.lds + F.wave * CONV_SCR); const int lane = F.lane;
    const ConvSrc S = conv_src(F);
#define CONV_DEC(it_) (SPACE == 0 ? conv_prologue(F, it_) : conv_expert(S, layer, it_))
    int it = i0 + cw; if (it >= i1) return;
    u32x4 ta[16], tb[16];
    ConvItem ca = CONV_DEC(it), cb = ca;
    conv_load(ca, ta, lane);
    for (;;) {
        const bool hb = it + nw < i1; if (hb) { cb = CONV_DEC(it + nw); conv_load(cb, tb, lane); }
        conv_store(ca, ta, scr, lane);
        if (!hb) break;
        const bool ha = it + 2 * nw < i1; if (ha) { ca = CONV_DEC(it + 2 * nw); conv_load(ca, ta, lane); }
        conv_store(cb, tb, scr, lane);
        if (!ha) break;
        it += 2 * nw;
    }
#undef CONV_DEC
}
__device__ __forceinline__ int t5_bucket(int dist) {
    if (dist < 16) return dist;
    const double v = log((double)dist / 16.0) / log(2048.0 / 16.0) * 16.0;
    int b = 16 + (int)v; return b > 31 ? 31 : b;
}
__device__ __forceinline__ void phase_prologue(const Frame& F) {
    const int gw = F.bid * NWAVES + F.wave, NGW = F.G * NWAVES;
    convert_items<0>(F, 0, 0, CI0 + CI1 + CI2 + CI3 + ((CONVERTERS && F.G == 256) ? P0_EXPERT_ITEMS : NEX * EXP_ITEMS), gw, NGW);
    { const size_t gt = (size_t)F.bid * NTHREADS + F.tid, GT = (size_t)F.G * NTHREADS; const float* x = F.in[0]; bf16_t* xa = (bf16_t*)(F.ws + WS_XA);
      for (size_t i = gt; i < (size_t)NTOK * D / 8; i += GT) { const f32x4 a = *(const f32x4*)(x + i * 8), b = *(const f32x4*)(x + i * 8 + 4);
          u32x4 w; w.x = cvt_pk_bf16(a[0], a[1]); w.y = cvt_pk_bf16(a[2], a[3]); w.z = cvt_pk_bf16(b[0], b[1]); w.w = cvt_pk_bf16(b[2], b[3]); if (!F8_FGATE) *(u32x4*)(xa + i * 8) = w;
          u32x2 q; q.x = cvt_pk4_fp8(a[0], a[1], a[2], a[3]); q.y = cvt_pk4_fp8(b[0], b[1], b[2], b[3]); *(u32x2*)(F.ws + WS_XQ + i * 8) = q; } }
    { const int gt = F.bid * NTHREADS + F.tid, GT = F.G * NTHREADS;
      bf16_t* rt = (bf16_t*)(F.ws + WS_RT);
      for (int i = gt; i < 2 * 64 * D; i += GT) { const int layer = i / (64 * D), e = (i / D) % 64, k = i % D; const float w = F.in[13][((size_t)layer * D + k) * 64 + e] * F.in[9][layer * D + k];
          const unsigned hi = cvt_pk_bf16(w, 0.f) & 0xffffu; const float lo = w - __uint_as_float(hi << 16);
          rt[((size_t)(layer * 2 + 0) * 64 + e) * D + k] = (bf16_t)hi; rt[((size_t)(layer * 2 + 1) * 64 + e) * D + k] = (bf16_t)(cvt_pk_bf16(lo, 0.f) & 0xffffu); }
      { const int gwv = F.bid * NWAVES + F.wave; if (gwv < 128) { const int layer = gwv >> 6, e = gwv & 63; float sg = 0.f, sb = 0.f;
            for (int k = F.lane; k < D; k += 64) { const float w = F.in[13][((size_t)layer * D + k) * 64 + e]; sg += w * F.in[9][layer * D + k]; sb += w * F.in[10][layer * D + k]; }
            sg = wave_sum(sg); sb = wave_sum(sb); if (F.lane == 0) { float* rgb = (float*)(F.ws + WS_RGB); rgb[(layer * 2 + 0) * 64 + e] = sg; rgb[(layer * 2 + 1) * 64 + e] = sb; } } }
      bf16_t* fh = (bf16_t*)(F.ws + WS_FGHI); bf16_t* fl = (bf16_t*)(F.ws + WS_FGLO);
      for (int i = gt; i < 16 * D; i += GT) { const int j = i / D, k = i % D; const float w = F.in[6][(size_t)k * IN1FULL + IN1W + j];
          const unsigned hi = cvt_pk_bf16(w, 0.f) & 0xffffu; const float lo = w - __uint_as_float(hi << 16);
          fh[(size_t)j * D + k] = (bf16_t)hi; fl[(size_t)j * D + k] = (bf16_t)(cvt_pk_bf16(lo, 0.f) & 0xffffu); }
      float* lb = (float*)(F.ws + WS_LB);
      for (int i = gt; i < 1024; i += GT) { const float a = F.in[2][i], b = F.in[2][1024 + i], c = F.in[2][2048 + i]; const float m = fmaxf(a, fmaxf(b, c));
          const float ea = expf(a - m), eb = expf(b - m), ec = expf(c - m); lb[i] = ea / (ea + eb + ec); }
      float* br = (float*)(F.ws + WS_BIASREL);
      for (int i = gt; i < 3 * 8 * 132; i += GT) { const int b3 = i / (8 * 132), h = (i / 132) % 8, rel = i % 132; const int dil = b3 == 0 ? 1 : (b3 == 1 ? 4 : 16);
          br[i] = rel <= 128 ? F.in[1][t5_bucket(rel * dil) * 8 + h] : 0.f; } }
}
__device__ __forceinline__ void fox_cumsum(const Frame& F) {
    const int gw = F.bid * NWAVES + F.wave, lane = F.lane;
    if (gw < 64) { const int b = gw >> 4, h = gw & 15; const float* __restrict__ fl = (const float*)(F.ws + WS_FLOG) + (size_t)b * SEQ * 16 + h; float* __restrict__ cc = (float*)(F.ws + WS_CC) + (size_t)gw * SEQ; const float bf = F.in[7][h];
        float run = 0.f;
#pragma unroll 1
        for (int half = 0; half < 2; ++half) {
            float z[32];
#pragma unroll
            for (int i = 0; i < 32; ++i) z[i] = fl[(size_t)((half * 32 + i) * 64 + lane) * 16];
#pragma unroll
            for (int i = 0; i < 32; ++i) { const float zz = z[i] + bf;
                float v = fminf(zz, 0.f) - log1pf(__expf(-fabsf(zz)));
#pragma unroll
                for (int o = 1; o < 64; o <<= 1) { const float u = __shfl_up(v, o); if (lane >= o) v += u; }
                cc[(half * 32 + i) * 64 + lane] = run + v; run += __shfl(v, 63); } } }
}
__device__ __forceinline__ void convert_experts(const Frame& F, int layer, int i0, int i1, int cw, int nw) { convert_items<1>(F, layer, i0, i1, cw, nw); }
constexpr int CONV_STRIDE = 4;
__device__ __forceinline__ bool is_converter(const Frame& F) { return CONVERTERS && F.G == 256 && ((F.bid >> 3) % CONV_STRIDE) == CONV_STRIDE - 1; }
__device__ __forceinline__ Frame work_frame(const Frame& F) { Frame W = F; if (CONVERTERS && F.G == 256) { const int local = F.bid >> 3; W.bid = (local - local / CONV_STRIDE) * 8 + (F.bid & 7); W.G = 256 - 256 / CONV_STRIDE; } return W; }
__device__ __forceinline__ int conv_cw(const Frame& F) { return (((F.bid >> 3) / CONV_STRIDE) * 8 + (F.bid & 7)) * NWAVES + F.wave; }
constexpr int CONV_NW = (256 / CONV_STRIDE) * NWAVES;
constexpr int CONV_L0_JOBS = NEX * EXP_ITEMS - P0_EXPERT_ITEMS, CONV_JOBS = CONV_L0_JOBS + NEX * EXP_ITEMS;
__device__ __forceinline__ void convert_jobs(const Frame& F, int j0, int j1) {
    const int cw = conv_cw(F);
    if (j0 < CONV_L0_JOBS) convert_items<1>(F, 0, P0_EXPERT_ITEMS + j0, P0_EXPERT_ITEMS + (j1 < CONV_L0_JOBS ? j1 : CONV_L0_JOBS), cw, CONV_NW);
    if (j1 > CONV_L0_JOBS) convert_items<1>(F, 1, (j0 > CONV_L0_JOBS ? j0 : CONV_L0_JOBS) - CONV_L0_JOBS, j1 - CONV_L0_JOBS, cw, CONV_NW);
}
struct RowArgs {
    const float* vin; const bf16_t* Y; const float* gam; const float* bet; float* xo; bf16_t* xob;
    const bf16_t* whi; const bf16_t* wlo; const float* rbias; unsigned* cnt; int* lists; const bf16_t* ysh; float* flog;
};
template <int MODE, int NT>
__device__ __forceinline__ void phase_rows(const Frame& F, const RowArgs& a) {
    const int lane = F.lane, wave = F.wave, fr = lane & 15, fq = lane >> 4;
    LAS float* xch = (LAS float*)(F.lds);
    LAS float* scb = (LAS float*)(F.lds + 16384);
    for (int base = F.bid * 4; base < NTOK / 16; base += F.G * 4) {
#pragma unroll 1
        for (int i = 0; i < 8; ++i) {
            const int tok = (base + (wave >> 1)) * 16 + (wave & 1) * 8 + i;
            const int l8 = 8 * lane;
            f32x4 va[4], vb[4];
            if (MODE == 1) { const bf16_t* src = (const bf16_t*)a.vin + (size_t)tok * D + l8;
#pragma unroll
                for (int j = 0; j < 4; ++j) { const u32x4 w = __builtin_nontemporal_load((const u32x4*)(src + 512 * j));
                    va[j] = (f32x4){bf_lo(w.x), bf_hi(w.x), bf_lo(w.y), bf_hi(w.y)} * (DN_ALPHA * Y_SCALE); vb[j] = (f32x4){bf_lo(w.z), bf_hi(w.z), bf_lo(w.w), bf_hi(w.w)} * (DN_ALPHA * Y_SCALE); } }
            else { const float* src = a.vin + (size_t)tok * D + l8;
#pragma unroll
                for (int j = 0; j < 4; ++j) { va[j] = *(const f32x4*)(src + 512 * j) * DN_ALPHA; vb[j] = *(const f32x4*)(src + 512 * j + 4) * DN_ALPHA; } }
            if (MODE == 0) { const bf16_t* ys = a.Y + (size_t)tok * D + l8;
#pragma unroll
                for (int j = 0; j < 4; ++j) { const u32x4 w = *(const u32x4*)(ys + 512 * j);
                    va[j][0] += bf_lo(w.x); va[j][1] += bf_hi(w.x); va[j][2] += bf_lo(w.y); va[j][3] += bf_hi(w.y); vb[j][0] += bf_lo(w.z); vb[j][1] += bf_hi(w.z); vb[j][2] += bf_lo(w.w); vb[j][3] += bf_hi(w.w); } }
            if (MODE == 1) {
                { const bf16_t* ys = a.ysh + (size_t)tok * D + l8;
#pragma unroll
                  for (int j = 0; j < 4; ++j) { const u32x4 w = __builtin_nontemporal_load((const u32x4*)(ys + 512 * j));
                      va[j] = va[j] + (f32x4){bf_lo(w.x), bf_hi(w.x), bf_lo(w.y), bf_hi(w.y)} * Y_SCALE; vb[j] = vb[j] + (f32x4){bf_lo(w.z), bf_hi(w.z), bf_lo(w.w), bf_hi(w.w)} * Y_SCALE; }
                  asm volatile("" : "+v"(va[0]), "+v"(va[1]), "+v"(va[2]), "+v"(va[3]), "+v"(vb[0]), "+v"(vb[1]), "+v"(vb[2]), "+v"(vb[3]) :: "memory"); }
#pragma unroll
                for (int sb3 = 0; sb3 < 2; ++sb3) {
                    u32x2 w[4][4];
#pragma unroll
                    for (int s = 0; s < 4; ++s) { const unsigned char* ys = (const unsigned char*)a.Y + ((size_t)tok * 9 + 4 * sb3 + s) * D + l8;
#pragma unroll
                        for (int j = 0; j < 4; ++j) w[s][j] = __builtin_nontemporal_load((const u32x2*)(ys + 512 * j)); }
#pragma unroll
                    for (int s = 0; s < 4; ++s)
#pragma unroll
                        for (int j = 0; j < 4; ++j) {
                            const f32x2 p0 = __builtin_amdgcn_cvt_pk_f32_fp8((int)w[s][j].x, false), p1 = __builtin_amdgcn_cvt_pk_f32_fp8((int)w[s][j].x, true), p2 = __builtin_amdgcn_cvt_pk_f32_fp8((int)w[s][j].y, false), p3 = __builtin_amdgcn_cvt_pk_f32_fp8((int)w[s][j].y, true);
                            va[j][0] += p0.x; va[j][1] += p0.y; va[j][2] += p1.x; va[j][3] += p1.y; vb[j][0] += p2.x; vb[j][1] += p2.y; vb[j][2] += p3.x; vb[j][3] += p3.y; }
                    asm volatile("" : "+v"(va[0]), "+v"(va[1]), "+v"(va[2]), "+v"(va[3]), "+v"(vb[0]), "+v"(vb[1]), "+v"(vb[2]), "+v"(vb[3]) :: "memory");
                }
#pragma unroll
                for (int j = 0; j < 4; ++j) { va[j] = va[j] * (1.0f / Y_SCALE); vb[j] = vb[j] * (1.0f / Y_SCALE); }
            }
            float s1 = 0.f;
#pragma unroll
            for (int j = 0; j < 4; ++j) s1 += ((va[j][0] + va[j][1]) + (va[j][2] + va[j][3])) + ((vb[j][0] + vb[j][1]) + (vb[j][2] + vb[j][3]));
            const float mean = wave_sum(s1) * (1.0f / D); float s2 = 0.f;
#pragma unroll
            for (int j = 0; j < 4; ++j) { va[j] = va[j] - mean; vb[j] = vb[j] - mean;
                s2 += ((va[j][0] * va[j][0] + va[j][1] * va[j][1]) + (va[j][2] * va[j][2] + va[j][3] * va[j][3])) + ((vb[j][0] * vb[j][0] + vb[j][1] * vb[j][1]) + (vb[j][2] * vb[j][2] + vb[j][3] * vb[j][3])); }
            const float rstd = 1.0f / sqrtf(wave_sum(s2) * (1.0f / D) + LN_EPS);
            float* dst = a.xo + (size_t)tok * D + l8;
            asm volatile("" : "+v"(va[0]), "+v"(va[1]), "+v"(va[2]), "+v"(va[3]), "+v"(vb[0]), "+v"(vb[1]), "+v"(vb[2]), "+v"(vb[3]) :: "memory");
#pragma unroll
            for (int j = 0; j < 4; ++j) { const f32x4 g0 = *(const f32x4*)(a.gam + 512 * j + l8), g1 = *(const f32x4*)(a.gam + 512 * j + l8 + 4), b0 = *(const f32x4*)(a.bet + 512 * j + l8), b1 = *(const f32x4*)(a.bet + 512 * j + l8 + 4);
                const f32x4 o0 = va[j] * rstd * g0 + b0, o1 = vb[j] * rstd * g1 + b1; *(f32x4*)(dst + 512 * j) = o0; *(f32x4*)(dst + 512 * j + 4) = o1;
                if (NT != 0) { u32x2 w; w.x = cvt_pk4_fp8(o0[0], o0[1], o0[2], o0[3]); w.y = cvt_pk4_fp8(o1[0], o1[1], o1[2], o1[3]); *(u32x2*)((unsigned char*)a.xob + (size_t)tok * D + l8 + 512 * j) = w; }
                if (j & 1) asm volatile("" ::: "memory"); }
        }
        if (NT == 0) continue;
        VM_WAIT(); __syncthreads();
        const int task = base + (wave & 3), kh = wave >> 2;
        f32x4 acc[NT > 0 ? NT : 1];
#pragma unroll
        for (int n = 0; n < NT; ++n) acc[n] = (f32x4){0.f, 0.f, 0.f, 0.f};
        const float* xr = a.xo + (size_t)(task * 16 + fr) * D + 8 * fq;
#pragma unroll 4
        for (int kb = kh * 32; kb < kh * 32 + 32; ++kb) {
            const f32x4 x0 = *(const f32x4*)(xr + 32 * kb), x1 = *(const f32x4*)(xr + 32 * kb + 4);
            u32x4 hi; hi.x = cvt_pk_bf16(x0[0], x0[1]); hi.y = cvt_pk_bf16(x0[2], x0[3]); hi.z = cvt_pk_bf16(x1[0], x1[1]); hi.w = cvt_pk_bf16(x1[2], x1[3]);
            u32x4 lo; lo.x = cvt_pk_bf16(x0[0] - bf_lo(hi.x), x0[1] - bf_hi(hi.x)); lo.y = cvt_pk_bf16(x0[2] - bf_lo(hi.y), x0[3] - bf_hi(hi.y));
            lo.z = cvt_pk_bf16(x1[0] - bf_lo(hi.z), x1[1] - bf_hi(hi.z)); lo.w = cvt_pk_bf16(x1[2] - bf_lo(hi.w), x1[3] - bf_hi(hi.w));
            const bf16x8 ah = __builtin_bit_cast(bf16x8, hi), al = __builtin_bit_cast(bf16x8, lo);
#pragma unroll
            for (int n = 0; n < NT; ++n) { const size_t wo = (size_t)(16 * n + fr) * D + 32 * kb + 8 * fq;
                const bf16x8 bh = *(const bf16x8*)(a.whi + wo), bl = *(const bf16x8*)(a.wlo + wo);
                acc[n] = MFMA16(ah, bh, acc[n]); acc[n] = MFMA16(al, bh, acc[n]); acc[n] = MFMA16(ah, bl, acc[n]); }
        }
        if (kh == 1) {
#pragma unroll
            for (int n = 0; n < NT; ++n) *(LAS f32x4*)(xch + (((wave & 3) * 4 + n) * 64 + lane) * 4) = acc[n];
        }
        __syncthreads();
        if (kh == 0) {
#pragma unroll
            for (int n = 0; n < NT; ++n) acc[n] = acc[n] + *(const LAS f32x4*)(xch + (((wave & 3) * 4 + n) * 64 + lane) * 4);
            if (NT == 1) {
#pragma unroll
                for (int r = 0; r < 4; ++r) a.flog[(size_t)(task * 16 + 4 * fq + r) * 16 + fr] = acc[0][r];
            } else {
                LAS float* sc = scb + (wave & 3) * (2 * 16 * 68); LAS float* sl = sc + 16 * 68;
#pragma unroll
                for (int n = 0; n < NT; ++n)
#pragma unroll
                    for (int r = 0; r < 4; ++r) { const int e = 16 * n + fr; const float s = 1.0f / (1.0f + expf(-acc[n][r])); sc[(4 * fq + r) * 68 + e] = s; sl[(4 * fq + r) * 68 + e] = s + a.rbias[e]; }
                LDS_WAIT(); asm volatile("" ::: "memory");
                if (lane < 16) {
                    const int tok = task * 16 + lane; const LAS float* ms = sc + lane * 68; LAS float* ml = sl + lane * 68;
                    float gs[8];
#pragma unroll
                    for (int g = 0; g < 8; ++g) { float m1 = -3e38f, m2 = -3e38f;
#pragma unroll
                        for (int j = 0; j < 8; ++j) { const float x = ml[8 * g + j]; if (x > m1) { m2 = m1; m1 = x; } else if (x > m2) m2 = x; }
                        gs[g] = m1 + m2; }
                    unsigned gmask = 0u;
#pragma unroll
                    for (int rnd = 0; rnd < 4; ++rnd) { float best = -3e38f; int bi = 0;
#pragma unroll
                        for (int g = 0; g < 8; ++g) { const bool ok = !((gmask >> g) & 1u) && gs[g] > best; best = ok ? gs[g] : best; bi = ok ? g : bi; }
                        gmask |= 1u << bi; }
                    int eid[8]; float ew[8]; float wsum = 0.f;
#pragma unroll
                    for (int rnd = 0; rnd < 8; ++rnd) { float best = -3e38f; int bi = 0;
#pragma unroll 1
                        for (int e = 0; e < 64; ++e) { const float x = ml[e]; const bool ok = ((gmask >> (e >> 3)) & 1u) && x > best; best = ok ? x : best; bi = ok ? e : bi; }
                        eid[rnd] = bi; ew[rnd] = ms[bi]; wsum += ms[bi]; ml[bi] = -3e38f; }
                    const float inv = 2.5f / wsum;
#pragma unroll
                    for (int j = 0; j < 8; ++j) { const unsigned pos = atomicAdd(a.cnt + 64 * eid[j], 1u); u32x2 rec; rec.x = (unsigned)(tok * 16 + j); rec.y = ((unsigned)tok << 18) | ((unsigned)j << 14) | (unsigned)(ew[j] * inv * (16383.0f / 2.5f) + 0.5f); *(u32x2*)(a.lists + 2 * ((size_t)eid[j] * LISTCAP + pos)) = rec; }
                    { u32x2 rec; rec.x = (unsigned)(tok * 16 + 8); rec.y = ((unsigned)tok << 18) | (8u << 14) | (unsigned)(16383.0f / 2.5f + 0.5f); *(u32x2*)(a.lists + 2 * ((size_t)NE * LISTCAP + tok)) = rec; }
                }
            }
        }
        __syncthreads();
    }
}

struct RouterArgs { const float* xres; const bf16_t* ymix; const float* gam; const float* bet; bf16_t* xob; unsigned char* xoq;
                    const bf16_t* whi; const bf16_t* wlo; const float* gvec; const float* bvec; const float* rbias; unsigned* cnt; int* lists; };
__device__ __forceinline__ void phase_router(const Frame& F, const RouterArgs& a) {
    int lane_ = F.lane; asm volatile("" : "+v"(lane_));
    const int lane = lane_, wave = F.wave, fr = lane & 15, fq = lane >> 4;
    LAS f32x4* pacc = (LAS f32x4*)(F.lds);
    LAS f32x2* pst = (LAS f32x2*)(F.lds + 32768);
    const __amdgpu_buffer_rsrc_t rs_hi = __builtin_amdgcn_make_buffer_rsrc((void*)a.whi, 0, 64 * D * 2, 0x00020000);
    const __amdgpu_buffer_rsrc_t rs_lo = __builtin_amdgcn_make_buffer_rsrc((void*)a.wlo, 0, 64 * D * 2, 0x00020000);
    const int wvoff = (fr * D + 8 * fq) * 2;
    for (int task = F.bid; task < NTOK / 16; task += F.G) {
        const int tok0 = task * 16;
        f32x4 va[8], vb[8];
        {   const float* xp = a.xres + (size_t)(tok0 + fr) * D + 256 * wave + 8 * fq; const bf16_t* yp = a.ymix + (size_t)(tok0 + fr) * D + 256 * wave + 8 * fq;
#pragma unroll
            for (int i = 0; i < 8; ++i) { const f32x4 x0 = *(const f32x4*)(xp + 32 * i), x1 = *(const f32x4*)(xp + 32 * i + 4); const u32x4 w = *(const u32x4*)(yp + 32 * i);
                va[i] = x0 * DN_ALPHA + (f32x4){bf_lo(w.x), bf_hi(w.x), bf_lo(w.y), bf_hi(w.y)}; vb[i] = x1 * DN_ALPHA + (f32x4){bf_lo(w.z), bf_hi(w.z), bf_lo(w.w), bf_hi(w.w)}; } }
        float s1 = 0.f, s2 = 0.f;
#pragma unroll
        for (int i = 0; i < 8; ++i) { s1 += ((va[i][0] + va[i][1]) + (va[i][2] + va[i][3])) + ((vb[i][0] + vb[i][1]) + (vb[i][2] + vb[i][3]));
            s2 += ((va[i][0] * va[i][0] + va[i][1] * va[i][1]) + (va[i][2] * va[i][2] + va[i][3] * va[i][3])) + ((vb[i][0] * vb[i][0] + vb[i][1] * vb[i][1]) + (vb[i][2] * vb[i][2] + vb[i][3] * vb[i][3])); }
        s1 += __shfl_xor(s1, 16); s1 += __shfl_xor(s1, 32); s2 += __shfl_xor(s2, 16); s2 += __shfl_xor(s2, 32);
        f32x4 acc[4];
#pragma unroll
        for (int n = 0; n < 4; ++n) acc[n] = (f32x4){0.f, 0.f, 0.f, 0.f};
#pragma unroll
        for (int i = 0; i < 8; ++i) {
            const f32x4 x0 = va[i], x1 = vb[i];
            u32x4 hi; hi.x = cvt_pk_bf16(x0[0], x0[1]); hi.y = cvt_pk_bf16(x0[2], x0[3]); hi.z = cvt_pk_bf16(x1[0], x1[1]); hi.w = cvt_pk_bf16(x1[2], x1[3]);
            u32x4 lo; lo.x = cvt_pk_bf16(x0[0] - bf_lo(hi.x), x0[1] - bf_hi(hi.x)); lo.y = cvt_pk_bf16(x0[2] - bf_lo(hi.y), x0[3] - bf_hi(hi.y));
            lo.z = cvt_pk_bf16(x1[0] - bf_lo(hi.z), x1[1] - bf_hi(hi.z)); lo.w = cvt_pk_bf16(x1[2] - bf_lo(hi.w), x1[3] - bf_hi(hi.w));
            const bf16x8 ah = __builtin_bit_cast(bf16x8, hi), al = __builtin_bit_cast(bf16x8, lo);
#pragma unroll
            for (int n = 0; n < 4; ++n) { const int so = ((16 * n) * D + 256 * wave + 32 * i) * 2;
                const bf16x8 bh = __builtin_bit_cast(bf16x8, __builtin_amdgcn_raw_buffer_load_b128(rs_hi, wvoff, so, 0)), bl = __builtin_bit_cast(bf16x8, __builtin_amdgcn_raw_buffer_load_b128(rs_lo, wvoff, so, 0));
                acc[n] = MFMA16(ah, bh, acc[n]); acc[n] = MFMA16(al, bh, acc[n]); acc[n] = MFMA16(ah, bl, acc[n]); }
            if (i & 1) asm volatile("" ::: "memory");
        }
        __syncthreads();
        if (fq == 0) pst[wave * 16 + fr] = (f32x2){s1, s2};
#pragma unroll
        for (int n = 0; n < 4; ++n) pacc[(wave * 4 + n) * 64 + lane] = acc[n];
        __syncthreads();
        float S1 = 0.f, S2 = 0.f;
#pragma unroll
        for (int w = 0; w < 8; ++w) { const f32x2 p = pst[w * 16 + fr]; S1 += p.x; S2 += p.y; }
        const float mean = S1 * (1.0f / D); const float var = fmaxf(S2 * (1.0f / D) - mean * mean, 0.f); const float rstd = 1.0f / sqrtf(var + LN_EPS);
        {   bf16_t* op = a.xob + (size_t)(tok0 + fr) * D + 256 * wave + 8 * fq; const float* gp = a.gam + 256 * wave + 8 * fq; const float* bp = a.bet + 256 * wave + 8 * fq;
#pragma unroll
            for (int i = 0; i < 8; ++i) { const f32x4 g0 = *(const f32x4*)(gp + 32 * i), g1 = *(const f32x4*)(gp + 32 * i + 4), b0 = *(const f32x4*)(bp + 32 * i), b1 = *(const f32x4*)(bp + 32 * i + 4);
                const f32x4 o0 = (va[i] - mean) * rstd * g0 + b0, o1 = (vb[i] - mean) * rstd * g1 + b1;
                u32x4 w; w.x = cvt_pk_bf16(o0[0], o0[1]); w.y = cvt_pk_bf16(o0[2], o0[3]); w.z = cvt_pk_bf16(o1[0], o1[1]); w.w = cvt_pk_bf16(o1[2], o1[3]); *(u32x4*)(op + 32 * i) = w;
                u32x2 wq; wq.x = cvt_pk4_fp8(o0[0], o0[1], o0[2], o0[3]); wq.y = cvt_pk4_fp8(o1[0], o1[1], o1[2], o1[3]); *(u32x2*)(a.xoq + (size_t)(tok0 + fr) * D + 256 * wave + 8 * fq + 32 * i) = wq; } }
#pragma unroll 1
        for (int tt = 0; tt < 2; ++tt) {
            const int t = 2 * wave + tt, tok = tok0 + t;
            float T1 = 0.f, T2 = 0.f;
#pragma unroll
            for (int w = 0; w < 8; ++w) { const f32x2 p = pst[w * 16 + t]; T1 += p.x; T2 += p.y; }
            const float tm = T1 * (1.0f / D); const float tv = fmaxf(T2 * (1.0f / D) - tm * tm, 0.f); const float tr = 1.0f / sqrtf(tv + LN_EPS);
            float raw = 0.f;
#pragma unroll
            for (int w = 0; w < 8; ++w) { const LAS float* pp = (const LAS float*)(pacc + (w * 4 + (lane >> 4)) * 64 + (t >> 2) * 16 + (lane & 15)); raw += pp[t & 3]; }
            const float logit = tr * (raw - tm * a.gvec[lane]) + a.bvec[lane];
            const float sc = 1.0f / (1.0f + expf(-logit)); const float sel = sc + a.rbias[lane];
            int rg = 0;
#pragma unroll
            for (int d = 1; d < 8; ++d) { const float so = __shfl_xor(sel, d); rg += (so > sel || (so == sel && (lane ^ d) < lane)) ? 1 : 0; }
            float gs = rg < 2 ? sel : 0.f; gs += __shfl_xor(gs, 1); gs += __shfl_xor(gs, 2); gs += __shfl_xor(gs, 4);
            const int g = lane >> 3; int rk = 0;
#pragma unroll
            for (int g2 = 0; g2 < 8; ++g2) { const float go = __int_as_float(__builtin_amdgcn_readlane(__float_as_int(gs), 8 * g2)); rk += (go > gs || (go == gs && g2 < g)) ? 1 : 0; }
            const float selm = rk < 4 ? sel : -1e30f;
            int rank = 0;
#pragma unroll 4
            for (int e2 = 0; e2 < 64; ++e2) { const float so = __int_as_float(__builtin_amdgcn_readlane(__float_as_int(selm), e2)); rank += (so > selm || (so == selm && e2 < lane)) ? 1 : 0; }
            const bool chosen = rank < 8;
            const float wsum = wave_sum(chosen ? sc : 0.f);
            if (chosen) { const float wgt = sc * (2.5f / wsum); const unsigned pos = atomicAdd(a.cnt + 64 * lane, 1u);
                u32x2 rec; rec.x = (unsigned)(tok * 16 + rank); rec.y = ((unsigned)tok << 18) | ((unsigned)rank << 14) | (unsigned)(wgt * (16383.0f / 2.5f) + 0.5f);
                *(u32x2*)(a.lists + 2 * ((size_t)lane * LISTCAP + pos)) = rec; }
        }
    }
}
struct AttnState { float m, l; f32x4 o[8]; };
__device__ __forceinline__ void attn_init(AttnState& st) { st.m = -1e30f; st.l = 0.f;
#pragma unroll
    for (int c = 0; c < 8; ++c) st.o[c] = (f32x4){0.f, 0.f, 0.f, 0.f}; }
__device__ __forceinline__ void attn_scores(const LAS unsigned char* lds, unsigned kb, const bf16x8 (&qf)[4], f32x4 (&s)[4], int fr, int fq) {
#pragma unroll
    for (int kt = 0; kt < 4; ++kt) { s[kt] = (f32x4){0.f, 0.f, 0.f, 0.f};
#pragma unroll
        for (int ks = 0; ks < 4; ++ks) { const bf16x8 kf = *(const LAS bf16x8*)(lds + kb + off_b(16 * kt + fr, 4 * ks + fq)); s[kt] = MFMA16(kf, qf[ks], s[kt]); } }
}
__device__ __forceinline__ void attn_update(unsigned ldsbase, unsigned vb, f32x4 (&s)[4], AttnState& st, int lane) {
    float mx = -1e30f;
#pragma unroll
    for (int kt = 0; kt < 4; ++kt)
#pragma unroll
        for (int r = 0; r < 4; ++r) mx = fmaxf(mx, s[kt][r]);
    mx = fmaxf(mx, __shfl_xor(mx, 16)); mx = fmaxf(mx, __shfl_xor(mx, 32));
    const float mn = fmaxf(st.m, mx), alpha = __expf(st.m - mn);
    float ps = 0.f;
#pragma unroll
    for (int kt = 0; kt < 4; ++kt)
#pragma unroll
        for (int r = 0; r < 4; ++r) { const float p = __expf(s[kt][r] - mn); s[kt][r] = p; ps += p; }
    ps += __shfl_xor(ps, 16); ps += __shfl_xor(ps, 32);
    st.l = st.l * alpha + ps; st.m = mn;
#pragma unroll
    for (int c = 0; c < 8; ++c) st.o[c] = st.o[c] * alpha;
    const unsigned g = lane >> 4, q = (lane & 15) >> 2, p = lane & 3, xm = (q << 2) | g;
#pragma unroll
    for (int ks = 0; ks < 2; ++ks) {
        u32x4 pw; pw.x = cvt_pk_bf16(s[2 * ks][0], s[2 * ks][1]); pw.y = cvt_pk_bf16(s[2 * ks][2], s[2 * ks][3]); pw.z = cvt_pk_bf16(s[2 * ks + 1][0], s[2 * ks + 1][1]); pw.w = cvt_pk_bf16(s[2 * ks + 1][2], s[2 * ks + 1][3]);
        const bf16x8 pf = __builtin_bit_cast(bf16x8, pw);
        s16x4 v0[8], v1[8];
#pragma unroll
        for (int c = 0; c < 8; ++c) {
            const unsigned chunk = ((2u * c + (p >> 1)) ^ xm) * 16u + 8u * (p & 1u);
            v0[c] = tr_read(ldsbase + vb + 256u * (32u * ks + 4u * g + q) + chunk);
            v1[c] = tr_read(ldsbase + vb + 256u * (32u * ks + 16u + 4u * g + q) + chunk); }
        asm volatile("s_waitcnt lgkmcnt(0)" : "+v"(v0[0]), "+v"(v0[1]), "+v"(v0[2]), "+v"(v0[3]), "+v"(v0[4]), "+v"(v0[5]), "+v"(v0[6]), "+v"(v0[7]) :: "memory");
        asm volatile("" : "+v"(v1[0]), "+v"(v1[1]), "+v"(v1[2]), "+v"(v1[3]), "+v"(v1[4]), "+v"(v1[5]), "+v"(v1[6]), "+v"(v1[7]) :: "memory");
#pragma unroll
        for (int c = 0; c < 8; ++c) st.o[c] = MFMA16(cat8(v0[c], v1[c]), pf, st.o[c]);
    }
}
#define STAGE_TILE(ldsoff, nrows, ROWPTR) do { for (int _n = F.tid; _n < (nrows) * 16; _n += NTHREADS) { const int _r = _n >> 4, _ch = _n & 15; \
        const u32x4 _v = *(const u32x4*)((const char*)(ROWPTR(_r)) + _ch * 16); *(LAS u32x4*)(F.lds + (ldsoff) + off_b(_r, _ch)) = _v; } } while (0)

struct DilItem { int br, dil, b, h, res, n, seq; };
__device__ __forceinline__ DilItem dil_make(int w, int k) { DilItem d;
    if (k < 4) { const int s = w >> 3; d.br = 0; d.dil = 1; d.b = s >> 3; d.h = s & 7; d.res = 0; d.n = (w & 7) * 4 + k; d.seq = s; }
    else if (k < 8) { const int s = w >> 1; d.br = 1; d.dil = 4; d.b = s >> 5; d.h = (s >> 2) & 7; d.res = s & 3; d.n = (w & 1) * 4 + (k - 4); d.seq = 32 + s; }
    else { const int s = 2 * w + ((k - 8) >> 1); d.br = 2; d.dil = 16; d.b = s >> 7; d.h = (s >> 4) & 7; d.res = s & 15; d.n = (k - 8) & 1; d.seq = 160 + s; }
    return d; }
__device__ __forceinline__ void dilated_items(const Frame& F) {
    const bf16_t* proj = (const bf16_t*)(F.ws + WS_PROJ);
    const int lane = F.lane, wave = F.wave, fr = lane & 15, fq = lane >> 4;
    const unsigned ldsbase = (unsigned)(size_t)F.lds;
    constexpr int KOFF = 0, VOFF = 65536, BOFF = 131072;
    const int sr = F.tid >> 4, sch = F.tid & 15;
    u32x4 rk[8], rv[8];
#define DIL_TOKF(d, ki) ((size_t)(d).b * SEQ + (size_t)(128 * ((d).n - 1) + (ki)) * (d).dil + (d).res)
#define DIL_LD1(d, _i) do { const bf16_t* _p = proj + DIL_TOKF(d, sr + 32 * (_i)) * IN0W + 128 * (d).h + 8 * sch; rk[_i] = *(const u32x4*)(_p + 1024); rv[_i] = *(const u32x4*)(_p + 2048); } while (0)
#define DIL_LOAD(d, reuse) do { DIL_LD1(d, 4); DIL_LD1(d, 5); DIL_LD1(d, 6); DIL_LD1(d, 7); \
        if ((d).n > 0 && !(reuse)) { DIL_LD1(d, 0); DIL_LD1(d, 1); DIL_LD1(d, 2); DIL_LD1(d, 3); } } while (0)
    int w = F.bid, k = 0; if (w >= 256) return;
    DilItem d = dil_make(w, 0);
    bool reuse = false; int ph = 1;
    DIL_LOAD(d, false);
    for (;;) {
        __syncthreads();
#pragma unroll
        for (int i = 4; i < 8; ++i) { const unsigned o_ = off_b(128 * ph + sr + 32 * (i - 4), sch); *(LAS u32x4*)(F.lds + KOFF + o_) = rk[i]; *(LAS u32x4*)(F.lds + VOFF + o_) = rv[i]; }
        if (d.n > 0 && !reuse) {
#pragma unroll
            for (int i = 0; i < 4; ++i) { const unsigned o_ = off_b(128 * (ph ^ 1) + sr + 32 * i, sch); *(LAS u32x4*)(F.lds + KOFF + o_) = rk[i]; *(LAS u32x4*)(F.lds + VOFF + o_) = rv[i]; } }
        if (F.tid < 132) ((LAS float*)(F.lds + BOFF))[F.tid] = ((const float*)(F.ws + WS_BIASREL))[(d.br * 8 + d.h) * 132 + F.tid];
        bf16x8 qf[4];
        { const size_t qt_ = (size_t)d.b * SEQ + (size_t)(128 * d.n + 16 * wave + fr) * d.dil + d.res;
#pragma unroll
          for (int ks = 0; ks < 4; ++ks) qf[ks] = *(const bf16x8*)(proj + qt_ * IN0W + 128 * d.h + 32 * ks + 8 * fq); }
        const DilItem c = d; const int cph = ph;
        int nk = k + 1, nw = w; if (nk == 12) { nk = 0; nw = w + F.G; }
        const bool has_next = nw < 256;
        if (has_next) { d = dil_make(nw, nk); reuse = (d.seq == c.seq) && (d.n == c.n + 1); ph = reuse ? (cph ^ 1) : 1; DIL_LOAD(d, reuse); }
        __syncthreads();
        const int qi = 16 * wave + fr; const size_t qtok = (size_t)c.b * SEQ + (size_t)(128 * c.n + qi) * c.dil + c.res;
        AttnState st; attn_init(st);
        const LAS float* bt = (const LAS float*)(F.lds + BOFF);
#pragma unroll 1
        for (int j = (c.n == 0 ? 2 : 0); j < 4; ++j) {
            if (64 * j > 16 * wave + 15 + 128 || 64 * j + 63 < 16 * wave) continue;
            const int jp = j ^ ((cph ^ 1) << 1);
            f32x4 s[4];
            attn_scores(F.lds, KOFF + jp * 16384, qf, s, fr, fq);
#pragma unroll
            for (int kt = 0; kt < 4; ++kt)
#pragma unroll
                for (int r = 0; r < 4; ++r) { const int ki = 64 * j + 16 * kt + 4 * fq + r, rel = qi + 128 - ki; const bool ok = rel >= 0 && rel <= 128; const int rc = ok ? rel : 0;
                    s[kt][r] = ok ? s[kt][r] * ATT_SCALE + bt[rc] : -1e30f; }
            attn_update(ldsbase, VOFF + jp * 16384, s, st, lane);
        }
        const float inv = 1.0f / st.l; bf16_t* ob = (bf16_t*)(F.ws + WS_OBR) + ((size_t)c.br * NTOK + qtok) * 1024 + 128 * c.h;
#pragma unroll
        for (int cc = 0; cc < 8; ++cc) { u32x2 w_; w_.x = cvt_pk_bf16(st.o[cc][0] * inv, st.o[cc][1] * inv); w_.y = cvt_pk_bf16(st.o[cc][2] * inv, st.o[cc][3] * inv); *(u32x2*)(ob + 16 * cc + 4 * fq) = w_; }
        if (fq == 0) ((float*)(F.ws + WS_LSE))[((size_t)c.br * NTOK + qtok) * 8 + c.h] = st.m + __logf(st.l);
        if (!has_next) break;
        k = nk; w = nw;
    }
#undef DIL_TOKF
#undef DIL_LD1
#undef DIL_LOAD
}
__device__ __forceinline__ void combine_tokens(const Frame& F) {
    const int gw = F.bid * NWAVES + F.wave, NGW = F.G * NWAVES, lane = F.lane, h = lane >> 3;
    const bf16_t* ob = (const bf16_t*)(F.ws + WS_OBR); const float* lse = (const float*)(F.ws + WS_LSE); unsigned char* a2 = F.ws + WS_A2Q;
    for (int tok = gw; tok < NTOK; tok += NGW) {
        const float l0 = lse[((size_t)0 * NTOK + tok) * 8 + h], l1 = lse[((size_t)1 * NTOK + tok) * 8 + h], l2 = lse[((size_t)2 * NTOK + tok) * 8 + h];
        const float m = fmaxf(l0, fmaxf(l1, l2)); const float e0 = __expf(l0 - m), e1 = __expf(l1 - m), e2 = __expf(l2 - m), inv = 1.0f / (e0 + e1 + e2);
        const float w[3] = {e0 * inv, e1 * inv, e2 * inv};
        float acc[16];
#pragma unroll
        for (int j = 0; j < 16; ++j) acc[j] = 0.f;
#pragma unroll
        for (int b3 = 0; b3 < 3; ++b3) { const u32x4* p = (const u32x4*)(ob + ((size_t)b3 * NTOK + tok) * 1024 + 16 * lane); const u32x4 x0 = __builtin_nontemporal_load(p), x1 = __builtin_nontemporal_load(p + 1);
            acc[0] += w[b3] * bf_lo(x0.x); acc[1] += w[b3] * bf_hi(x0.x); acc[2] += w[b3] * bf_lo(x0.y); acc[3] += w[b3] * bf_hi(x0.y);
            acc[4] += w[b3] * bf_lo(x0.z); acc[5] += w[b3] * bf_hi(x0.z); acc[6] += w[b3] * bf_lo(x0.w); acc[7] += w[b3] * bf_hi(x0.w);
            acc[8] += w[b3] * bf_lo(x1.x); acc[9] += w[b3] * bf_hi(x1.x); acc[10] += w[b3] * bf_lo(x1.y); acc[11] += w[b3] * bf_hi(x1.y);
            acc[12] += w[b3] * bf_lo(x1.z); acc[13] += w[b3] * bf_hi(x1.z); acc[14] += w[b3] * bf_lo(x1.w); acc[15] += w[b3] * bf_hi(x1.w); }
        u32x4 o; o.x = cvt_pk4_fp8(acc[0], acc[1], acc[2], acc[3]); o.y = cvt_pk4_fp8(acc[4], acc[5], acc[6], acc[7]); o.z = cvt_pk4_fp8(acc[8], acc[9], acc[10], acc[11]); o.w = cvt_pk4_fp8(acc[12], acc[13], acc[14], acc[15]);
        *(u32x4*)(a2 + (size_t)tok * D + 16 * lane) = o;
    }
}
__device__ __forceinline__ void fox_item(const Frame& F, int item) {
    const int rnd = item >> 8, cc = item & 255, bh = cc & 63, g4 = cc >> 6; const int qb = 31 - (4 * rnd + ((rnd & 1) ? 3 - g4 : g4));
    const int b = bh >> 4, h = bh & 15;
    const bf16_t* proj = (const bf16_t*)(F.ws + WS_PROJ); const float* cbase = (const float*)(F.ws + WS_CC) + (size_t)bh * SEQ;
    const int lane = F.lane, wave = F.wave, fr = lane & 15, fq = lane >> 4;
    const unsigned ldsbase = (unsigned)(size_t)F.lds;
    constexpr int BUFB = 33792;
    const int qrow = 128 * qb + 16 * wave + fr; const size_t qtok = (size_t)b * SEQ + qrow;
    bf16x8 qf[4];
#pragma unroll
    for (int ks = 0; ks < 4; ++ks) qf[ks] = *(const bf16x8*)(proj + qtok * IN1W + 128 * h + 32 * ks + 8 * fq);
    const float cq = cbase[qrow];
    const int j0 = 2 * qb + 1;
    float qk;
    { const unsigned* kn = (const unsigned*)(F.ws + WS_CTL) + CW_KN + bh * 4; const float kmax = sqrtf(__uint_as_float(kn[0]) + __uint_as_float(kn[1]) + __uint_as_float(kn[2]) + __uint_as_float(kn[3]));
      float qs = 0.f;
#pragma unroll
      for (int ks = 0; ks < 4; ++ks) { const u32x4 w = __builtin_bit_cast(u32x4, qf[ks]);
          qs += bf_lo(w.x) * bf_lo(w.x) + bf_hi(w.x) * bf_hi(w.x) + bf_lo(w.y) * bf_lo(w.y) + bf_hi(w.y) * bf_hi(w.y) + bf_lo(w.z) * bf_lo(w.z) + bf_hi(w.z) * bf_hi(w.z) + bf_lo(w.w) * bf_lo(w.w) + bf_hi(w.w) * bf_hi(w.w); }
      qs += __shfl_xor(qs, 16); qs += __shfl_xor(qs, 32); qk = sqrtf(qs) * kmax * ATT_SCALE; }
    LAS unsigned* pflag = (LAS unsigned*)(F.lds + 2 * BUFB);
    const int sr0 = F.tid >> 4, sch = F.tid & 15;
    u32x4 rk0, rk1, rv0, rv1; float rc = 0.f;
#define FOX_LOAD(j) do { const bf16_t* _p0 = proj + ((size_t)b * SEQ + 64 * (j) + sr0) * IN1W + 128 * h + 8 * sch; const bf16_t* _p1 = _p0 + (size_t)32 * IN1W; \
        rk0 = *(const u32x4*)(_p0 + 2048); rk1 = *(const u32x4*)(_p1 + 2048); rv0 = *(const u32x4*)(_p0 + 4096); rv1 = *(const u32x4*)(_p1 + 4096); if (F.tid < 64) rc = cbase[64 * (j) + F.tid]; } while (0)
#define FOX_WRITE(bufo) do { *(LAS u32x4*)(F.lds + (bufo) + off_b(sr0, sch)) = rk0; *(LAS u32x4*)(F.lds + (bufo) + off_b(sr0 + 32, sch)) = rk1; \
        *(LAS u32x4*)(F.lds + (bufo) + 16384 + off_b(sr0, sch)) = rv0; *(LAS u32x4*)(F.lds + (bufo) + 16384 + off_b(sr0 + 32, sch)) = rv1; if (F.tid < 64) ((LAS float*)(F.lds + (bufo) + 32768))[F.tid] = rc; } while (0)
    __syncthreads();
    FOX_LOAD(j0); FOX_WRITE(0);
    __syncthreads();
    AttnState st; attn_init(st);
    int cur = 0;
#pragma unroll 1
    for (int j = j0; j >= 0; --j) {
        if (j > 0) FOX_LOAD(j - 1);
        const int bufo = cur * BUFB;
        if (64 * j <= 128 * qb + 16 * wave + 15) {
            f32x4 s[4];
            attn_scores(F.lds, bufo, qf, s, fr, fq);
            const LAS float* ck = (const LAS float*)(F.lds + bufo + 32768);
#pragma unroll
            for (int kt = 0; kt < 4; ++kt) { const f32x4 c4 = *(const LAS f32x4*)(ck + 16 * kt + 4 * fq);
#pragma unroll
                for (int r = 0; r < 4; ++r) { const int key = 64 * j + 16 * kt + 4 * fq + r; s[kt][r] = key <= qrow ? s[kt][r] * ATT_SCALE + (cq - c4[r]) : -1e30f; } }
            attn_update(ldsbase, bufo + 16384, s, st, lane);
        }
        if (j > 0) { const float cend = cbase[64 * j - 1];
            const bool need = qk + (cq - cend) - st.m >= -FOX_T;
            const bool anyneed = __any(need);
            if (lane == 0) pflag[cur * 8 + wave] = anyneed ? 1u : 0u;
            FOX_WRITE((cur ^ 1) * BUFB); }
        __syncthreads();
        if (j > 0) { const u32x4 f0 = *(const LAS u32x4*)(pflag + cur * 8), f1 = *(const LAS u32x4*)(pflag + cur * 8 + 4);
            if ((f0.x | f0.y | f0.z | f0.w | f1.x | f1.y | f1.z | f1.w) == 0u) break; }
        cur ^= 1;
    }
    const float inv = 1.0f / st.l; unsigned char* ob = F.ws + WS_A2Q + qtok * D + 128 * h;
#pragma unroll
    for (int c = 0; c < 8; ++c) *(unsigned*)(ob + 16 * c + 4 * fq) = cvt_pk4_fp8(st.o[c][0] * inv, st.o[c][1] * inv, st.o[c][2] * inv, st.o[c][3] * inv);
#undef FOX_LOAD
#undef FOX_WRITE
}
__device__ __forceinline__ unsigned raw_off(int t, int k) { return (unsigned)(t * 256 + ((((k >> 3) ^ (t & 15))) << 4) + (k & 7) * 2); }
__device__ __forceinline__ unsigned raw_chunk(int t, int ch) { return (unsigned)(t * 256 + ((ch ^ (t & 15)) << 4)); }
#define HG_PART_OFF 133120
#ifndef PRB_HA
#define PRB_HA 1
#define PRB_HC 1
#define PRB_DIL 1
#endif
#define HGRN_FRONT(F_OFF, H) \
    const int k_ = F.tid & 127, tq_ = F.tid >> 7; const float lbk_ = ((const float*)(F.ws + WS_LB))[128 * (H) + k_]; \
    float a16[16], key16[16]; { float run_ = 0.f; \
    _Pragma("unroll") for (int i = 0; i < 16; ++i) { const float fl_ = bf2f(*(const LAS bf16_t*)(F.lds + (F_OFF) + raw_off(16 * tq_ + i, k_))); \
        const float fo_ = lbk_ + (1.0f - lbk_) * sigmoidf_(fl_); run_ += __logf(fo_); a16[i] = run_; key16[i] = 1.0f - fo_; } \
    ((LAS float*)(F.lds + HG_PART_OFF))[tq_ * 128 + k_] = run_; } \
    __syncthreads(); \
    float aoff_ = 0.f, atot_ = 0.f; \
    _Pragma("unroll") for (int q = 0; q < 4; ++q) { const float p_ = ((const LAS float*)(F.lds + HG_PART_OFF))[q * 128 + k_]; atot_ += p_; aoff_ += q < tq_ ? p_ : 0.f; } \
    _Pragma("unroll") for (int i = 0; i < 16; ++i) a16[i] += aoff_;

__device__ __forceinline__ void hgrn_a_items(const Frame& F) {
    const bf16_t* proj = (const bf16_t*)(F.ws + WS_PROJ);
    const int lane = F.lane, wave = F.wave, fr = lane & 15, fq = lane >> 4;
    const unsigned ldsbase = (unsigned)(size_t)F.lds;
    constexpr int KD_OFF = 0, VAL_OFF = 20480, F_OFF = 40960;
    const int sr = F.tid >> 4, sch = F.tid & 15;
    u32x4 rf[2], rv[2];
#define HGA_LOAD(it_) do { const int _bh = (it_) >> 6, _c = (it_) & 63, _t0 = (_bh >> 3) * SEQ + 64 * _c, _h = _bh & 7; \
        _Pragma("unroll") for (int _i = 0; _i < 2; ++_i) { const bf16_t* _p = proj + (size_t)(_t0 + sr + 32 * _i) * IN0W + 128 * _h + 8 * sch; rf[_i] = *(const u32x4*)(_p + 4096); rv[_i] = *(const u32x4*)(_p + 5120); } } while (0)
    int itx = F.bid; if (itx >= 2048 * PRB_HA) return;
    HGA_LOAD(itx & 2047);
    for (;;) {
        const int it = itx & 2047;
        const int h = (it >> 6) & 7;
        __syncthreads();
#pragma unroll
        for (int i = 0; i < 2; ++i) { *(LAS u32x4*)(F.lds + F_OFF + raw_chunk(sr + 32 * i, sch)) = rf[i]; *(LAS u32x4*)(F.lds + VAL_OFF + off_b(sr + 32 * i, sch)) = rv[i]; }
        const int nit = itx + F.G; const bool has_next = nit < 2048 * PRB_HA;
        if (has_next) HGA_LOAD(nit & 2047);
        __syncthreads();
        HGRN_FRONT(F_OFF, h)
        {
            u32x4 w0, w1; float kd[16];
#pragma unroll
            for (int i = 0; i < 16; ++i) kd[i] = key16[i] * __expf(atot_ - a16[i]);
            w0.x = cvt_pk_bf16(kd[0], kd[1]); w0.y = cvt_pk_bf16(kd[2], kd[3]); w0.z = cvt_pk_bf16(kd[4], kd[5]); w0.w = cvt_pk_bf16(kd[6], kd[7]);
            w1.x = cvt_pk_bf16(kd[8], kd[9]); w1.y = cvt_pk_bf16(kd[10], kd[11]); w1.z = cvt_pk_bf16(kd[12], kd[13]); w1.w = cvt_pk_bf16(kd[14], kd[15]);
            *(LAS u32x4*)(F.lds + KD_OFF + k_ * 144 + tq_ * 32) = w0; *(LAS u32x4*)(F.lds + KD_OFF + k_ * 144 + tq_ * 32 + 16) = w1;
            if (tq_ == 0) ((float*)(F.ws + WS_ALAST))[(size_t)it * 128 + k_] = atot_;
        }
        __syncthreads();
        const unsigned g = lane >> 4, q = (lane & 15) >> 2, p = lane & 3;
        bf16x8 af[2];
        {   s16x4 x0[2], x1[2];
#pragma unroll
            for (int ks = 0; ks < 2; ++ks) { x0[ks] = tr_read(ldsbase + VAL_OFF + off_b(32 * ks + 8 * g + q, 2 * wave + (p >> 1)) + 8 * (p & 1));
                x1[ks] = tr_read(ldsbase + VAL_OFF + off_b(32 * ks + 8 * g + 4 + q, 2 * wave + (p >> 1)) + 8 * (p & 1)); }
            asm volatile("s_waitcnt lgkmcnt(0)" : "+v"(x0[0]), "+v"(x0[1]), "+v"(x1[0]), "+v"(x1[1]) :: "memory");
            af[0] = cat8(x0[0], x1[0]); af[1] = cat8(x0[1], x1[1]); }
        bf16_t* lt = (bf16_t*)(F.ws + WS_LT) + (size_t)it * 16384;
#pragma unroll
        for (int nt = 0; nt < 8; ++nt) { f32x4 acc = (f32x4){0.f, 0.f, 0.f, 0.f};
#pragma unroll
            for (int ks = 0; ks < 2; ++ks) { const bf16x8 bfr = *(const LAS bf16x8*)(F.lds + KD_OFF + (16 * nt + fr) * 144 + (32 * ks + 8 * fq) * 2); acc = MFMA16(af[ks], bfr, acc); }
#pragma unroll
            for (int r = 0; r < 4; ++r) { unsigned ub = __float_as_uint(acc[r]); ub = (ub + 0x7fffu + ((ub >> 16) & 1u)) >> 16;
                lt[(size_t)(16 * wave + 4 * fq + r) * 128 + 16 * nt + fr] = (bf16_t)ub; } }
        if (!has_next) break;
        itx = nit;
    }
#undef HGA_LOAD
}
__device__ __forceinline__ void hgrn_scan(const Frame& F) {
    const int gt = F.bid * NTHREADS + F.tid, GT = F.G * NTHREADS;
    const bf16_t* lt = (const bf16_t*)(F.ws + WS_LT); const float* al = (const float*)(F.ws + WS_ALAST); bf16_t* st = (bf16_t*)(F.ws + WS_ST);
    for (int e = gt; e < 32 * 128 * 32; e += GT) { const int bh = e >> 12, v = (e >> 5) & 127, k4 = (e & 31) * 4;
        f32x4 s = (f32x4){0.f, 0.f, 0.f, 0.f};
#pragma unroll 4
        for (int c = 0; c < 64; ++c) { const size_t it = (size_t)bh * 64 + c; const size_t o = (it * 128 + v) * 128 + k4;
            u32x2 w; w.x = cvt_pk_bf16(s[0], s[1]); w.y = cvt_pk_bf16(s[2], s[3]); *(u32x2*)(st + o) = w;
            const u32x2 lw = __builtin_nontemporal_load((const u32x2*)(lt + o)); const f32x4 l = (f32x4){bf_lo(lw.x), bf_hi(lw.x), bf_lo(lw.y), bf_hi(lw.y)}, a = *(const f32x4*)(al + it * 128 + k4);
            s[0] = __expf(a[0]) * s[0] + l[0]; s[1] = __expf(a[1]) * s[1] + l[1]; s[2] = __expf(a[2]) * s[2] + l[2]; s[3] = __expf(a[3]) * s[3] + l[3]; } }
}
__device__ __forceinline__ void hgrn_c_items(const Frame& F) {
    const bf16_t* proj = (const bf16_t*)(F.ws + WS_PROJ);
    const int lane = F.lane, wave = F.wave, fr = lane & 15, fq = lane >> 4;
    const unsigned ldsbase = (unsigned)(size_t)F.lds;
    constexpr int A_OFF = 0, F_OFF = 34816, Q_OFF = 51200, G_OFF = 67584, VAL_OFF = 83968, ST_OFF = 100352, RMS_OFF = 135168;
    static_assert(G_OFF + 16384 <= VAL_OFF && VAL_OFF + 16384 <= ST_OFF && ST_OFF + 32768 <= HG_PART_OFF && HG_PART_OFF + 2048 <= RMS_OFF && RMS_OFF + 512 <= LDS_MISC, "LDS map");
    const int sr = F.tid >> 4, sch = F.tid & 15;
    u32x4 rf[2], rq[2], rv[2], rg[2], rs[4];
#define HGC_LOAD(it_) do { const int _bh = (it_) >> 6, _c = (it_) & 63, _t0 = (_bh >> 3) * SEQ + 64 * _c, _h = _bh & 7; \
        _Pragma("unroll") for (int _i = 0; _i < 2; ++_i) { const bf16_t* _p = proj + (size_t)(_t0 + sr + 32 * _i) * IN0W + 128 * _h + 8 * sch; \
            rq[_i] = __builtin_nontemporal_load((const u32x4*)(_p + 3072)); rf[_i] = __builtin_nontemporal_load((const u32x4*)(_p + 4096)); rv[_i] = __builtin_nontemporal_load((const u32x4*)(_p + 5120)); rg[_i] = __builtin_nontemporal_load((const u32x4*)(_p + 6144)); } \
        _Pragma("unroll") for (int _i = 0; _i < 4; ++_i) rs[_i] = __builtin_nontemporal_load((const u32x4*)((const bf16_t*)(F.ws + WS_ST) + ((size_t)(it_) * 128 + sr + 32 * _i) * 128 + 8 * sch)); } while (0)
    int itx = F.bid; if (itx >= 2048 * PRB_HC) return;
    HGC_LOAD(itx & 2047);
    for (;;) {
        const int it = itx & 2047;
        const int bh = it >> 6, c = it & 63, b = bh >> 3, h = bh & 7, t0 = b * SEQ + 64 * c;
        __syncthreads();
#pragma unroll
        for (int i = 0; i < 2; ++i) { const unsigned ro = raw_chunk(sr + 32 * i, sch);
            *(LAS u32x4*)(F.lds + F_OFF + ro) = rf[i]; *(LAS u32x4*)(F.lds + Q_OFF + ro) = rq[i]; *(LAS u32x4*)(F.lds + G_OFF + ro) = rg[i]; *(LAS u32x4*)(F.lds + VAL_OFF + off_b(sr + 32 * i, sch)) = rv[i]; }
#pragma unroll
        for (int i = 0; i < 4; ++i) *(LAS u32x4*)(F.lds + ST_OFF + off_b(sr + 32 * i, sch)) = rs[i];
        const int nit = itx + F.G; const bool has_next = nit < 2048 * PRB_HC;
        if (has_next) HGC_LOAD(nit & 2047);
        __syncthreads();
        {
        HGRN_FRONT(F_OFF, h)
#pragma unroll
        for (int i = 0; i < 16; ++i) { const int t = 16 * tq_ + i; ((LAS float*)(F.lds + A_OFF))[t * 132 + k_] = a16[i];
            LAS bf16_t* qp = (LAS bf16_t*)(F.lds + Q_OFF + raw_off(t, k_)); *qp = (bf16_t)(cvt_pk_bf16(siluf_(bf2f(*qp)), 0.f) & 0xffffu);
            *(LAS bf16_t*)(F.lds + F_OFF + raw_off(t, k_)) = (bf16_t)(cvt_pk_bf16(key16[i], 0.f) & 0xffffu); }
        }
        __syncthreads();
        const int vh = wave >> 2, I = vh ? 3 - (wave & 3) : (wave & 3);
        const LAS float* al = (const LAS float*)(F.lds + A_OFF);
        f32x4 o[4];
#pragma unroll
        for (int c4 = 0; c4 < 4; ++c4) o[c4] = (f32x4){0.f, 0.f, 0.f, 0.f};
        bf16x8 qh[4];
#pragma unroll
        for (int ks = 0; ks < 4; ++ks) {
            const int t = 16 * I + fr, k = 32 * ks + 8 * fq;
            const u32x4 fw = *(const LAS u32x4*)(F.lds + Q_OFF + raw_chunk(t, 4 * ks + fq));
            const f32x4 a0 = *(const LAS f32x4*)(al + t * 132 + k), a1 = *(const LAS f32x4*)(al + t * 132 + k + 4);
            f32x4 r0 = (f32x4){0.f, 0.f, 0.f, 0.f}, r1 = r0;
            if (I > 0) { r0 = *(const LAS f32x4*)(al + (16 * I - 1) * 132 + k); r1 = *(const LAS f32x4*)(al + (16 * I - 1) * 132 + k + 4); }
            const float f0 = bf_lo(fw.x), f1 = bf_hi(fw.x), f2 = bf_lo(fw.y), f3 = bf_hi(fw.y), f4 = bf_lo(fw.z), f5 = bf_hi(fw.z), f6 = bf_lo(fw.w), f7 = bf_hi(fw.w);
            u32x4 qi; qi.x = cvt_pk_bf16(f0 * __expf(a0[0]), f1 * __expf(a0[1])); qi.y = cvt_pk_bf16(f2 * __expf(a0[2]), f3 * __expf(a0[3]));
            qi.z = cvt_pk_bf16(f4 * __expf(a1[0]), f5 * __expf(a1[1])); qi.w = cvt_pk_bf16(f6 * __expf(a1[2]), f7 * __expf(a1[3]));
            u32x4 qr; qr.x = cvt_pk_bf16(f0 * __expf(a0[0] - r0[0]), f1 * __expf(a0[1] - r0[1])); qr.y = cvt_pk_bf16(f2 * __expf(a0[2] - r0[2]), f3 * __expf(a0[3] - r0[3]));
            qr.z = cvt_pk_bf16(f4 * __expf(a1[0] - r1[0]), f5 * __expf(a1[1] - r1[1])); qr.w = cvt_pk_bf16(f6 * __expf(a1[2] - r1[2]), f7 * __expf(a1[3] - r1[3]));
            qh[ks] = __builtin_bit_cast(bf16x8, qr);
            const bf16x8 qib = __builtin_bit_cast(bf16x8, qi);
#pragma unroll
            for (int c4 = 0; c4 < 4; ++c4) { const bf16x8 sf = *(const LAS bf16x8*)(F.lds + ST_OFF + off_b(16 * (4 * vh + c4) + fr, 4 * ks + fq)); o[c4] = MFMA16(sf, qib, o[c4]); }
        }
        f32x4 sc[4];
#pragma unroll
        for (int J = 0; J < 4; ++J) { sc[J] = (f32x4){0.f, 0.f, 0.f, 0.f};
            if (J <= I && (J & 1) == vh) {
#pragma unroll
                for (int ks = 0; ks < 4; ++ks) {
                    const int s = 16 * J + fr, k = 32 * ks + 8 * fq;
                    const u32x4 kw = *(const LAS u32x4*)(F.lds + F_OFF + raw_chunk(s, 4 * ks + fq));
                    const f32x4 a0 = *(const LAS f32x4*)(al + s * 132 + k), a1 = *(const LAS f32x4*)(al + s * 132 + k + 4);
                    f32x4 r0 = (f32x4){0.f, 0.f, 0.f, 0.f}, r1 = r0;
                    if (I > 0) { r0 = *(const LAS f32x4*)(al + (16 * I - 1) * 132 + k); r1 = *(const LAS f32x4*)(al + (16 * I - 1) * 132 + k + 4); }
                    u32x4 kh; kh.x = cvt_pk_bf16(bf_lo(kw.x) * __expf(r0[0] - a0[0]), bf_hi(kw.x) * __expf(r0[1] - a0[1])); kh.y = cvt_pk_bf16(bf_lo(kw.y) * __expf(r0[2] - a0[2]), bf_hi(kw.y) * __expf(r0[3] - a0[3]));
                    kh.z = cvt_pk_bf16(bf_lo(kw.z) * __expf(r1[0] - a1[0]), bf_hi(kw.z) * __expf(r1[1] - a1[1])); kh.w = cvt_pk_bf16(bf_lo(kw.w) * __expf(r1[2] - a1[2]), bf_hi(kw.w) * __expf(r1[3] - a1[3]));
                    sc[J] = MFMA16(__builtin_bit_cast(bf16x8, kh), qh[ks], sc[J]);
                }
#pragma unroll
                for (int r = 0; r < 4; ++r) sc[J][r] = (J < I || (4 * fq + r) <= fr) ? sc[J][r] : 0.f;
            }
        }
        const unsigned g = lane >> 4, q = (lane & 15) >> 2, p = lane & 3, xm = (q << 2) | g;
        LAS u32x2* xch = (LAS u32x2*)(F.lds + LDS_REC);
        u32x2 own[2];
#pragma unroll
        for (int ks = 0; ks < 2; ++ks) {
            const f32x4 se = sc[2 * ks], so = sc[2 * ks + 1];
            const float x0 = vh ? so[0] : se[0], x1 = vh ? so[1] : se[1], x2 = vh ? so[2] : se[2], x3 = vh ? so[3] : se[3];
            own[ks].x = cvt_pk_bf16(x0, x1); own[ks].y = cvt_pk_bf16(x2, x3);
            xch[((I * 2 + ks) * 2 + vh) * 64 + lane] = own[ks]; }
        __syncthreads();
#pragma unroll
        for (int ks = 0; ks < 2; ++ks) {
            if (2 * ks <= I) {
                const u32x2 oth = xch[((I * 2 + ks) * 2 + (vh ^ 1)) * 64 + lane];
                u32x4 pw; pw.x = vh ? oth.x : own[ks].x; pw.y = vh ? oth.y : own[ks].y; pw.z = vh ? own[ks].x : oth.x; pw.w = vh ? own[ks].y : oth.y;
                const bf16x8 pf = __builtin_bit_cast(bf16x8, pw);
                s16x4 v0[4], v1[4];
#pragma unroll
                for (int c4 = 0; c4 < 4; ++c4) { const unsigned chunk = ((2u * (4 * vh + c4) + (p >> 1)) ^ xm) * 16u + 8u * (p & 1u);
                    v0[c4] = tr_read(ldsbase + VAL_OFF + 256u * (32u * ks + 4u * g + q) + chunk);
                    v1[c4] = tr_read(ldsbase + VAL_OFF + 256u * (32u * ks + 16u + 4u * g + q) + chunk); }
                asm volatile("s_waitcnt lgkmcnt(0)" : "+v"(v0[0]), "+v"(v0[1]), "+v"(v0[2]), "+v"(v0[3]), "+v"(v1[0]), "+v"(v1[1]), "+v"(v1[2]), "+v"(v1[3]) :: "memory");
#pragma unroll
                for (int c4 = 0; c4 < 4; ++c4) o[c4] = MFMA16(cat8(v0[c4], v1[c4]), pf, o[c4]);
            }
        }
        float ss = 0.f;
#pragma unroll
        for (int c4 = 0; c4 < 4; ++c4)
#pragma unroll
            for (int r = 0; r < 4; ++r) ss += o[c4][r] * o[c4][r];
        ss += __shfl_xor(ss, 16); ss += __shfl_xor(ss, 32);
        if (fq == 0) ((LAS float*)(F.lds + RMS_OFF))[vh * 64 + 16 * I + fr] = ss;
        __syncthreads();
        const float tot = ((const LAS float*)(F.lds + RMS_OFF))[16 * I + fr] + ((const LAS float*)(F.lds + RMS_OFF))[64 + 16 * I + fr];
        const float rstd = 1.0f / sqrtf(tot * (1.0f / 128.0f) + RMS_EPS);
        const size_t tok = (size_t)t0 + 16 * I + fr; const float* gn = F.in[4] + 128 * h; unsigned char* a2 = F.ws + WS_A2Q + tok * D + 1024 + 128 * h;
#pragma unroll
        for (int c4 = 0; c4 < 4; ++c4) { const int cc = 4 * vh + c4, v = 16 * cc + 4 * fq;
            const u32x2 gw = *(const LAS u32x2*)(F.lds + G_OFF + raw_chunk(16 * I + fr, 2 * cc + (fq >> 1)) + 8 * (fq & 1)); const f32x4 gg = *(const f32x4*)(gn + v);
            const float g0 = bf_lo(gw.x), g1 = bf_hi(gw.x), g2 = bf_lo(gw.y), g3 = bf_hi(gw.y);
            *(unsigned*)(a2 + v) = cvt_pk4_fp8(o[c4][0] * rstd * gg[0] * siluf_(g0), o[c4][1] * rstd * gg[1] * siluf_(g1), o[c4][2] * rstd * gg[2] * siluf_(g2), o[c4][3] * rstd * gg[3] * siluf_(g3)); }
        if (!has_next) break;
        itx = nit;
    }
#undef HGC_LOAD
}
__device__ __forceinline__ int build_tile_table(const Frame& F, const unsigned* cnt) {
    LAS int* cnts = (LAS int*)(F.lds + LDS_TT); LAS int* tstart = cnts + 72; LAS int* tt = cnts + 256;
    __syncthreads();
    if (F.wave == 0) {
        int c = (int)cnt[64 * F.lane]; c = c > LISTCAP ? LISTCAP : c;
        int n = (c + 255) >> 8, incl = n;
#pragma unroll
        for (int o = 1; o < 64; o <<= 1) { const int u = __shfl_up(incl, o); if (F.lane >= o) incl += u; }
        int s = incl - n;
        if (s > 640) s = 640;
        if (s + n > 640) { n = 640 - s; c = n * 256 < c ? n * 256 : c; }
        cnts[F.lane] = c; tstart[F.lane] = s; if (F.lane == 63) tstart[NE] = s + n;
        for (int ti = 0; ti < n; ++ti) { tt[2 * (s + ti)] = F.lane; tt[2 * (s + ti) + 1] = ti; }
    }
    __syncthreads();
    return tstart[NE];
}
__device__ __forceinline__ int reuse_tile_table(const Frame& F) { return ((const LAS int*)(F.lds + LDS_TT))[72 + NE]; }

__device__ __forceinline__ void phase_stagger(const Frame& F, int groups, int step_ticks) {
    const unsigned long long t0 = __builtin_amdgcn_s_memrealtime(); const unsigned long long wait = (unsigned long long)(((F.bid >> 3) % groups) * step_ticks);
    while (__builtin_amdgcn_s_memrealtime() - t0 < wait) __builtin_amdgcn_s_sleep(4);
}
#ifndef STG_DOWN_G
#define STG_DOWN_G 1
#define STG_DOWN_T 0
#endif
struct Args { const float* in[21]; float* out; unsigned char* ws; int ph_lo, ph_hi; };
constexpr int N_PHASES = 18;

__global__ void __launch_bounds__(NTHREADS, 2) hybrid_fwd(Args args) {
    extern __shared__ __attribute__((aligned(16))) unsigned char lds_raw[];
    Frame F0;
    F0.lds = (LAS unsigned char*)lds_raw; F0.tid = 0; F0.lane = 0; F0.wave = 0; F0.G = gridDim.x; F0.bid = blockIdx.x;
    F0.in = args.in; F0.out = args.out; F0.ws = args.ws;
    unsigned char* ws = args.ws;
    unsigned* ctl = (unsigned*)(ws + WS_CTL);
    volatile LAS unsigned* MISC = (volatile LAS unsigned*)(F0.lds + LDS_MISC);
    const int wave0 = __builtin_amdgcn_readfirstlane((int)threadIdx.x >> 6);
    if (threadIdx.x < 64) MISC[threadIdx.x] = 0u;
    __syncthreads();
    const int lo = args.ph_lo, hi = args.ph_hi;
    XcdBarrier bar; bar.bar = ctl + CW_BAR; bar.x = 0; bar.st = MISC + 8; bar.w0 = wave0;
    if (hi - lo > 1) bar = xcd_barrier_post(ctl + CW_BAR, MISC + 8, wave0);
#ifndef PROBE_MASK
#define PROBE_MASK 0
#endif
#define REPS(k) (((((PROBE_MASK) >> (k)) & 1) && hi > 1) ? 2 : 1)
#ifndef DBG_MASK
#define DBG_MASK 0x3ffff
#endif
#define IN(k) (((DBG_MASK >> (k)) & 1) && lo <= (k) && (k) < hi)
#define PHASE_FRAME() Frame F = F0; { int t_ = (wave0 << 6) + lane_id_(); asm volatile("" : "+v"(t_)); F.tid = t_; F.lane = t_ & 63; F.wave = __builtin_amdgcn_readfirstlane(t_ >> 6); }
#define SEAM(k) do { if (lo <= (k) && (k) + 1 < hi) xcd_barrier(bar); } while (0)
    constexpr int SHADOW_IPS = 2 * 256 * NWAVES, SHADOW_SEAMS = 12, SHADOW_ITEMS = (SHADOW_IPS * SHADOW_SEAMS < NEX * EXP_ITEMS) ? SHADOW_IPS * SHADOW_SEAMS : NEX * EXP_ITEMS;
    const bool shadow_on = (lo == 0 && hi == N_PHASES && F0.G == 256);
#define SEAM_CONV(k, slot) do { if (lo <= (k) && (k) + 1 < hi) { if (shadow_on) { const XbTicket tk_ = xcd_barrier_arrive(bar); \
            { Frame FS = F0; int t_ = (wave0 << 6) + lane_id_(); asm volatile("" : "+v"(t_)); FS.tid = t_; FS.lane = t_ & 63; FS.wave = __builtin_amdgcn_readfirstlane(t_ >> 6); \
              convert_items<1>(FS, 1, (slot) * SHADOW_IPS, ((slot) + 1) * SHADOW_IPS < NEX * EXP_ITEMS ? ((slot) + 1) * SHADOW_IPS : NEX * EXP_ITEMS, FS.bid * NWAVES + FS.wave, FS.G * NWAVES); } \
            xcd_barrier_wait(bar, tk_); } else xcd_barrier(bar); } } while (0)

#define SEAM_L(pid, layer) do { if ((layer) == 0 && (pid) != 7) SEAM_CONV(pid, (pid) <= 6 ? (pid) : (pid) - 1); else if ((layer) == 1 && (pid) <= 13) SEAM_CONV(pid, (pid) - 2); else SEAM(pid); } while (0)
    if (IN(0)) { PHASE_FRAME(); _Pragma("unroll 1") for (int rep_ = 0; rep_ < REPS(0); ++rep_) phase_prologue(F); SEAM_CONV(0, 0); }
#define PH_INPROJ(pid, layer) if (IN(pid)) { PHASE_FRAME(); \
        if ((layer) == 1) { fox_cumsum(F); convert_experts(F, 1, shadow_on ? SHADOW_ITEMS : 0, NEX * EXP_ITEMS, F.bid * NWAVES + F.wave, F.G * NWAVES); __syncthreads();     \
            pg8::ProbPlain8 P{(const char*)(ws + WS_XQ), (const char*)(ws + WS_WIN1), D, NTOK / 256, IN1W / 256, F.G, F.bid}; \
            pg8::EpiBf16 E{(bf16_t*)(ws + WS_PROJ), IN1W, ctl + CW_KN, 8, 16}; pg8::gemm_phase(F.lds, P, E, F.wave); } \
        else if (F8_FGATE) { pg8::ProbPlain8 P{(const char*)(ws + WS_XQ), (const char*)(ws + WS_WIN0Q), D, NTOK / 256, IN0W / 256, F.G, F.bid};            \
              pg8::EpiBf16 E{(bf16_t*)(ws + WS_PROJ), IN0W, nullptr, 8, 16}; pg8::gemm_phase(F.lds, P, E, F.wave); } \
        else { { pg8::ProbPlain8 P{(const char*)(ws + WS_XQ), (const char*)(ws + WS_WIN0Q), D, NTOK / 256, 16, F.G, F.bid};            \
              pg8::EpiBf16 E{(bf16_t*)(ws + WS_PROJ), IN0W, nullptr, 8, 16}; pg8::gemm_phase(F.lds, P, E, F.wave); } \
            { pg8::ProbPlain P{(const char*)(ws + WS_XA), (const char*)(ws + WS_WIN0) + (size_t)4096 * D * 2, D, NTOK / 256, 4, F.G, F.bid};     \
              pg8::EpiBf16 E{(bf16_t*)(ws + WS_PROJ) + 4096, IN0W, nullptr, 8, 16}; pg8::gemm_phase(F.lds, P, E, F.wave); } \
            { pg8::ProbPlain8 P{(const char*)(ws + WS_XQ), (const char*)(ws + WS_WIN0Q) + (size_t)5120 * D, D, NTOK / 256, 8, F.G, F.bid};     \
              pg8::EpiBf16 E{(bf16_t*)(ws + WS_PROJ) + 5120, IN0W, nullptr, 8, 16}; pg8::gemm_phase(F.lds, P, E, F.wave); } } SEAM_L(pid, layer); }
#define PH_OUTPROJ(pid, layer) if (IN(pid)) { PHASE_FRAME(); \
        pg8::ProbPlain8 P{(const char*)(ws + WS_A2Q), (const char*)(ws + ((layer) ? WS_WOUT1 : WS_WOUT0)), D, NTOK / 256, D / 256, F.G, F.bid}; \
        pg8::EpiBf16 E{(bf16_t*)(ws + WS_YF), D, nullptr, 0, 0}; pg8::gemm_phase(F.lds, P, E, F.wave); SEAM_L(pid, layer); }
#define PH_ROUTER(pid, layer) if (IN(pid)) { PHASE_FRAME(); \
        RouterArgs a{(layer) ? (const float*)(ws + WS_X2F) : F.in[0], (const bf16_t*)(ws + WS_YF), F.in[9] + (layer) * D, F.in[10] + (layer) * D, (bf16_t*)(ws + WS_X1B), (unsigned char*)(ws + WS_X1Q), \
                  (const bf16_t*)(ws + WS_RT) + (size_t)((layer) * 2 + 0) * 64 * D, (const bf16_t*)(ws + WS_RT) + (size_t)((layer) * 2 + 1) * 64 * D, \
                  (const float*)(ws + WS_RGB) + ((layer) * 2 + 0) * 64, (const float*)(ws + WS_RGB) + ((layer) * 2 + 1) * 64, F.in[14] + (layer) * 64, ctl + CW_CNT + (layer) * 66 * 64, (int*)(ws + WS_LISTS)}; \
        phase_router(F, a); SEAM_L(pid, layer); }
#define PH_GATEUP(pid, layer) if (IN(pid)) { PHASE_FRAME(); \
        const int ntiles = build_tile_table(F, ctl + CW_CNT + (layer) * 66 * 64); \
        pg8::ProbMoE<true> P{(const char*)(ws + WS_X1Q), (const char*)(ws + WS_WGU + (size_t)(layer) * WGU_LAYER), D, ntiles, 4, F.G, F.bid, (const int*)(ws + WS_LISTS), (const LAS int*)(F.lds + LDS_TT) + 256, (const LAS int*)(F.lds + LDS_TT), (const LAS unsigned short*)(F.lds + LDS_TT + 6656)}; \
        pg8::fill_tok_cache(P, (LAS unsigned short*)(F.lds + LDS_TT + 6656), F.tid); \
        pg8::EpiSwiGLU E{(unsigned char*)(ws + WS_H)}; pg8::gemm_phase(F.lds, P, E, F.wave); \
        { pg8::ProbPlain8 PS{(const char*)(ws + WS_X1Q), (const char*)(ws + WS_WSH + (size_t)(layer) * WSH_LAYER), D, NTOK / 256, 4, F.G, F.bid}; \
          pg8::EpiSwiGLU16 ES{(bf16_t*)(ws + WS_HSH)}; pg8::gemm_phase(F.lds, PS, ES, F.wave); } SEAM_L(pid, layer); }
#define PH_DOWN(pid, layer) if (IN(pid)) { PHASE_FRAME(); \
        const int ntiles = (lo < (pid)) ? reuse_tile_table(F) : build_tile_table(F, ctl + CW_CNT + (layer) * 66 * 64);     \
        pg8::ProbMoE<false> P{(const char*)(ws + WS_H), (const char*)(ws + WS_WD + (size_t)(layer) * WD_LAYER), EDIM, ntiles, 8, F.G, F.bid, (const int*)(ws + WS_LISTS), (const LAS int*)(F.lds + LDS_TT) + 256, (const LAS int*)(F.lds + LDS_TT), nullptr}; \
        pg8::EpiDown E{(unsigned char*)(ws + WS_Y), F.lds}; pg8::fill_rec_cache(P, F.lds, F.tid); pg8::gemm_phase(F.lds, P, E, F.wave); if (REPS(pid) > 1) { asm volatile("" : "+s"(P.A), "+s"(P.Bt) :: "memory"); pg8::gemm_phase(F.lds, P, E, F.wave); } \
        { pg8::ProbPlain PS{(const char*)(ws + WS_HSH), (const char*)(ws + WS_WSH + (size_t)(layer) * WSH_LAYER + 4 * MiB), EDIM, NTOK / 256, D / 256, F.G, F.bid}; \
          pg8::EpiBf16 ES{(bf16_t*)(ws + WS_YSH), D, nullptr, 0, 0}; pg8::gemm_phase(F.lds, PS, ES, F.wave); } SEAM_L(pid, layer); }
    PH_INPROJ(1, 0)
    constexpr int CJ2 = (int)((long)CONV_JOBS * CONV_F2 / 1024), CJ3 = (int)((long)CONV_JOBS * CONV_F3 / 1024);
    if (IN(2)) { PHASE_FRAME(); if (is_converter(F)) convert_jobs(F, 0, CJ2); else { const Frame W = work_frame(F); dilated_items(W); hgrn_a_items(W); } SEAM_CONV(2, 2); }
    if (IN(3)) { PHASE_FRAME(); if (is_converter(F)) convert_jobs(F, CJ2, CJ3); else { const Frame W = work_frame(F); hgrn_scan(W); } SEAM_CONV(3, 3); }
    if (IN(4)) { PHASE_FRAME(); if (is_converter(F)) convert_jobs(F, CJ3, CONV_JOBS); else { const Frame W = work_frame(F); hgrn_c_items(W); combine_tokens(W); } SEAM_CONV(4, 4); }
    PH_OUTPROJ(5, 0)
    PH_ROUTER(6, 0)
    PH_GATEUP(7, 0)
    PH_DOWN(8, 0)
    if (IN(9)) { PHASE_FRAME();
        RowArgs a{(const float*)(ws + WS_X1B), (const bf16_t*)(ws + WS_Y), F.in[11], F.in[12], (float*)(ws + WS_X2F), (bf16_t*)(ws + WS_XQ),
                  (const bf16_t*)(ws + WS_FGHI), (const bf16_t*)(ws + WS_FGLO), nullptr, nullptr, nullptr, (const bf16_t*)(ws + WS_YSH), (float*)(ws + WS_FLOG)};
        _Pragma("unroll 1") for (int rep_ = 0; rep_ < REPS(9); ++rep_) phase_rows<1, 1>(F, a); SEAM_CONV(9, 8); }
    PH_INPROJ(11, 1)
    if (IN(12)) { PHASE_FRAME(); _Pragma("unroll 1") for (int rep_ = 0; rep_ < REPS(12); ++rep_) for (int it = F.bid; it < 2048; it += F.G) fox_item(F, it); SEAM_CONV(12, 10); }
    PH_OUTPROJ(13, 1)
    PH_ROUTER(14, 1)
    PH_GATEUP(15, 1)
    PH_DOWN(16, 1)
    if (IN(17)) { PHASE_FRAME();
        RowArgs a{(const float*)(ws + WS_X1B), (const bf16_t*)(ws + WS_Y), F.in[11] + D, F.in[12] + D, F.out, (bf16_t*)(ws + WS_XA),
                  nullptr, nullptr, nullptr, nullptr, nullptr, (const bf16_t*)(ws + WS_YSH), nullptr};
        _Pragma("unroll 1") for (int rep_ = 0; rep_ < REPS(17); ++rep_) phase_rows<1, 0>(F, a); }
#undef IN
#undef SEAM
}

#ifndef MK_N_LAUNCHES
#define MK_N_LAUNCHES 1
#endif
extern "C" void kernel_launch(void* const* d_in, const int* in_sizes, int n_in, void* d_out, int out_size, void* d_ws, size_t ws_size, hipStream_t stream) {
    static int grid = 0;
    if (grid == 0) {
        if (n_in != 21 || out_size != NTOK * D || ws_size < WS_END) { fprintf(stderr, "kernel_launch: unexpected shapes (n_in %d, out %d, ws %zu < %zu)\n", n_in, out_size, ws_size, (size_t)WS_END); grid = -1; return; }
        int dev = 0, cus = 0, per_cu = 0;
        if (hipGetDevice(&dev) != hipSuccess || hipDeviceGetAttribute(&cus, hipDeviceAttributeMultiprocessorCount, dev) != hipSuccess) { grid = -1; return; }
        if (hipFuncSetAttribute((const void*)hybrid_fwd, hipFuncAttributeMaxDynamicSharedMemorySize, LDS_BYTES) != hipSuccess) { fprintf(stderr, "kernel_launch: hipFuncSetAttribute failed\n"); grid = -1; return; }
        if (hipOccupancyMaxActiveBlocksPerMultiprocessor(&per_cu, (const void*)hybrid_fwd, NTHREADS, LDS_BYTES) != hipSuccess || per_cu < 1) { fprintf(stderr, "kernel_launch: occupancy query says %d\n", per_cu); }
        (void)hipGetLastError();
        grid = cus;
    }
    if (grid < 0) return;
    (void)in_sizes;
    if (hipMemsetAsync((char*)d_ws + WS_CTL, 0, CTL_ZERO_BYTES, stream) != hipSuccess) return;
    Args a{};
    for (int i = 0; i < 21; ++i) a.in[i] = (const float*)d_in[i];
    a.out = (float*)d_out; a.ws = (unsigned char*)d_ws;
    if (MK_N_LAUNCHES == 1) { a.ph_lo = 0; a.ph_hi = N_PHASES; hipLaunchKernelGGL(hybrid_fwd, dim3(grid), dim3(NTHREADS), LDS_BYTES, stream, a); }
    else for (int p = 0; p < N_PHASES; ++p) { a.ph_lo = p; a.ph_hi = p + 1; hipLaunchKernelGGL(hybrid_fwd, dim3(grid), dim3(NTHREADS), LDS_BYTES, stream, a); }
}
```

```cpp
#include <hip/hip_runtime.h>
#include <cstdio>
#include <cstdint>

#define LAS __attribute__((address_space(3)))
#define GAS __attribute__((address_space(1)))
typedef unsigned short bf16_t;
typedef short bf16x8 __attribute__((ext_vector_type(8)));
typedef short s16x4 __attribute__((ext_vector_type(4)));
typedef float f32x4 __attribute__((ext_vector_type(4)));
typedef float f32x2 __attribute__((ext_vector_type(2)));
typedef unsigned u32x4 __attribute__((ext_vector_type(4)));
typedef unsigned u32x2 __attribute__((ext_vector_type(2)));
typedef int i32x4 __attribute__((ext_vector_type(4)));
typedef int i32x8 __attribute__((ext_vector_type(8)));

constexpr int D = 2048, NTOK = 16384, SEQ = 4096, NBATCH = 4;
constexpr int IN0W = 7168, IN1W = 6144, IN1FULL = 6160;
constexpr int NE = 64, NEX = 65  , EDIM = 512, LISTCAP = 16384;
constexpr float LN_EPS = 1e-5f, RMS_EPS = 1e-6f;
constexpr float DN_ALPHA = 1.4142135623730951f;
constexpr float ATT_SCALE = 0.08838834764831845f;
constexpr int NWAVES = 8, NTHREADS = 512;

constexpr size_t MiB = 1u << 20;
constexpr size_t WS_CTL = 0, CTL_ZERO_BYTES = 1 * MiB;
constexpr size_t WS_LB = 1 * MiB;
constexpr size_t WS_BIASREL = 1 * MiB + 16384;
constexpr size_t WS_FGHI = 1 * MiB + 65536;
constexpr size_t WS_FGLO = 1 * MiB + 131072;
constexpr size_t WS_RGB = 1 * MiB + 196608;
constexpr size_t WS_RT = 2 * MiB;
constexpr size_t WS_YPOS = 3 * MiB;
constexpr size_t WS_FLOG = 4 * MiB;
constexpr size_t WS_CC = 5 * MiB;
constexpr size_t WS_LSE = 6 * MiB;
constexpr size_t WS_ALAST = 8 * MiB;
constexpr size_t WS_WIN0 = 16 * MiB, WS_WOUT0 = 44 * MiB, WS_WIN1 = 52 * MiB, WS_WOUT1 = 76 * MiB;
constexpr size_t WS_WGU = 84 * MiB;
constexpr size_t WS_WD = 604 * MiB;
constexpr size_t WGU_LAYER = 260 * MiB, WD_LAYER = 130 * MiB;
constexpr size_t WS_XA = 864 * MiB;
constexpr size_t WS_X1B = 928 * MiB;
constexpr size_t WS_A2 = 992 * MiB;
constexpr size_t WS_YF = 1056 * MiB;
constexpr size_t WS_X2F = 1120 * MiB;
constexpr size_t WS_H = 1248 * MiB;
constexpr size_t WS_Y = 1408 * MiB;
constexpr size_t WS_PROJ = 1408 * MiB;
constexpr size_t WS_LT = 1632 * MiB;
constexpr size_t WS_ST = 1760 * MiB;
constexpr size_t WS_OBR = 1824 * MiB;
constexpr size_t WS_LISTS = 1920 * MiB;
constexpr size_t WS_X1Q = 1930 * MiB;
constexpr size_t WS_XQ = 1962 * MiB;
constexpr size_t WS_A2Q = 1994 * MiB;
constexpr size_t WS_WIN0Q = WS_WIN0;
constexpr size_t WS_WSH = 2026 * MiB;
constexpr size_t WSH_LAYER = 6 * MiB;
constexpr size_t WS_HSH = WS_YF;
constexpr size_t WS_YSH = WS_A2;
constexpr size_t WS_END = 2044 * MiB;
constexpr int CW_BAR = 4096;
constexpr int CW_CNT = 16384;
constexpr int CW_KN = 32768;
#ifndef CONVERTERS
#define CONVERTERS 0
#endif
constexpr int P0_EXPERT_ITEMS = 0;
constexpr float W8_SCALE = 64.0f;
constexpr int W8_SCALE_E8M0 = 0x7c7c7c7c, ONE_E8M0 = 0x7c7c7c7c;
constexpr float Y_SCALE = 16.0f;
constexpr float FOX_T = 30.0f;

#define YF_SCALE 16.0f
#ifndef F8_FGATE
#define F8_FGATE 1
#endif
#ifndef PRB_HA
#define PRB_HA 1
#define PRB_HC 1
#define PRB_DIL 1
#endif
#ifndef CONV_F2
#define CONV_F2 380
#define CONV_F3 510
#endif
__device__ __forceinline__ unsigned cvt_pk_bf16(float lo, float hi) { unsigned r; asm volatile("v_cvt_pk_bf16_f32 %0, %1, %2" : "=v"(r) : "v"(lo), "v"(hi)); return r; }
__device__ __forceinline__ float clamp8(float v) { return __builtin_amdgcn_fmed3f(v, -448.0f, 448.0f); }
__device__ __forceinline__ unsigned cvt_pk4_fp8(float a, float b, float c, float d) { a = clamp8(a); b = clamp8(b); c = clamp8(c); d = clamp8(d); int o = 0; o = __builtin_amdgcn_cvt_pk_fp8_f32(a, b, o, false); o = __builtin_amdgcn_cvt_pk_fp8_f32(c, d, o, true); return (unsigned)o; }
__device__ __forceinline__ float bf_lo(unsigned w) { return __uint_as_float(w << 16); }
__device__ __forceinline__ float bf_hi(unsigned w) { return __uint_as_float(w & 0xffff0000u); }
__device__ __forceinline__ float bf2f(bf16_t b) { return __uint_as_float(((unsigned)b) << 16); }
__device__ __forceinline__ u32x4 f8x8_to_bf16(u32x2 x) { const f32x2 p0 = __builtin_amdgcn_cvt_pk_f32_fp8((int)x.x, false), p1 = __builtin_amdgcn_cvt_pk_f32_fp8((int)x.x, true), p2 = __builtin_amdgcn_cvt_pk_f32_fp8((int)x.y, false), p3 = __builtin_amdgcn_cvt_pk_f32_fp8((int)x.y, true);
    u32x4 w; w.x = cvt_pk_bf16(p0.x, p0.y); w.y = cvt_pk_bf16(p1.x, p1.y); w.z = cvt_pk_bf16(p2.x, p2.y); w.w = cvt_pk_bf16(p3.x, p3.y); return w; }
__device__ __forceinline__ float sigmoidf_(float x) { return 1.0f / (1.0f + __expf(-x)); }
__device__ __forceinline__ float siluf_(float x) { return x / (1.0f + __expf(-x)); }
__device__ __forceinline__ float wave_sum(float v) {
#pragma unroll
    for (int o = 1; o < 64; o <<= 1) v += __shfl_xor(v, o);
    return v;
}
#define MFMA16(a, b, c) __builtin_amdgcn_mfma_f32_16x16x32_bf16((a), (b), (c), 0, 0, 0)
#define LDS_WAIT() asm volatile("s_waitcnt lgkmcnt(0)" ::: "memory")
#define VM_WAIT() asm volatile("s_waitcnt vmcnt(0)" ::: "memory")
__device__ __forceinline__ unsigned off_b(unsigned row, unsigned ch) { return 256u * row + 16u * (ch ^ (((row & 3u) << 2) | ((row >> 2) & 3u))); }
__device__ __forceinline__ s16x4 tr_read(unsigned addr) { s16x4 r; asm volatile("ds_read_b64_tr_b16 %0, %1" : "=v"(r) : "v"(addr) : "memory"); return r; }
__device__ __forceinline__ bf16x8 cat8(s16x4 a, s16x4 b) { return __builtin_shufflevector(a, b, 0, 1, 2, 3, 4, 5, 6, 7); }

#define XB_TMO      128
#define XB_XCNT(j)  (256  + 64 * (j))
#define XB_XSUB(j)  (1280 + 64 * (j))
#define XB_XGEN(j)  (2304 + 64 * (j))
#define XB_TOP      3328
#define XB_TOPGEN   3392
#define XCD_BAR_WORDS 3456
#define XB_SPIN_CAP (1u << 22)
__device__ __forceinline__ unsigned xb_ld(unsigned* p)              { return __hip_atomic_load(p, __ATOMIC_RELAXED, __HIP_MEMORY_SCOPE_AGENT); }
__device__ __forceinline__ unsigned xb_add(unsigned* p, unsigned v) { return __hip_atomic_fetch_add(p, v, __ATOMIC_RELAXED, __HIP_MEMORY_SCOPE_AGENT); }
__device__ __forceinline__ unsigned xb_xcc_id() { return (unsigned)__builtin_amdgcn_s_getreg((3 << 11) | 20) & 0xFu; }
#define XB_SPIN(cond, bar) do { unsigned _sp = 0; while (cond) { __builtin_amdgcn_s_sleep(1); \
    if ((++_sp & 255u) == 0u) { if (xb_ld(&(bar)[XB_TMO])) break; if (_sp > XB_SPIN_CAP) { atomicAdd(&(bar)[XB_TMO], 1u); break; } } } } while (0)
__device__ __forceinline__ int lane_id_() { int l; asm volatile("v_mbcnt_lo_u32_b32 %0, -1, 0\n\tv_mbcnt_hi_u32_b32 %0, -1, %0" : "=v"(l)); return l; }
struct XcdBarrier { unsigned* bar; unsigned x; volatile LAS unsigned* st; int w0; };
__device__ __forceinline__ XcdBarrier xcd_barrier_post(unsigned* bar, volatile LAS unsigned* st, int w0) {
    XcdBarrier b; b.bar = bar; b.x = xb_xcc_id(); b.st = st; b.w0 = w0;
    if (w0 == 0 && lane_id_() == 0) (void)xb_add(&bar[XB_XCNT(b.x)], 1u);
    return b;
}
__device__ __forceinline__ void xcd_barrier_complete(unsigned* bar, unsigned x, unsigned& nloc, unsigned& nx) {
    const unsigned G = gridDim.x * gridDim.y * gridDim.z;
    unsigned sum, cnt, mine, sp = 0u;
    for (;;) {
        sum = 0u; cnt = 0u; mine = 0u;
#pragma unroll
        for (unsigned j = 0; j < 16; ++j) { const unsigned c = xb_ld(&bar[XB_XCNT(j)]); sum += c; cnt += (c > 0u) ? 1u : 0u; mine = (j == x) ? c : mine; }
        if (sum == G) break;
        __builtin_amdgcn_s_sleep(1);
        if ((++sp & 255u) == 0u) { if (xb_ld(&bar[XB_TMO])) break; if (sp > XB_SPIN_CAP) { atomicAdd(&bar[XB_TMO], 1u); break; } }
    }
    nloc = mine > 0u ? mine : 1u; nx = cnt > 0u ? cnt : 1u;
}
__device__ __forceinline__ void xcd_barrier(const XcdBarrier& b) {
    asm volatile("s_waitcnt vmcnt(0)" ::: "memory");
    __syncthreads();
    if (b.w0 == 0 && lane_id_() == 0) {
        unsigned* bar = b.bar;
        __builtin_amdgcn_s_waitcnt(0);
        unsigned nloc = b.st[0], nx = b.st[1];
        if (nloc == 0u) { xcd_barrier_complete(bar, b.x, nloc, nx); b.st[0] = nloc; b.st[1] = nx; }
        const unsigned old = xb_add(&bar[XB_XSUB(b.x)], 1u);
        const unsigned gen = old / nloc;
        if (old + 1u == (gen + 1u) * nloc) {
            __builtin_amdgcn_fence(__ATOMIC_RELEASE, "agent");
            asm volatile("s_waitcnt vmcnt(0)" ::: "memory");
            const unsigned og = xb_add(&bar[XB_TOP], 1u);
            const unsigned tg = og / nx;
            if (og + 1u == (tg + 1u) * nx) xb_add(&bar[XB_TOPGEN], 1u);
            else XB_SPIN(xb_ld(&bar[XB_TOPGEN]) == tg, bar);
            __builtin_amdgcn_fence(__ATOMIC_ACQUIRE, "agent");
            xb_add(&bar[XB_XGEN(b.x)], 1u);
            asm volatile("s_waitcnt vmcnt(0)" ::: "memory");
        } else {
            XB_SPIN(xb_ld(&bar[XB_XGEN(b.x)]) == gen, bar);
            __builtin_amdgcn_fence(__ATOMIC_ACQUIRE, "agent");
            asm volatile("s_waitcnt vmcnt(0)" ::: "memory");
        }
    }
    __syncthreads();
}
struct XbTicket { unsigned gen, tg; int role; };
__device__ __forceinline__ XbTicket xcd_barrier_arrive(const XcdBarrier& b) {
    XbTicket t; t.gen = 0u; t.tg = 0u; t.role = 0;
    asm volatile("s_waitcnt vmcnt(0)" ::: "memory");
    __syncthreads();
    if (b.w0 == 0 && lane_id_() == 0) {
        unsigned* bar = b.bar;
        __builtin_amdgcn_s_waitcnt(0);
        unsigned nloc = b.st[0], nx = b.st[1];
        if (nloc == 0u) { xcd_barrier_complete(bar, b.x, nloc, nx); b.st[0] = nloc; b.st[1] = nx; }
        const unsigned old = xb_add(&bar[XB_XSUB(b.x)], 1u);
        t.gen = old / nloc;
        if (old + 1u == (t.gen + 1u) * nloc) {
            __builtin_amdgcn_fence(__ATOMIC_RELEASE, "agent");
            asm volatile("s_waitcnt vmcnt(0)" ::: "memory");
            const unsigned og = xb_add(&bar[XB_TOP], 1u);
            t.tg = og / nx;
            if (og + 1u == (t.tg + 1u) * nx) { xb_add(&bar[XB_TOPGEN], 1u); t.role = 2; } else t.role = 1;
        }
    }
    return t;
}
__device__ __forceinline__ void xcd_barrier_wait(const XcdBarrier& b, const XbTicket& t) {
    asm volatile("s_waitcnt vmcnt(0)" ::: "memory");
    if (b.w0 == 0 && lane_id_() == 0) {
        unsigned* bar = b.bar;
        if (t.role != 0) {
            if (t.role == 1) XB_SPIN(xb_ld(&bar[XB_TOPGEN]) == t.tg, bar);
            __builtin_amdgcn_fence(__ATOMIC_ACQUIRE, "agent");
            xb_add(&bar[XB_XGEN(b.x)], 1u);
            asm volatile("s_waitcnt vmcnt(0)" ::: "memory");
        } else {
            XB_SPIN(xb_ld(&bar[XB_XGEN(b.x)]) == t.gen, bar);
            __builtin_amdgcn_fence(__ATOMIC_ACQUIRE, "agent");
            asm volatile("s_waitcnt vmcnt(0)" ::: "memory");
        }
    }
    __syncthreads();
}
constexpr int LDS_BYTES = 163840;
constexpr int LDS_REC = 147456;
constexpr int LDS_MISC = 143360;
constexpr int LDS_TT = 131072;
namespace pg8 {
constexpr int BM = 256, BK = 64, HALF = 128, HTB = HALF * BK * 2, STAGE_BYTES = 8 * HTB, NXCD = 8, WGM = 8;
__host__ __device__ __forceinline__ int lds_byte(int r, int c) { const int st = (r >> 4) * 2 + (c >> 5), rr = r & 15, cc = c & 31, ob = rr * 64 + cc * 2; return st * 1024 + (ob ^ (((ob >> 9) & 1) << 5)); }
__host__ __device__ __forceinline__ void stage_rc(int b, int& R, int& C) { const int st = b / 1024, sb = b % 1024, swz = sb ^ (((sb >> 9) & 1) << 5); R = (st >> 1) * 16 + swz / 64; C = (st & 1) * 32 + (swz % 64) / 2; }
__host__ __device__ __forceinline__ int perm32(int rho) { const int n = rho >> 4, i = rho & 15; return 8 * (i >> 2) + 4 * n + (i & 3); }

struct Unit { int pm, pn, e, nrows, lbase, ord; };

__device__ __forceinline__ bool enum_unit(int i, int nM, int nN, int G, int c, int& pm, int& pn) {
    const int nwg = nM * nN; const long L = (long)i * G + c; if (L >= nwg) return false;
    int wgid = (int)L; { const int q = nwg / NXCD, r = nwg % NXCD, xcd = wgid % NXCD, off = wgid / NXCD; wgid = (xcd < r ? xcd * (q + 1) : r * (q + 1) + (xcd - r) * q) + off; }
    const int nig = WGM * nN, gid = wgid / nig, fm = gid * WGM, gsz = (nM - fm) < WGM ? (nM - fm) : WGM;
    pm = fm + ((wgid % nig) % gsz); pn = (wgid % nig) / gsz; return true;
}

struct ProbPlain {
    static constexpr bool GATHER = false, FP8 = false; static constexpr int NTC = 0;
    const char* A; const char* Bt; int K, nM, nN, G, c;
    __device__ __forceinline__ bool next(int i, Unit& u) const { u.e = 0; u.nrows = 256; u.lbase = 0; u.ord = i; return enum_unit(i, nM, nN, G, c, u.pm, u.pn); }
    __device__ __forceinline__ const char* a_base() const { return A; }
    __device__ __forceinline__ unsigned a_rowoff(const Unit& u, int r) const { return (unsigned)(u.pm * BM + r) * (unsigned)(K * 2); }
    __device__ __forceinline__ const char* b_base(const Unit& u) const { return Bt + (size_t)u.pn * BM * K * 2; }
};
struct ProbPlain8 {
    static constexpr bool GATHER = false, FP8 = true; static constexpr int NTC = 0;
    const char* A; const char* Bt; int K, nM, nN, G, c;
    __device__ __forceinline__ bool next(int i, Unit& u) const { u.e = 0; u.nrows = 256; u.lbase = 0; u.ord = i; return enum_unit(i, nM, nN, G, c, u.pm, u.pn); }
    __device__ __forceinline__ const char* a_base() const { return A; }
    __device__ __forceinline__ unsigned a_rowoff(const Unit& u, int r) const { return (unsigned)(u.pm * BM + r) * (unsigned)K; }
    __device__ __forceinline__ const char* b_base(const Unit& u) const { return Bt + (size_t)u.pn * BM * K; }
};
template <bool GATHER_> struct ProbMoE {
    static constexpr bool GATHER = GATHER_, FP8 = true; static constexpr int NTC = GATHER_ ? 0 : 4;
    const char* A; const char* Bt; int K, nM, nN, G, c; const int* list; const LAS int* tt; const LAS int* cnts; const LAS unsigned short* tokc;
    __device__ __forceinline__ bool next(int i, Unit& u) const {
        if (!enum_unit(i, nM, nN, G, c, u.pm, u.pn)) return false;
        u.ord = i;
        const int e = tt[2 * u.pm], ti = tt[2 * u.pm + 1]; u.e = e; const int rem = cnts[e] - ti * BM; u.nrows = rem < BM ? rem : BM; u.lbase = e * LISTCAP + ti * BM; return true;
    }
    __device__ __forceinline__ const char* a_base() const { return A; }
    __device__ __forceinline__ unsigned a_rowoff(const Unit& u, int r) const {
        if (GATHER) return (unsigned)tokc[u.ord * BM + r] * (unsigned)K;
        return (unsigned)(u.pm * BM + r) * (unsigned)K;
    }
    __device__ __forceinline__ const char* b_base(const Unit& u) const { return Bt + ((size_t)u.e * nN + u.pn) * BM * K; }
};

template <class Prob> __device__ __forceinline__ void fill_tok_cache(const Prob& P, LAS unsigned short* tokc, int tid) {
    Unit u;
    for (int i = 0; i < 11 && P.next(i, u); ++i)
        if (tid < BM) { const int rr = tid < u.nrows ? tid : u.nrows - 1; tokc[i * BM + tid] = (unsigned short)(P.list[2 * (u.lbase + rr)] >> 4); }
    __syncthreads();
}
struct NoPre {};
struct EpiBf16 {
    static constexpr bool PERM = true, PERM16 = true; typedef NoPre Pre;
    static constexpr int NST = 16;
    bf16_t* O; int ldc; unsigned* kn; int kn_lo, kn_hi;
    __device__ __forceinline__ Pre prefetch(const Unit&, int, int) const { return Pre{}; }
    __device__ __forceinline__ void operator()(const f32x4 (&acc)[2][2][4][2], const Unit& u, int wr, int wc, int fr, int fq, const Pre&) const {
        const int row0 = u.pm * BM + wr * 64 + fr, col0 = u.pn * BM + wc * 64 + 16 * fq;
        float kmx = 0.f;
#pragma unroll
        for (int ai = 0; ai < 2; ++ai)
#pragma unroll
            for (int m = 0; m < 4; ++m) { bf16_t* rowp = O + (size_t)(row0 + ai * HALF + m * 16) * ldc + col0;
                const f32x4 a0 = acc[ai][0][m][0], a1 = acc[ai][0][m][1], b0 = acc[ai][1][m][0], b1 = acc[ai][1][m][1];
                u32x4 w0, w1; w0.x = cvt_pk_bf16(a0[0], a0[1]); w0.y = cvt_pk_bf16(a0[2], a0[3]); w0.z = cvt_pk_bf16(a1[0], a1[1]); w0.w = cvt_pk_bf16(a1[2], a1[3]);
                w1.x = cvt_pk_bf16(b0[0], b0[1]); w1.y = cvt_pk_bf16(b0[2], b0[3]); w1.z = cvt_pk_bf16(b1[0], b1[1]); w1.w = cvt_pk_bf16(b1[2], b1[3]);
                *(u32x4*)rowp = w0; *(u32x4*)(rowp + 8) = w1;
                if (kn) { float ss = 0.f;
#pragma unroll
                    for (int q = 0; q < 4; ++q) { const unsigned x0 = q == 0 ? w0.x : q == 1 ? w0.y : q == 2 ? w0.z : w0.w, x1 = q == 0 ? w1.x : q == 1 ? w1.y : q == 2 ? w1.z : w1.w;
                        ss += bf_lo(x0) * bf_lo(x0) + bf_hi(x0) * bf_hi(x0) + bf_lo(x1) * bf_lo(x1) + bf_hi(x1) * bf_hi(x1); }
                    ss += __shfl_xor(ss, 16); ss += __shfl_xor(ss, 32); kmx = fmaxf(kmx, ss); } }
        if (kn && u.pn >= kn_lo && u.pn < kn_hi) {
            float v = kmx;
#pragma unroll
            for (int o = 1; o < 16; o <<= 1) v = fmaxf(v, __shfl_xor(v, o));
            if (fr == 0 && fq == 0) atomicMax(kn + (((u.pm * BM) / SEQ) * 16 + 2 * (u.pn - kn_lo) + (wc >> 1)) * 4 + (wc & 1), __float_as_uint(v));
        }
    }
};
struct EpiResF32 {
    static constexpr bool PERM = false, PERM16 = false; typedef NoPre Pre; static constexpr int NST = 0;
    const float* res; float* out; int ldc; float alpha;
    __device__ __forceinline__ Pre prefetch(const Unit&, int, int) const { return Pre{}; }
    __device__ __forceinline__ void operator()(const f32x4 (&acc)[2][2][4][2], const Unit& u, int wr, int wc, int fr, int fq, const Pre&) const {
        const int row0 = u.pm * BM + wr * 64 + fr, col0 = u.pn * BM + wc * 32 + 4 * fq;
#pragma unroll
        for (int ai = 0; ai < 2; ++ai)
#pragma unroll
            for (int m = 0; m < 4; ++m) { const size_t off = (size_t)(row0 + ai * HALF + m * 16) * ldc + col0;
#pragma unroll
                for (int bj = 0; bj < 2; ++bj)
#pragma unroll
                    for (int n = 0; n < 2; ++n) { const f32x4 r = *(const f32x4*)(res + off + bj * HALF + n * 16); *(f32x4*)(out + off + bj * HALF + n * 16) = r * alpha + acc[ai][bj][m][n]; }
                asm volatile("" ::: "memory"); }
    }
};
struct EpiSwiGLU {
    static constexpr bool PERM = true, PERM16 = false; typedef NoPre Pre; static constexpr int NST = 8;
    unsigned char* H;
    __device__ __forceinline__ Pre prefetch(const Unit&, int, int) const { return Pre{}; }
    __device__ __forceinline__ void operator()(const f32x4 (&acc)[2][2][4][2], const Unit& u, int wr, int wc, int fr, int fq, const Pre&) const {
        const int row0 = u.pm * BM + wr * 64 + fr, col0 = u.pn * HALF + wc * 32 + 8 * fq;
#pragma unroll
        for (int ai = 0; ai < 2; ++ai)
#pragma unroll
            for (int m = 0; m < 4; ++m) { unsigned char* rowp = H + (size_t)(row0 + ai * HALF + m * 16) * EDIM + col0;
                float h[8];
#pragma unroll
                for (int n = 0; n < 2; ++n)
#pragma unroll
                    for (int j = 0; j < 4; ++j) { const float g = acc[ai][0][m][n][j], up = acc[ai][1][m][n][j]; h[n * 4 + j] = fminf(fmaxf(g * __builtin_amdgcn_rcpf(1.0f + __expf(-g)) * up, -440.f), 440.f); }
                int o0 = 0, o1 = 0; o0 = __builtin_amdgcn_cvt_pk_fp8_f32(h[0], h[1], o0, false); o0 = __builtin_amdgcn_cvt_pk_fp8_f32(h[2], h[3], o0, true);
                o1 = __builtin_amdgcn_cvt_pk_fp8_f32(h[4], h[5], o1, false); o1 = __builtin_amdgcn_cvt_pk_fp8_f32(h[6], h[7], o1, true);
                u32x2 w; w.x = (unsigned)o0; w.y = (unsigned)o1; *(u32x2*)rowp = w; }
    }
};
struct EpiSwiGLU16 {
    static constexpr bool PERM = true, PERM16 = false; typedef NoPre Pre; static constexpr int NST = 8;
    bf16_t* H;
    __device__ __forceinline__ Pre prefetch(const Unit&, int, int) const { return Pre{}; }
    __device__ __forceinline__ void operator()(const f32x4 (&acc)[2][2][4][2], const Unit& u, int wr, int wc, int fr, int fq, const Pre&) const {
        const int row0 = u.pm * BM + wr * 64 + fr, col0 = u.pn * HALF + wc * 32 + 8 * fq;
#pragma unroll
        for (int ai = 0; ai < 2; ++ai)
#pragma unroll
            for (int m = 0; m < 4; ++m) { bf16_t* rowp = H + (size_t)(row0 + ai * HALF + m * 16) * EDIM + col0;
                float h[8];
#pragma unroll
                for (int n = 0; n < 2; ++n)
#pragma unroll
                    for (int j = 0; j < 4; ++j) { const float g = acc[ai][0][m][n][j], up = acc[ai][1][m][n][j]; h[n * 4 + j] = g * __builtin_amdgcn_rcpf(1.0f + __expf(-g)) * up; }
                u32x4 w; w.x = cvt_pk_bf16(h[0], h[1]); w.y = cvt_pk_bf16(h[2], h[3]); w.z = cvt_pk_bf16(h[4], h[5]); w.w = cvt_pk_bf16(h[6], h[7]);
                *(u32x4*)rowp = w; }
    }
};
struct EpiDown {
    static constexpr bool PERM = true, PERM16 = true;
    typedef NoPre Pre; static constexpr int NST = 8;
    unsigned char* Y; LAS unsigned char* lds;
    static __device__ __forceinline__ int rec_off(int ord) { return ord < 16 ? LDS_REC + ord * 1024 : LDS_TT + 6656 + (ord - 16) * 1024; }
    __device__ __forceinline__ Pre prefetch(const Unit&, int, int) const { return Pre{}; }
    __device__ __forceinline__ void operator()(const f32x4 (&acc)[2][2][4][2], const Unit& u, int wr, int wc, int fr, int fq, const Pre&) const {
        const int col0 = u.pn * BM + wc * 64 + 16 * fq;
        const LAS unsigned* rec = (const LAS unsigned*)(lds + rec_off(u.ord));
        unsigned info[2][4];
#pragma unroll
        for (int ai = 0; ai < 2; ++ai)
#pragma unroll
            for (int m = 0; m < 4; ++m) info[ai][m] = rec[ai * HALF + wr * 64 + m * 16 + fr];
#pragma unroll
        for (int ai = 0; ai < 2; ++ai)
#pragma unroll
            for (int m = 0; m < 4; ++m) { const int r = ai * HALF + wr * 64 + m * 16 + fr; const bool ok = r < u.nrows;
                const unsigned v = info[ai][m]; const int tok = (int)(v >> 18), slot = (int)((v >> 14) & 15u); const float w = (float)(v & 16383u) * (2.5f / 16383.0f) * Y_SCALE;
                unsigned char* rowp = Y + (size_t)(ok ? tok * 9 + slot : NTOK * 9) * D + col0;
                u32x4 o;
                { const f32x4 a0 = acc[ai][0][m][0] * w, a1 = acc[ai][0][m][1] * w, b0 = acc[ai][1][m][0] * w, b1 = acc[ai][1][m][1] * w;
                  o.x = cvt_pk4_fp8(a0[0], a0[1], a0[2], a0[3]); o.y = cvt_pk4_fp8(a1[0], a1[1], a1[2], a1[3]); o.z = cvt_pk4_fp8(b0[0], b0[1], b0[2], b0[3]); o.w = cvt_pk4_fp8(b1[0], b1[1], b1[2], b1[3]); }
                *(u32x4*)rowp = o; }
    }
};
struct EpiProj0 {
    static constexpr bool PERM = true, PERM16 = true; typedef NoPre Pre; static constexpr int NST = 8;
    bf16_t* O;
    __device__ __forceinline__ Pre prefetch(const Unit&, int, int) const { return Pre{}; }
    __device__ __forceinline__ void operator()(const f32x4 (&acc)[2][2][4][2], const Unit& u, int wr, int wc, int fr, int fq, const Pre&) const {
        const int row0 = u.pm * BM + wr * 64 + fr, col0 = u.pn * BM + wc * 64 + 16 * fq;
#pragma unroll
        for (int ai = 0; ai < 2; ++ai)
#pragma unroll
            for (int m = 0; m < 4; ++m) { const size_t row = (size_t)(row0 + ai * HALF + m * 16);
                const f32x4 a0 = acc[ai][0][m][0], a1 = acc[ai][0][m][1], b0 = acc[ai][1][m][0], b1 = acc[ai][1][m][1];
                if (u.pn < 12) { bf16_t* rowp = O + row * IN0W + col0;
                    u32x4 w0, w1; w0.x = cvt_pk_bf16(a0[0], a0[1]); w0.y = cvt_pk_bf16(a0[2], a0[3]); w0.z = cvt_pk_bf16(a1[0], a1[1]); w0.w = cvt_pk_bf16(a1[2], a1[3]);
                    w1.x = cvt_pk_bf16(b0[0], b0[1]); w1.y = cvt_pk_bf16(b0[2], b0[3]); w1.z = cvt_pk_bf16(b1[0], b1[1]); w1.w = cvt_pk_bf16(b1[2], b1[3]);
                    *(u32x4*)rowp = w0; *(u32x4*)(rowp + 8) = w1; }
                else { unsigned char* rowp = (unsigned char*)O + row * (IN0W * 2) + 6144 + (col0 - 3072);
                    u32x4 o; o.x = cvt_pk4_fp8(a0[0], a0[1], a0[2], a0[3]); o.y = cvt_pk4_fp8(a1[0], a1[1], a1[2], a1[3]); o.z = cvt_pk4_fp8(b0[0], b0[1], b0[2], b0[3]); o.w = cvt_pk4_fp8(b1[0], b1[1], b1[2], b1[3]);
                    *(u32x4*)rowp = o; } }
    }
};
struct EpiF8 {
    static constexpr bool PERM = true, PERM16 = true; typedef NoPre Pre; static constexpr int NST = 8;
    unsigned char* O; int ldc; float scale;
    __device__ __forceinline__ Pre prefetch(const Unit&, int, int) const { return Pre{}; }
    __device__ __forceinline__ void operator()(const f32x4 (&acc)[2][2][4][2], const Unit& u, int wr, int wc, int fr, int fq, const Pre&) const {
        const int col0 = u.pn * BM + wc * 64 + 16 * fq;
#pragma unroll
        for (int ai = 0; ai < 2; ++ai)
#pragma unroll
            for (int m = 0; m < 4; ++m) { const int row = u.pm * BM + ai * HALF + wr * 64 + m * 16 + fr;
                unsigned char* rowp = O + (size_t)row * ldc + col0;
                const f32x4 a0 = acc[ai][0][m][0] * scale, a1 = acc[ai][0][m][1] * scale, b0 = acc[ai][1][m][0] * scale, b1 = acc[ai][1][m][1] * scale;
                u32x4 o; o.x = cvt_pk4_fp8(a0[0], a0[1], a0[2], a0[3]); o.y = cvt_pk4_fp8(a1[0], a1[1], a1[2], a1[3]); o.z = cvt_pk4_fp8(b0[0], b0[1], b0[2], b0[3]); o.w = cvt_pk4_fp8(b1[0], b1[1], b1[2], b1[3]);
                *(u32x4*)rowp = o; }
    }
};
struct EpiY8 {
    static constexpr bool PERM = true, PERM16 = true; typedef NoPre Pre; static constexpr int NST = 8;
    unsigned char* Y;
    __device__ __forceinline__ Pre prefetch(const Unit&, int, int) const { return Pre{}; }
    __device__ __forceinline__ void operator()(const f32x4 (&acc)[2][2][4][2], const Unit& u, int wr, int wc, int fr, int fq, const Pre&) const {
        const int col0 = u.pn * BM + wc * 64 + 16 * fq;
#pragma unroll
        for (int ai = 0; ai < 2; ++ai)
#pragma unroll
            for (int m = 0; m < 4; ++m) { const int tok = u.pm * BM + ai * HALF + wr * 64 + m * 16 + fr;
                unsigned char* rowp = Y + (size_t)(tok * 9 + 8) * D + col0;
                const f32x4 a0 = acc[ai][0][m][0] * Y_SCALE, a1 = acc[ai][0][m][1] * Y_SCALE, b0 = acc[ai][1][m][0] * Y_SCALE, b1 = acc[ai][1][m][1] * Y_SCALE;
                u32x4 o; o.x = cvt_pk4_fp8(a0[0], a0[1], a0[2], a0[3]); o.y = cvt_pk4_fp8(a1[0], a1[1], a1[2], a1[3]); o.z = cvt_pk4_fp8(b0[0], b0[1], b0[2], b0[3]); o.w = cvt_pk4_fp8(b1[0], b1[1], b1[2], b1[3]);
                *(u32x4*)rowp = o; }
    }
};
template <class Prob> __device__ __forceinline__ void fill_rec_cache(const Prob& P, LAS unsigned char* lds, int tid) {
    Unit u;
    for (int i = tid >> 8; i < 21 && P.next(i, u); i += 2) { const int r = tid & 255, rr = r < u.nrows ? r : u.nrows - 1;
        ((LAS unsigned*)(lds + EpiDown::rec_off(i)))[r] = (unsigned)P.list[2 * (size_t)(u.lbase + rr) + 1]; }
    __syncthreads();
}

template <class Prob, class Epi>
__device__ __forceinline__ void gemm_phase(LAS unsigned char* lds, const Prob& P, const Epi& E, int wave_s) {
    int tid_ = (wave_s << 6) + lane_id_(); asm volatile("" : "+v"(tid_));
    const int tid = tid_, wid = __builtin_amdgcn_readfirstlane(tid >> 6), lane = tid & 63, wr = wid >> 2, wc = wid & 3, fr = lane & 15, fq = lane >> 4;
    constexpr int ESZ = Prob::FP8 ? 1 : 2;
    const int K = P.K, nt = K * ESZ / (BK * 2);
    int Rst[2]; unsigned Cst2[2], voffB[2], voffBh[2][2];
#pragma unroll
    for (int i = 0; i < 2; ++i) { int R, C; stage_rc(tid * 16 + i * 8192, R, C); const int Rb = Epi::PERM ? ((R & ~31) + perm32(R & 31)) : R;
        Rst[i] = R; Cst2[i] = (unsigned)C * 2u; voffB[i] = (unsigned)(Rb * K) * (unsigned)ESZ + (unsigned)C * 2u;
        if constexpr (Epi::PERM16) { const int r16 = 64 * (R >> 5) + 16 * ((R & 15) >> 2) + 4 * ((R >> 4) & 1) + (R & 3);
            voffBh[0][i] = (unsigned)(r16 * K) * (unsigned)ESZ + (unsigned)C * 2u; voffBh[1][i] = (unsigned)((r16 + 8) * K) * (unsigned)ESZ + (unsigned)C * 2u; } }
    const size_t kstep = (size_t)(BK * 2);
    const size_t hstep = (size_t)HALF * K * ESZ;
    const unsigned ldsw = (unsigned)wid * 1024u;
    const int aoff = lds_byte(wr * 64 + fr, fq * 8), boff = lds_byte(wc * 32 + fr, fq * 8);
#define PG8_SA(b, h) (((b) * 2 + (h)) * HTB)
#define PG8_SB(b, h) ((4 + (b) * 2 + (h)) * HTB)
#define PG8_STAGE(bufoff, gbase, voff) do { _Pragma("unroll") for (int _i = 0; _i < 2; ++_i) \
        __builtin_amdgcn_global_load_lds((const unsigned*)((const char*)(gbase) + (voff)[_i]), (LAS unsigned*)(lds + (bufoff) + ldsw + _i * 8192), 16, 0, 0); } while (0)
#define PG8_LD2(dst, addr) do { const i32x4 _lo = *(const LAS i32x4*)(addr), _hi = *(const LAS i32x4*)((addr) + 1024); dst = __builtin_shufflevector(_lo, _hi, 0, 1, 2, 3, 4, 5, 6, 7); } while (0)
#define PG8_LDA(dst, b, h) do { _Pragma("unroll") for (int m = 0; m < 4; ++m) PG8_LD2(dst[m], lds + PG8_SA(b, h) + aoff + m * 2048); } while (0)
#define PG8_LDB(dst, b, h) do { _Pragma("unroll") for (int n = 0; n < 2; ++n) PG8_LD2(dst[n], lds + PG8_SB(b, h) + boff + n * 2048); } while (0)
#define PG8_LO(x) __builtin_bit_cast(bf16x8, __builtin_shufflevector(x, x, 0, 1, 2, 3))
#define PG8_HI(x) __builtin_bit_cast(bf16x8, __builtin_shufflevector(x, x, 4, 5, 6, 7))
#define PG8_MMA(ai, bj, At, Bt) do { __builtin_amdgcn_s_setprio(1); \
        if constexpr (Prob::FP8) { _Pragma("unroll") for (int m = 0; m < 4; ++m) _Pragma("unroll") for (int n = 0; n < 2; ++n) \
            asm volatile("v_mfma_scale_f32_16x16x128_f8f6f4 %0, %1, %2, %0, %3, %3 op_sel_hi:[0,0,0]" : "+v"(acc[ai][bj][m][n]) : "v"(Bt[n]), "v"(At[m]), "v"(mxscale)); } \
        else { _Pragma("unroll") for (int m = 0; m < 4; ++m) _Pragma("unroll") for (int n = 0; n < 2; ++n) { \
            acc[ai][bj][m][n] = __builtin_amdgcn_mfma_f32_16x16x32_bf16(PG8_LO(Bt[n]), PG8_LO(At[m]), acc[ai][bj][m][n], 0, 0, 0); \
            acc[ai][bj][m][n] = __builtin_amdgcn_mfma_f32_16x16x32_bf16(PG8_HI(Bt[n]), PG8_HI(At[m]), acc[ai][bj][m][n], 0, 0, 0); } } \
        __builtin_amdgcn_s_setprio(0); } while (0)
#define PG8_WAIT_V(n) asm volatile("s_waitcnt vmcnt(" #n ")" ::: "memory")
#define PG8_WAIT_R() do { if (relax) asm volatile("s_waitcnt vmcnt(%0)" :: "n"(8 + Epi::NST) : "memory"); else asm volatile("s_waitcnt vmcnt(8)" ::: "memory"); } while (0)
#define PG8_WAIT_L(n) asm volatile("s_waitcnt lgkmcnt(" #n ")" ::: "memory")
#define PG8_BAR __builtin_amdgcn_s_barrier()
#define PG8_SCHED __builtin_amdgcn_sched_barrier(0)
    Unit cur, nxt; int ui = 0;
    if (!P.next(0, cur)) return;
    f32x4 acc[2][2][4][2];
#pragma unroll
    for (int a = 0; a < 2; ++a)
#pragma unroll
        for (int b = 0; b < 2; ++b)
#pragma unroll
            for (int m = 0; m < 4; ++m)
#pragma unroll
                for (int n = 0; n < 2; ++n) acc[a][b][m][n] = (f32x4){0.f, 0.f, 0.f, 0.f};
    int mxscale = W8_SCALE_E8M0; asm volatile("" : "+v"(mxscale));
    i32x8 At[4], B0[2], B1[2];
    const char* aB = P.a_base();
    unsigned voAc[2][2], voAn[2][2], voffA[2]; const char* cAu = aB; const char* nAu = aB;
    if constexpr (Prob::GATHER) {
#pragma unroll
        for (int h = 0; h < 2; ++h)
#pragma unroll
            for (int i = 0; i < 2; ++i) voAc[h][i] = P.a_rowoff(cur, h * HALF + Rst[i]) + Cst2[i];
    } else {
#pragma unroll
        for (int i = 0; i < 2; ++i) voffA[i] = (unsigned)(Rst[i] * K) * (unsigned)ESZ + Cst2[i];
        cAu = aB + P.a_rowoff(cur, 0);
    }
#define PG8_STAGE_B(bufoff, ptr, h) do { if constexpr (Epi::PERM16) { PG8_STAGE(bufoff, ptr, voffBh[h]); } else { PG8_STAGE(bufoff, (ptr) + (h) * hstep, voffB); } } while (0)
#define PG8_STAGE_A(bufoff, ptr, h, SEL) do { if constexpr (Prob::GATHER) { if (SEL) { unsigned _vs[2] = {last ? voAn[h][0] : voAc[h][0], last ? voAn[h][1] : voAc[h][1]}; PG8_STAGE(bufoff, ptr, _vs); } else { PG8_STAGE(bufoff, ptr, voAc[h]); } } else { PG8_STAGE(bufoff, (ptr) + (h) * hstep, voffA); } } while (0)
    const char* cB = P.b_base(cur);
    { const char* p0 = Prob::GATHER ? aB : cAu; const bool last = false; (void)last;
    PG8_STAGE_B(PG8_SB(0, 0), cB, 0); PG8_STAGE_B(PG8_SB(0, 1), cB, 1); PG8_STAGE_A(PG8_SA(0, 0), p0, 0, 0); PG8_STAGE_A(PG8_SA(0, 1), p0, 1, 0);
    if (wr == 1) PG8_BAR;
    PG8_WAIT_V(2); PG8_BAR;
    PG8_STAGE_B(PG8_SB(1, 0), cB + kstep, 0); PG8_STAGE_A(PG8_SA(1, 0), p0 + kstep, 0, 0); PG8_STAGE_B(PG8_SB(1, 1), cB + kstep, 1);
    if constexpr (Prob::FP8) PG8_WAIT_V(0); else PG8_WAIT_V(6);
    PG8_BAR; }
    for (;;) {
        const typename Epi::Pre pre = E.prefetch(cur, wr, fr);
        const bool has_next = P.next(ui + 1, nxt);
        const char* nB = cB; nAu = cAu;
        if constexpr (Prob::GATHER) {
#pragma unroll
            for (int h = 0; h < 2; ++h)
#pragma unroll
                for (int i = 0; i < 2; ++i) voAn[h][i] = voAc[h][i];
        }
        if (has_next) { nB = P.b_base(nxt);
            if constexpr (Prob::GATHER) {
#pragma unroll
                for (int h = 0; h < 2; ++h)
#pragma unroll
                    for (int i = 0; i < 2; ++i) voAn[h][i] = P.a_rowoff(nxt, h * HALF + Rst[i]) + Cst2[i];
            } else nAu = aB + P.a_rowoff(nxt, 0); }
        const char* curA = Prob::GATHER ? aB : cAu; const char* nxtA = Prob::GATHER ? aB : nAu;
#define PG8_BODY() do { \
            const char* a1 = curA + (size_t)(t + 1) * kstep; \
            const char* a2 = last ? nxtA : curA + (size_t)(t + 2) * kstep; const char* b2 = last ? nB : cB + (size_t)(t + 2) * kstep; \
            const char* a3 = a2 + kstep; const char* b3 = b2 + kstep; \
              \
            PG8_LDB(B0, 0, 0); PG8_LDB(B1, 0, 1); PG8_SCHED; PG8_LDA(At, 0, 0); PG8_STAGE_A(PG8_SA(1, 1), a1, 1, 0); \
            PG8_WAIT_R(); PG8_WAIT_L(0); PG8_BAR; PG8_MMA(0, 0, At, B0); PG8_MMA(0, 1, At, B1); PG8_BAR; PG8_SCHED; \
              \
            PG8_LDA(At, 0, 1); PG8_STAGE_B(PG8_SB(0, 0), b2, 0); PG8_STAGE_B(PG8_SB(0, 1), b2, 1); PG8_STAGE_A(PG8_SA(0, 0), a2, 0, 1); \
            PG8_WAIT_R(); PG8_WAIT_L(0); PG8_BAR; PG8_MMA(1, 0, At, B0); PG8_MMA(1, 1, At, B1); PG8_BAR; PG8_SCHED; \
              \
            PG8_LDB(B0, 1, 0); PG8_LDB(B1, 1, 1); PG8_SCHED; PG8_LDA(At, 1, 0); PG8_STAGE_A(PG8_SA(0, 1), a2, 1, 1); \
            PG8_WAIT_V(8); PG8_WAIT_L(0); PG8_BAR; PG8_MMA(0, 0, At, B0); PG8_MMA(0, 1, At, B1); PG8_BAR; PG8_SCHED; \
              \
            PG8_LDA(At, 1, 1); PG8_STAGE_B(PG8_SB(1, 0), b3, 0); PG8_STAGE_B(PG8_SB(1, 1), b3, 1); PG8_STAGE_A(PG8_SA(1, 0), a3, 0, 1); \
            PG8_WAIT_V(8); PG8_WAIT_L(0); PG8_BAR; PG8_MMA(1, 0, At, B0); PG8_MMA(1, 1, At, B1); PG8_BAR; PG8_SCHED; \
        } while (0)
        if constexpr (Prob::NTC > 0) {
            _Pragma("unroll") for (int t = 0; t < Prob::NTC; t += 2) { const bool last = (t == Prob::NTC - 2); const bool relax = (t == 0); PG8_BODY(); }
        } else {
            if constexpr (Prob::FP8) { constexpr int t = 0; constexpr bool last = false, relax = true; PG8_BODY(); }
            for (int t = Prob::FP8 ? 2 : 0; t < nt; t += 2) { const bool last = (t == nt - 2); constexpr bool relax = false; PG8_BODY(); }
        }
#undef PG8_BODY
        if constexpr (Prob::FP8) asm volatile("s_nop 15\n\ts_nop 15" ::: "memory");
        if (wr == 0) PG8_BAR;
        E(acc, cur, wr, wc, fr, fq, pre);
        if (!has_next) break;
#pragma unroll
        for (int a = 0; a < 2; ++a)
#pragma unroll
            for (int b = 0; b < 2; ++b)
#pragma unroll
                for (int m = 0; m < 4; ++m)
#pragma unroll
                    for (int n = 0; n < 2; ++n) acc[a][b][m][n] = (f32x4){0.f, 0.f, 0.f, 0.f};
        cur = nxt; cB = nB; cAu = nAu; ++ui;
        if constexpr (Prob::GATHER) {
#pragma unroll
            for (int h = 0; h < 2; ++h)
#pragma unroll
                for (int i = 0; i < 2; ++i) voAc[h][i] = voAn[h][i];
        }
        if (wr == 1) PG8_BAR;
    }
    PG8_WAIT_V(0);
    PG8_BAR;
#undef PG8_SA
#undef PG8_SB
#undef PG8_STAGE
#undef PG8_STAGE_A
#undef PG8_STAGE_B
#undef PG8_LDA
#undef PG8_LDB
#undef PG8_MMA
#undef PG8_LD2
#undef PG8_LO
#undef PG8_HI
#undef PG8_WAIT_V
#undef PG8_WAIT_R
#undef PG8_WAIT_L
#undef PG8_BAR
#undef PG8_SCHED
}
}
struct Frame {
    LAS unsigned char* lds; int tid, lane, wave, G, bid;
    const float* const* in; float* out; unsigned char* ws;
};

constexpr int EXP_ITEMS = 768;
constexpr int CONV_SCR = 17408;
struct ConvItem { const float* src; unsigned char* dst; int ldw, K, fp8; };
__device__ __forceinline__ ConvItem conv_matrix(const float* W, int ldw, int K, int N, bf16_t* WT, int item, int fp8 = 0) {
    const int nblk = N / 32, kb = item / nblk, nb = item % nblk; ConvItem c; c.src = W + (size_t)(128 * kb) * ldw + 32 * nb; c.dst = (unsigned char*)WT + ((size_t)(32 * nb) * K + 128 * kb) * (fp8 ? 1 : 2); c.ldw = ldw; c.K = K; c.fp8 = fp8; return c;
}
struct ConvSrc { const float* g; const float* u; const float* d; const float* sg; const float* su; const float* sd; unsigned char* ws; };
__device__ __forceinline__ ConvSrc conv_src(const Frame& F) { ConvSrc c; c.g = F.in[15]; c.u = F.in[16]; c.d = F.in[17]; c.sg = F.in[18]; c.su = F.in[19]; c.sd = F.in[20]; c.ws = F.ws; return c; }
__device__ __forceinline__ ConvItem conv_expert(const ConvSrc& S, int layer, int item) {
    const int e = item / EXP_ITEMS, r = item % EXP_ITEMS, which = r / 256, it = r % 256; ConvItem c;
    if (which < 2) {
        const float* W = e < NE ? (which ? S.u : S.g) + ((size_t)layer * NE + e) * D * EDIM : (which ? S.su : S.sg) + (size_t)layer * D * EDIM;
        const int kb = it / 16, nb = it % 16, n0 = 32 * nb;
        const int dest = (n0 >> 7) * 256 + which * 128 + (n0 & 127);
        c.src = W + (size_t)(128 * kb) * EDIM + n0; c.ldw = EDIM; c.K = D;
        if (e < NE) { c.dst = (S.ws + WS_WGU + (size_t)layer * WGU_LAYER) + ((size_t)e * 1024 + dest) * D + 128 * kb; c.fp8 = 1; }
        else { c.dst = (S.ws + WS_WSH + (size_t)layer * WSH_LAYER) + ((size_t)dest * D + 128 * kb); c.fp8 = 1; }
    } else {
        const float* W = e < NE ? S.d + ((size_t)layer * NE + e) * EDIM * D : S.sd + (size_t)layer * EDIM * D;
        const int kb = it / 64, nb = it % 64;
        c.src = W + (size_t)(128 * kb) * D + 32 * nb; c.ldw = D; c.K = EDIM;
        if (e < NE) { c.dst = (S.ws + WS_WD + (size_t)layer * WD_LAYER) + ((size_t)e * D + 32 * nb) * EDIM + 128 * kb; c.fp8 = 1; }
        else { c.dst = (S.ws + WS_WSH + (size_t)layer * WSH_LAYER + 4 * MiB) + ((size_t)(32 * nb) * EDIM + 128 * kb) * 2; c.fp8 = 0; }
    }
    return c;
}
constexpr int CI0 = (D / 128) * (IN0W / 32), CI1 = (D / 128) * (D / 32), CI2 = (D / 128) * (IN1W / 32), CI3 = CI1;
__device__ __forceinline__ ConvItem conv_prologue(const Frame& F, int it) {
    int r = it;
    if (r < CI0) { const int nb_ = r % (IN0W / 32); if (F8_FGATE || nb_ < 128 || nb_ >= 160) return conv_matrix(F.in[3], IN0W, D, IN0W, (bf16_t*)(F.ws + WS_WIN0Q), r, 1); return conv_matrix(F.in[3], IN0W, D, IN0W, (bf16_t*)(F.ws + WS_WIN0), r); } r -= CI0;
    if (r < CI1) return conv_matrix(F.in[5], D, D, D, (bf16_t*)(F.ws + WS_WOUT0), r, 1); r -= CI1;
    if (r < CI2) return conv_matrix(F.in[6], IN1FULL, D, IN1W, (bf16_t*)(F.ws + WS_WIN1), r, 1); r -= CI2;
    if (r < CI3) return conv_matrix(F.in[8], D, D, D, (bf16_t*)(F.ws + WS_WOUT1), r, 1); r -= CI3;
    return conv_expert(conv_src(F), 0, r);
}
__device__ __forceinline__ void conv_load(const ConvItem& c, u32x4 (&t)[16], int lane) {
#pragma unroll
    for (int i = 0; i < 16; ++i) t[i] = __builtin_nontemporal_load((const u32x4*)(c.src + (size_t)(8 * i + (lane >> 3)) * c.ldw + 4 * (lane & 7)));
}
__device__ __forceinline__ void conv_store(const ConvItem& c, const u32x4 (&t)[16], LAS float* scr, int lane) {
#pragma unroll
    for (int i = 0; i < 16; ++i) { LAS unsigned* d = (LAS unsigned*)scr + (8 * i + (lane >> 3)) * 33 + 4 * (lane & 7); d[0] = t[i].x; d[1] = t[i].y; d[2] = t[i].z; d[3] = t[i].w; }
    LDS_WAIT(); asm volatile("" ::: "memory");
    const int cc = lane & 7;
#pragma unroll
    for (int j = 0; j < 4; ++j) { const int n = (lane >> 3) + 8 * j; const LAS float* sp = scr + (16 * cc) * 33 + n;
        if (c.fp8) {
            u32x4 o; o.x = cvt_pk4_fp8(sp[0 * 33] * W8_SCALE, sp[1 * 33] * W8_SCALE, sp[2 * 33] * W8_SCALE, sp[3 * 33] * W8_SCALE); o.y = cvt_pk4_fp8(sp[4 * 33] * W8_SCALE, sp[5 * 33] * W8_SCALE, sp[6 * 33] * W8_SCALE, sp[7 * 33] * W8_SCALE);
            o.z = cvt_pk4_fp8(sp[8 * 33] * W8_SCALE, sp[9 * 33] * W8_SCALE, sp[10 * 33] * W8_SCALE, sp[11 * 33] * W8_SCALE); o.w = cvt_pk4_fp8(sp[12 * 33] * W8_SCALE, sp[13 * 33] * W8_SCALE, sp[14 * 33] * W8_SCALE, sp[15 * 33] * W8_SCALE);
            __builtin_nontemporal_store(o, (u32x4*)(c.dst + (size_t)n * c.K + 16 * cc)); }
        else { u32x4 o, p; o.x = cvt_pk_bf16(sp[0 * 33], sp[1 * 33]); o.y = cvt_pk_bf16(sp[2 * 33], sp[3 * 33]); o.z = cvt_pk_bf16(sp[4 * 33], sp[5 * 33]); o.w = cvt_pk_bf16(sp[6 * 33], sp[7 * 33]);
            p.x = cvt_pk_bf16(sp[8 * 33], sp[9 * 33]); p.y = cvt_pk_bf16(sp[10 * 33], sp[11 * 33]); p.z = cvt_pk_bf16(sp[12 * 33], sp[13 * 33]); p.w = cvt_pk_bf16(sp[14 * 33], sp[15 * 33]);
            u32x4* dp = (u32x4*)(c.dst + ((size_t)n * c.K + 16 * cc) * 2); dp[0] = o; dp[1] = p; } }
    LDS_WAIT(); asm volatile("" ::: "memory");
}
template <int SPACE>
__device__ __forceinline__ void convert_items(const Frame& F, int layer, int i0, int i1, int cw, int nw) {
    LAS float* scr = (LAS float*)(F.lds + F.wave * CONV_SCR); const int lane = F.lane;
    const ConvSrc S = conv_src(F);
#define CONV_DEC(it_) (SPACE == 0 ? conv_prologue(F, it_) : conv_expert(S, layer, it_))
    int it = i0 + cw; if (it >= i1) return;
    u32x4 ta[16], tb[16];
    ConvItem ca = CONV_DEC(it), cb = ca;
    conv_load(ca, ta, lane);
    for (;;) {
        const bool hb = it + nw < i1; if (hb) { cb = CONV_DEC(it + nw); conv_load(cb, tb, lane); }
        conv_store(ca, ta, scr, lane);
        if (!hb) break;
        const bool ha = it + 2 * nw < i1; if (ha) { ca = CONV_DEC(it + 2 * nw); conv_load(ca, ta, lane); }
        conv_store(cb, tb, scr, lane);
        if (!ha) break;
        it += 2 * nw;
    }
#undef CONV_DEC
}
__device__ __forceinline__ int t5_bucket(int dist) {
    if (dist < 16) return dist;
    const double v = log((double)dist / 16.0) / log(2048.0 / 16.0) * 16.0;
    int b = 16 + (int)v; return b > 31 ? 31 : b;
}
__device__ __forceinline__ void phase_prologue(const Frame& F) {
    const int gw = F.bid * NWAVES + F.wave, NGW = F.G * NWAVES;
    convert_items<0>(F, 0, 0, CI0 + CI1 + CI2 + CI3 + ((CONVERTERS && F.G == 256) ? P0_EXPERT_ITEMS : NEX * EXP_ITEMS), gw, NGW);
    { const size_t gt = (size_t)F.bid * NTHREADS + F.tid, GT = (size_t)F.G * NTHREADS; const float* x = F.in[0]; bf16_t* xa = (bf16_t*)(F.ws + WS_XA);
      for (size_t i = gt; i < (size_t)NTOK * D / 8; i += GT) { const f32x4 a = *(const f32x4*)(x + i * 8), b = *(const f32x4*)(x + i * 8 + 4);
          u32x4 w; w.x = cvt_pk_bf16(a[0], a[1]); w.y = cvt_pk_bf16(a[2], a[3]); w.z = cvt_pk_bf16(b[0], b[1]); w.w = cvt_pk_bf16(b[2], b[3]); if (!F8_FGATE) *(u32x4*)(xa + i * 8) = w;
          u32x2 q; q.x = cvt_pk4_fp8(a[0], a[1], a[2], a[3]); q.y = cvt_pk4_fp8(b[0], b[1], b[2], b[3]); *(u32x2*)(F.ws + WS_XQ + i * 8) = q; } }
    { const int gt = F.bid * NTHREADS + F.tid, GT = F.G * NTHREADS;
      bf16_t* rt = (bf16_t*)(F.ws + WS_RT);
      for (int i = gt; i < 2 * 64 * D; i += GT) { const int layer = i / (64 * D), e = (i / D) % 64, k = i % D; const float w = F.in[13][((size_t)layer * D + k) * 64 + e] * F.in[9][layer * D + k];
          const unsigned hi = cvt_pk_bf16(w, 0.f) & 0xffffu; const float lo = w - __uint_as_float(hi << 16);
          rt[((size_t)(layer * 2 + 0) * 64 + e) * D + k] = (bf16_t)hi; rt[((size_t)(layer * 2 + 1) * 64 + e) * D + k] = (bf16_t)(cvt_pk_bf16(lo, 0.f) & 0xffffu); }
      { const int gwv = F.bid * NWAVES + F.wave; if (gwv < 128) { const int layer = gwv >> 6, e = gwv & 63; float sg = 0.f, sb = 0.f;
            for (int k = F.lane; k < D; k += 64) { const float w = F.in[13][((size_t)layer * D + k) * 64 + e]; sg += w * F.in[9][layer * D + k]; sb += w * F.in[10][layer * D + k]; }
            sg = wave_sum(sg); sb = wave_sum(sb); if (F.lane == 0) { float* rgb = (float*)(F.ws + WS_RGB); rgb[(layer * 2 + 0) * 64 + e] = sg; rgb[(layer * 2 + 1) * 64 + e] = sb; } } }
      bf16_t* fh = (bf16_t*)(F.ws + WS_FGHI); bf16_t* fl = (bf16_t*)(F.ws + WS_FGLO);
      for (int i = gt; i < 16 * D; i += GT) { const int j = i / D, k = i % D; const float w = F.in[6][(size_t)k * IN1FULL + IN1W + j];
          const unsigned hi = cvt_pk_bf16(w, 0.f) & 0xffffu; const float lo = w - __uint_as_float(hi << 16);
          fh[(size_t)j * D + k] = (bf16_t)hi; fl[(size_t)j * D + k] = (bf16_t)(cvt_pk_bf16(lo, 0.f) & 0xffffu); }
      float* lb = (float*)(F.ws + WS_LB);
      for (int i = gt; i < 1024; i += GT) { const float a = F.in[2][i], b = F.in[2][1024 + i], c = F.in[2][2048 + i]; const float m = fmaxf(a, fmaxf(b, c));
          const float ea = expf(a - m), eb = expf(b - m), ec = expf(c - m); lb[i] = ea / (ea + eb + ec); }
      float* br = (float*)(F.ws + WS_BIASREL);
      for (int i = gt; i < 3 * 8 * 132; i += GT) { const int b3 = i / (8 * 132), h = (i / 132) % 8, rel = i % 132; const int dil = b3 == 0 ? 1 : (b3 == 1 ? 4 : 16);
          br[i] = rel <= 128 ? F.in[1][t5_bucket(rel * dil) * 8 + h] : 0.f; } }
}
__device__ __forceinline__ void fox_cumsum(const Frame& F) {
    const int gw = F.bid * NWAVES + F.wave, lane = F.lane;
    if (gw < 64) { const int b = gw >> 4, h = gw & 15; const float* __restrict__ fl = (const float*)(F.ws + WS_FLOG) + (size_t)b * SEQ * 16 + h; float* __restrict__ cc = (float*)(F.ws + WS_CC) + (size_t)gw * SEQ; const float bf = F.in[7][h];
        float run = 0.f;
#pragma unroll 1
        for (int half = 0; half < 2; ++half) {
            float z[32];
#pragma unroll
            for (int i = 0; i < 32; ++i) z[i] = fl[(size_t)((half * 32 + i) * 64 + lane) * 16];
#pragma unroll
            for (int i = 0; i < 32; ++i) { const float zz = z[i] + bf;
                float v = fminf(zz, 0.f) - log1pf(__expf(-fabsf(zz)));
#pragma unroll
                for (int o = 1; o < 64; o <<= 1) { const float u = __shfl_up(v, o); if (lane >= o) v += u; }
                cc[(half * 32 + i) * 64 + lane] = run + v; run += __shfl(v, 63); } } }
}
__device__ __forceinline__ void convert_experts(const Frame& F, int layer, int i0, int i1, int cw, int nw) { convert_items<1>(F, layer, i0, i1, cw, nw); }
constexpr int CONV_STRIDE = 4;
__device__ __forceinline__ bool is_converter(const Frame& F) { return CONVERTERS && F.G == 256 && ((F.bid >> 3) % CONV_STRIDE) == CONV_STRIDE - 1; }
__device__ __forceinline__ Frame work_frame(const Frame& F) { Frame W = F; if (CONVERTERS && F.G == 256) { const int local = F.bid >> 3; W.bid = (local - local / CONV_STRIDE) * 8 + (F.bid & 7); W.G = 256 - 256 / CONV_STRIDE; } return W; }
__device__ __forceinline__ int conv_cw(const Frame& F) { return (((F.bid >> 3) / CONV_STRIDE) * 8 + (F.bid & 7)) * NWAVES + F.wave; }
constexpr int CONV_NW = (256 / CONV_STRIDE) * NWAVES;
constexpr int CONV_L0_JOBS = NEX * EXP_ITEMS - P0_EXPERT_ITEMS, CONV_JOBS = CONV_L0_JOBS + NEX * EXP_ITEMS;
__device__ __forceinline__ void convert_jobs(const Frame& F, int j0, int j1) {
    const int cw = conv_cw(F);
    if (j0 < CONV_L0_JOBS) convert_items<1>(F, 0, P0_EXPERT_ITEMS + j0, P0_EXPERT_ITEMS + (j1 < CONV_L0_JOBS ? j1 : CONV_L0_JOBS), cw, CONV_NW);
    if (j1 > CONV_L0_JOBS) convert_items<1>(F, 1, (j0 > CONV_L0_JOBS ? j0 : CONV_L0_JOBS) - CONV_L0_JOBS, j1 - CONV_L0_JOBS, cw, CONV_NW);
}
struct RowArgs {
    const float* vin; const bf16_t* Y; const float* gam; const float* bet; float* xo; bf16_t* xob;
    const bf16_t* whi; const bf16_t* wlo; const float* rbias; unsigned* cnt; int* lists; const bf16_t* ysh; float* flog;
};
template <int MODE, int NT>
__device__ __forceinline__ void phase_rows(const Frame& F, const RowArgs& a) {
    const int lane = F.lane, wave = F.wave, fr = lane & 15, fq = lane >> 4;
    LAS float* xch = (LAS float*)(F.lds);
    LAS float* scb = (LAS float*)(F.lds + 16384);
    for (int base = F.bid * 4; base < NTOK / 16; base += F.G * 4) {
#pragma unroll 1
        for (int i = 0; i < 8; ++i) {
            const int tok = (base + (wave >> 1)) * 16 + (wave & 1) * 8 + i;
            const int l8 = 8 * lane;
            f32x4 va[4], vb[4];
            if (MODE == 1) { const bf16_t* src = (const bf16_t*)a.vin + (size_t)tok * D + l8;
#pragma unroll
                for (int j = 0; j < 4; ++j) { const u32x4 w = __builtin_nontemporal_load((const u32x4*)(src + 512 * j));
                    va[j] = (f32x4){bf_lo(w.x), bf_hi(w.x), bf_lo(w.y), bf_hi(w.y)} * (DN_ALPHA * Y_SCALE); vb[j] = (f32x4){bf_lo(w.z), bf_hi(w.z), bf_lo(w.w), bf_hi(w.w)} * (DN_ALPHA * Y_SCALE); } }
            else { const float* src = a.vin + (size_t)tok * D + l8;
#pragma unroll
                for (int j = 0; j < 4; ++j) { va[j] = *(const f32x4*)(src + 512 * j) * DN_ALPHA; vb[j] = *(const f32x4*)(src + 512 * j + 4) * DN_ALPHA; } }
            if (MODE == 0) { const bf16_t* ys = a.Y + (size_t)tok * D + l8;
#pragma unroll
                for (int j = 0; j < 4; ++j) { const u32x4 w = *(const u32x4*)(ys + 512 * j);
                    va[j][0] += bf_lo(w.x); va[j][1] += bf_hi(w.x); va[j][2] += bf_lo(w.y); va[j][3] += bf_hi(w.y); vb[j][0] += bf_lo(w.z); vb[j][1] += bf_hi(w.z); vb[j][2] += bf_lo(w.w); vb[j][3] += bf_hi(w.w); } }
            if (MODE == 1) {
                { const unsigned char* ys = (const unsigned char*)a.Y + ((size_t)tok * 9 + 8) * D + l8;
                  u32x2 w9[4];
#pragma unroll
                  for (int j = 0; j < 4; ++j) w9[j] = __builtin_nontemporal_load((const u32x2*)(ys + 512 * j));
#pragma unroll
                  for (int j = 0; j < 4; ++j) {
                      const f32x2 p0 = __builtin_amdgcn_cvt_pk_f32_fp8((int)w9[j].x, false), p1 = __builtin_amdgcn_cvt_pk_f32_fp8((int)w9[j].x, true), p2 = __builtin_amdgcn_cvt_pk_f32_fp8((int)w9[j].y, false), p3 = __builtin_amdgcn_cvt_pk_f32_fp8((int)w9[j].y, true);
                      va[j][0] += p0.x; va[j][1] += p0.y; va[j][2] += p1.x; va[j][3] += p1.y; vb[j][0] += p2.x; vb[j][1] += p2.y; vb[j][2] += p3.x; vb[j][3] += p3.y; }
                  asm volatile("" : "+v"(va[0]), "+v"(va[1]), "+v"(va[2]), "+v"(va[3]), "+v"(vb[0]), "+v"(vb[1]), "+v"(vb[2]), "+v"(vb[3]) :: "memory"); }
#pragma unroll
                for (int sb3 = 0; sb3 < 2; ++sb3) {
                    u32x2 w[4][4];
#pragma unroll
                    for (int s = 0; s < 4; ++s) { const unsigned char* ys = (const unsigned char*)a.Y + ((size_t)tok * 9 + 4 * sb3 + s) * D + l8;
#pragma unroll
                        for (int j = 0; j < 4; ++j) w[s][j] = __builtin_nontemporal_load((const u32x2*)(ys + 512 * j)); }
#pragma unroll
                    for (int s = 0; s < 4; ++s)
#pragma unroll
                        for (int j = 0; j < 4; ++j) {
                            const f32x2 p0 = __builtin_amdgcn_cvt_pk_f32_fp8((int)w[s][j].x, false), p1 = __builtin_amdgcn_cvt_pk_f32_fp8((int)w[s][j].x, true), p2 = __builtin_amdgcn_cvt_pk_f32_fp8((int)w[s][j].y, false), p3 = __builtin_amdgcn_cvt_pk_f32_fp8((int)w[s][j].y, true);
                            va[j][0] += p0.x; va[j][1] += p0.y; va[j][2] += p1.x; va[j][3] += p1.y; vb[j][0] += p2.x; vb[j][1] += p2.y; vb[j][2] += p3.x; vb[j][3] += p3.y; }
                    asm volatile("" : "+v"(va[0]), "+v"(va[1]), "+v"(va[2]), "+v"(va[3]), "+v"(vb[0]), "+v"(vb[1]), "+v"(vb[2]), "+v"(vb[3]) :: "memory");
                }
#pragma unroll
                for (int j = 0; j < 4; ++j) { va[j] = va[j] * (1.0f / Y_SCALE); vb[j] = vb[j] * (1.0f / Y_SCALE); }
            }
            float s1 = 0.f;
#pragma unroll
            for (int j = 0; j < 4; ++j) s1 += ((va[j][0] + va[j][1]) + (va[j][2] + va[j][3])) + ((vb[j][0] + vb[j][1]) + (vb[j][2] + vb[j][3]));
            const float mean = wave_sum(s1) * (1.0f / D); float s2 = 0.f;
#pragma unroll
            for (int j = 0; j < 4; ++j) { va[j] = va[j] - mean; vb[j] = vb[j] - mean;
                s2 += ((va[j][0] * va[j][0] + va[j][1] * va[j][1]) + (va[j][2] * va[j][2] + va[j][3] * va[j][3])) + ((vb[j][0] * vb[j][0] + vb[j][1] * vb[j][1]) + (vb[j][2] * vb[j][2] + vb[j][3] * vb[j][3])); }
            const float rstd = 1.0f / sqrtf(wave_sum(s2) * (1.0f / D) + LN_EPS);
            float* dst = a.xo + (size_t)tok * D + l8;
            asm volatile("" : "+v"(va[0]), "+v"(va[1]), "+v"(va[2]), "+v"(va[3]), "+v"(vb[0]), "+v"(vb[1]), "+v"(vb[2]), "+v"(vb[3]) :: "memory");
#pragma unroll
            for (int j = 0; j < 4; ++j) { const f32x4 g0 = *(const f32x4*)(a.gam + 512 * j + l8), g1 = *(const f32x4*)(a.gam + 512 * j + l8 + 4), b0 = *(const f32x4*)(a.bet + 512 * j + l8), b1 = *(const f32x4*)(a.bet + 512 * j + l8 + 4);
                const f32x4 o0 = va[j] * rstd * g0 + b0, o1 = vb[j] * rstd * g1 + b1;
                if (NT != 0) { u32x4 wb; wb.x = cvt_pk_bf16(o0[0], o0[1]); wb.y = cvt_pk_bf16(o0[2], o0[3]); wb.z = cvt_pk_bf16(o1[0], o1[1]); wb.w = cvt_pk_bf16(o1[2], o1[3]); *(u32x4*)((bf16_t*)a.xo + (size_t)tok * D + l8 + 512 * j) = wb; }
                else { *(f32x4*)(dst + 512 * j) = o0; *(f32x4*)(dst + 512 * j + 4) = o1; }
                if (NT != 0) { u32x2 w; w.x = cvt_pk4_fp8(o0[0], o0[1], o0[2], o0[3]); w.y = cvt_pk4_fp8(o1[0], o1[1], o1[2], o1[3]); *(u32x2*)((unsigned char*)a.xob + (size_t)tok * D + l8 + 512 * j) = w; }
                if (j & 1) asm volatile("" ::: "memory"); }
        }
        if (NT == 0) continue;
        VM_WAIT(); __syncthreads();
        const int task = base + (wave & 3), kh = wave >> 2;
        f32x4 acc[NT > 0 ? NT : 1];
#pragma unroll
        for (int n = 0; n < NT; ++n) acc[n] = (f32x4){0.f, 0.f, 0.f, 0.f};
        const bf16_t* xr = (const bf16_t*)a.xo + (size_t)(task * 16 + fr) * D + 8 * fq;
#pragma unroll 4
        for (int kb = kh * 32; kb < kh * 32 + 32; ++kb) {
            const bf16x8 ah = *(const bf16x8*)(xr + 32 * kb);
#pragma unroll
            for (int n = 0; n < NT; ++n) { const size_t wo = (size_t)(16 * n + fr) * D + 32 * kb + 8 * fq;
                const bf16x8 bh = *(const bf16x8*)(a.whi + wo), bl = *(const bf16x8*)(a.wlo + wo);
                acc[n] = MFMA16(ah, bh, acc[n]); acc[n] = MFMA16(ah, bl, acc[n]); }
        }
        if (kh == 1) {
#pragma unroll
            for (int n = 0; n < NT; ++n) *(LAS f32x4*)(xch + (((wave & 3) * 4 + n) * 64 + lane) * 4) = acc[n];
        }
        __syncthreads();
        if (kh == 0) {
#pragma unroll
            for (int n = 0; n < NT; ++n) acc[n] = acc[n] + *(const LAS f32x4*)(xch + (((wave & 3) * 4 + n) * 64 + lane) * 4);
            if (NT == 1) {
#pragma unroll
                for (int r = 0; r < 4; ++r) a.flog[(size_t)(task * 16 + 4 * fq + r) * 16 + fr] = acc[0][r];
            } else {
                LAS float* sc = scb + (wave & 3) * (2 * 16 * 68); LAS float* sl = sc + 16 * 68;
#pragma unroll
                for (int n = 0; n < NT; ++n)
#pragma unroll
                    for (int r = 0; r < 4; ++r) { const int e = 16 * n + fr; const float s = 1.0f / (1.0f + expf(-acc[n][r])); sc[(4 * fq + r) * 68 + e] = s; sl[(4 * fq + r) * 68 + e] = s + a.rbias[e]; }
                LDS_WAIT(); asm volatile("" ::: "memory");
                if (lane < 16) {
                    const int tok = task * 16 + lane; const LAS float* ms = sc + lane * 68; LAS float* ml = sl + lane * 68;
                    float gs[8];
#pragma unroll
                    for (int g = 0; g < 8; ++g) { float m1 = -3e38f, m2 = -3e38f;
#pragma unroll
                        for (int j = 0; j < 8; ++j) { const float x = ml[8 * g + j]; if (x > m1) { m2 = m1; m1 = x; } else if (x > m2) m2 = x; }
                        gs[g] = m1 + m2; }
                    unsigned gmask = 0u;
#pragma unroll
                    for (int rnd = 0; rnd < 4; ++rnd) { float best = -3e38f; int bi = 0;
#pragma unroll
                        for (int g = 0; g < 8; ++g) { const bool ok = !((gmask >> g) & 1u) && gs[g] > best; best = ok ? gs[g] : best; bi = ok ? g : bi; }
                        gmask |= 1u << bi; }
                    int eid[8]; float ew[8]; float wsum = 0.f;
#pragma unroll
                    for (int rnd = 0; rnd < 8; ++rnd) { float best = -3e38f; int bi = 0;
#pragma unroll 1
                        for (int e = 0; e < 64; ++e) { const float x = ml[e]; const bool ok = ((gmask >> (e >> 3)) & 1u) && x > best; best = ok ? x : best; bi = ok ? e : bi; }
                        eid[rnd] = bi; ew[rnd] = ms[bi]; wsum += ms[bi]; ml[bi] = -3e38f; }
                    const float inv = 2.5f / wsum;
#pragma unroll
                    for (int j = 0; j < 8; ++j) { const unsigned pos = atomicAdd(a.cnt + 64 * eid[j], 1u); u32x2 rec; rec.x = (unsigned)(tok * 16 + j); rec.y = ((unsigned)tok << 18) | ((unsigned)j << 14) | (unsigned)(ew[j] * inv * (16383.0f / 2.5f) + 0.5f); *(u32x2*)(a.lists + 2 * ((size_t)eid[j] * LISTCAP + pos)) = rec; }
                    { u32x2 rec; rec.x = (unsigned)(tok * 16 + 8); rec.y = ((unsigned)tok << 18) | (8u << 14) | (unsigned)(16383.0f / 2.5f + 0.5f); *(u32x2*)(a.lists + 2 * ((size_t)NE * LISTCAP + tok)) = rec; }
                }
            }
        }
        __syncthreads();
    }
}

struct RouterArgs { const float* xres; const bf16_t* ymix; const float* gam; const float* bet; bf16_t* xob; unsigned char* xoq;
                    const bf16_t* whi; const bf16_t* wlo; const float* gvec; const float* bvec; const float* rbias; unsigned* cnt; int* lists; };
template <bool XB16> __device__ __forceinline__ void phase_router(const Frame& F, const RouterArgs& a) {
    int lane_ = F.lane; asm volatile("" : "+v"(lane_));
    const int lane = lane_, wave = F.wave, fr = lane & 15, fq = lane >> 4;
    LAS f32x4* pacc = (LAS f32x4*)(F.lds);
    LAS f32x2* pst = (LAS f32x2*)(F.lds + 32768);
    const __amdgpu_buffer_rsrc_t rs_hi = __builtin_amdgcn_make_buffer_rsrc((void*)a.whi, 0, 64 * D * 2, 0x00020000);
    const __amdgpu_buffer_rsrc_t rs_lo = __builtin_amdgcn_make_buffer_rsrc((void*)a.wlo, 0, 64 * D * 2, 0x00020000);
    const int wvoff = (fr * D + 8 * fq) * 2;
    for (int task = F.bid; task < NTOK / 16; task += F.G) {
        const int tok0 = task * 16;
        f32x4 va[8], vb[8];
        {   const float* xp = a.xres + (size_t)(tok0 + fr) * D + 256 * wave + 8 * fq; const bf16_t* yp = a.ymix + (size_t)(tok0 + fr) * D + 256 * wave + 8 * fq;
#pragma unroll
            for (int i = 0; i < 8; ++i) { f32x4 x0, x1; if (XB16) { const u32x4 xw = *(const u32x4*)((const bf16_t*)a.xres + (size_t)(tok0 + fr) * D + 256 * wave + 8 * fq + 32 * i); x0 = (f32x4){bf_lo(xw.x), bf_hi(xw.x), bf_lo(xw.y), bf_hi(xw.y)}; x1 = (f32x4){bf_lo(xw.z), bf_hi(xw.z), bf_lo(xw.w), bf_hi(xw.w)}; } else { x0 = *(const f32x4*)(xp + 32 * i); x1 = *(const f32x4*)(xp + 32 * i + 4); } const u32x2 w = *(const u32x2*)((const unsigned char*)a.ymix + (size_t)(tok0 + fr) * D + 256 * wave + 8 * fq + 32 * i);
                const f32x2 p0 = __builtin_amdgcn_cvt_pk_f32_fp8((int)w.x, false), p1 = __builtin_amdgcn_cvt_pk_f32_fp8((int)w.x, true), p2 = __builtin_amdgcn_cvt_pk_f32_fp8((int)w.y, false), p3 = __builtin_amdgcn_cvt_pk_f32_fp8((int)w.y, true);
                va[i] = x0 * DN_ALPHA + (f32x4){p0.x, p0.y, p1.x, p1.y} * (1.0f / YF_SCALE); vb[i] = x1 * DN_ALPHA + (f32x4){p2.x, p2.y, p3.x, p3.y} * (1.0f / YF_SCALE); } }
        float s1 = 0.f, s2 = 0.f;
#pragma unroll
        for (int i = 0; i < 8; ++i) { s1 += ((va[i][0] + va[i][1]) + (va[i][2] + va[i][3])) + ((vb[i][0] + vb[i][1]) + (vb[i][2] + vb[i][3]));
            s2 += ((va[i][0] * va[i][0] + va[i][1] * va[i][1]) + (va[i][2] * va[i][2] + va[i][3] * va[i][3])) + ((vb[i][0] * vb[i][0] + vb[i][1] * vb[i][1]) + (vb[i][2] * vb[i][2] + vb[i][3] * vb[i][3])); }
        s1 += __shfl_xor(s1, 16); s1 += __shfl_xor(s1, 32); s2 += __shfl_xor(s2, 16); s2 += __shfl_xor(s2, 32);
        f32x4 acc[4];
#pragma unroll
        for (int n = 0; n < 4; ++n) acc[n] = (f32x4){0.f, 0.f, 0.f, 0.f};
#pragma unroll
        for (int i = 0; i < 8; ++i) {
            const f32x4 x0 = va[i], x1 = vb[i];
            u32x4 hi; hi.x = cvt_pk_bf16(x0[0], x0[1]); hi.y = cvt_pk_bf16(x0[2], x0[3]); hi.z = cvt_pk_bf16(x1[0], x1[1]); hi.w = cvt_pk_bf16(x1[2], x1[3]);
            u32x4 lo; lo.x = cvt_pk_bf16(x0[0] - bf_lo(hi.x), x0[1] - bf_hi(hi.x)); lo.y = cvt_pk_bf16(x0[2] - bf_lo(hi.y), x0[3] - bf_hi(hi.y));
            lo.z = cvt_pk_bf16(x1[0] - bf_lo(hi.z), x1[1] - bf_hi(hi.z)); lo.w = cvt_pk_bf16(x1[2] - bf_lo(hi.w), x1[3] - bf_hi(hi.w));
            const bf16x8 ah = __builtin_bit_cast(bf16x8, hi), al = __builtin_bit_cast(bf16x8, lo);
#pragma unroll
            for (int n = 0; n < 4; ++n) { const int so = ((16 * n) * D + 256 * wave + 32 * i) * 2;
                const bf16x8 bh = __builtin_bit_cast(bf16x8, __builtin_amdgcn_raw_buffer_load_b128(rs_hi, wvoff, so, 0)), bl = __builtin_bit_cast(bf16x8, __builtin_amdgcn_raw_buffer_load_b128(rs_lo, wvoff, so, 0));
                acc[n] = MFMA16(ah, bh, acc[n]); acc[n] = MFMA16(al, bh, acc[n]); acc[n] = MFMA16(ah, bl, acc[n]); }
            if (i & 1) asm volatile("" ::: "memory");
        }
        __syncthreads();
        if (fq == 0) pst[wave * 16 + fr] = (f32x2){s1, s2};
#pragma unroll
        for (int n = 0; n < 4; ++n) pacc[(wave * 4 + n) * 64 + lane] = acc[n];
        __syncthreads();
        float S1 = 0.f, S2 = 0.f;
#pragma unroll
        for (int w = 0; w < 8; ++w) { const f32x2 p = pst[w * 16 + fr]; S1 += p.x; S2 += p.y; }
        const float mean = S1 * (1.0f / D); const float var = fmaxf(S2 * (1.0f / D) - mean * mean, 0.f); const float rstd = 1.0f / sqrtf(var + LN_EPS);
        {   bf16_t* op = a.xob + (size_t)(tok0 + fr) * D + 256 * wave + 8 * fq; const float* gp = a.gam + 256 * wave + 8 * fq; const float* bp = a.bet + 256 * wave + 8 * fq;
#pragma unroll
            for (int i = 0; i < 8; ++i) { const f32x4 g0 = *(const f32x4*)(gp + 32 * i), g1 = *(const f32x4*)(gp + 32 * i + 4), b0 = *(const f32x4*)(bp + 32 * i), b1 = *(const f32x4*)(bp + 32 * i + 4);
                const f32x4 o0 = (va[i] - mean) * rstd * g0 + b0, o1 = (vb[i] - mean) * rstd * g1 + b1;
                u32x4 w; w.x = cvt_pk_bf16(o0[0], o0[1]); w.y = cvt_pk_bf16(o0[2], o0[3]); w.z = cvt_pk_bf16(o1[0], o1[1]); w.w = cvt_pk_bf16(o1[2], o1[3]); *(u32x4*)(op + 32 * i) = w;
                u32x2 wq; wq.x = cvt_pk4_fp8(o0[0], o0[1], o0[2], o0[3]); wq.y = cvt_pk4_fp8(o1[0], o1[1], o1[2], o1[3]); *(u32x2*)(a.xoq + (size_t)(tok0 + fr) * D + 256 * wave + 8 * fq + 32 * i) = wq; } }
#pragma unroll 1
        for (int tt = 0; tt < 2; ++tt) {
            const int t = 2 * wave + tt, tok = tok0 + t;
            float T1 = 0.f, T2 = 0.f;
#pragma unroll
            for (int w = 0; w < 8; ++w) { const f32x2 p = pst[w * 16 + t]; T1 += p.x; T2 += p.y; }
            const float tm = T1 * (1.0f / D); const float tv = fmaxf(T2 * (1.0f / D) - tm * tm, 0.f); const float tr = 1.0f / sqrtf(tv + LN_EPS);
            float raw = 0.f;
#pragma unroll
            for (int w = 0; w < 8; ++w) { const LAS float* pp = (const LAS float*)(pacc + (w * 4 + (lane >> 4)) * 64 + (t >> 2) * 16 + (lane & 15)); raw += pp[t & 3]; }
            const float logit = tr * (raw - tm * a.gvec[lane]) + a.bvec[lane];
            const float sc = 1.0f / (1.0f + expf(-logit)); const float sel = sc + a.rbias[lane];
            int rg = 0;
#pragma unroll
            for (int d = 1; d < 8; ++d) { const float so = __shfl_xor(sel, d); rg += (so > sel || (so == sel && (lane ^ d) < lane)) ? 1 : 0; }
            float gs = rg < 2 ? sel : 0.f; gs += __shfl_xor(gs, 1); gs += __shfl_xor(gs, 2); gs += __shfl_xor(gs, 4);
            const int g = lane >> 3; int rk = 0;
#pragma unroll
            for (int g2 = 0; g2 < 8; ++g2) { const float go = __int_as_float(__builtin_amdgcn_readlane(__float_as_int(gs), 8 * g2)); rk += (go > gs || (go == gs && g2 < g)) ? 1 : 0; }
            const float selm = rk < 4 ? sel : -1e30f;
            int rank = 0;
#pragma unroll 4
            for (int e2 = 0; e2 < 64; ++e2) { const float so = __int_as_float(__builtin_amdgcn_readlane(__float_as_int(selm), e2)); rank += (so > selm || (so == selm && e2 < lane)) ? 1 : 0; }
            const bool chosen = rank < 8;
            const float wsum = wave_sum(chosen ? sc : 0.f);
            if (chosen) { const float wgt = sc * (2.5f / wsum); const unsigned pos = atomicAdd(a.cnt + 64 * lane, 1u);
                u32x2 rec; rec.x = (unsigned)(tok * 16 + rank); rec.y = ((unsigned)tok << 18) | ((unsigned)rank << 14) | (unsigned)(wgt * (16383.0f / 2.5f) + 0.5f);
                *(u32x2*)(a.lists + 2 * ((size_t)lane * LISTCAP + pos)) = rec; }
        }
    }
}
struct AttnState { float m, l; f32x4 o[8]; };
__device__ __forceinline__ void attn_init(AttnState& st) { st.m = -1e30f; st.l = 0.f;
#pragma unroll
    for (int c = 0; c < 8; ++c) st.o[c] = (f32x4){0.f, 0.f, 0.f, 0.f}; }
__device__ __forceinline__ void attn_scores(const LAS unsigned char* lds, unsigned kb, const bf16x8 (&qf)[4], f32x4 (&s)[4], int fr, int fq) {
#pragma unroll
    for (int kt = 0; kt < 4; ++kt) { s[kt] = (f32x4){0.f, 0.f, 0.f, 0.f};
#pragma unroll
        for (int ks = 0; ks < 4; ++ks) { const bf16x8 kf = *(const LAS bf16x8*)(lds + kb + off_b(16 * kt + fr, 4 * ks + fq)); s[kt] = MFMA16(kf, qf[ks], s[kt]); } }
}
__device__ __forceinline__ void attn_update(unsigned ldsbase, unsigned vb, f32x4 (&s)[4], AttnState& st, int lane) {
    float mx = -1e30f;
#pragma unroll
    for (int kt = 0; kt < 4; ++kt)
#pragma unroll
        for (int r = 0; r < 4; ++r) mx = fmaxf(mx, s[kt][r]);
    mx = fmaxf(mx, __shfl_xor(mx, 16)); mx = fmaxf(mx, __shfl_xor(mx, 32));
    const float mn = fmaxf(st.m, mx), alpha = __expf(st.m - mn);
    float ps = 0.f;
#pragma unroll
    for (int kt = 0; kt < 4; ++kt)
#pragma unroll
        for (int r = 0; r < 4; ++r) { const float p = __expf(s[kt][r] - mn); s[kt][r] = p; ps += p; }
    ps += __shfl_xor(ps, 16); ps += __shfl_xor(ps, 32);
    st.l = st.l * alpha + ps; st.m = mn;
#pragma unroll
    for (int c = 0; c < 8; ++c) st.o[c] = st.o[c] * alpha;
    const unsigned g = lane >> 4, q = (lane & 15) >> 2, p = lane & 3, xm = (q << 2) | g;
#pragma unroll
    for (int ks = 0; ks < 2; ++ks) {
        u32x4 pw; pw.x = cvt_pk_bf16(s[2 * ks][0], s[2 * ks][1]); pw.y = cvt_pk_bf16(s[2 * ks][2], s[2 * ks][3]); pw.z = cvt_pk_bf16(s[2 * ks + 1][0], s[2 * ks + 1][1]); pw.w = cvt_pk_bf16(s[2 * ks + 1][2], s[2 * ks + 1][3]);
        const bf16x8 pf = __builtin_bit_cast(bf16x8, pw);
        s16x4 v0[8], v1[8];
#pragma unroll
        for (int c = 0; c < 8; ++c) {
            const unsigned chunk = ((2u * c + (p >> 1)) ^ xm) * 16u + 8u * (p & 1u);
            v0[c] = tr_read(ldsbase + vb + 256u * (32u * ks + 4u * g + q) + chunk);
            v1[c] = tr_read(ldsbase + vb + 256u * (32u * ks + 16u + 4u * g + q) + chunk); }
        asm volatile("s_waitcnt lgkmcnt(0)" : "+v"(v0[0]), "+v"(v0[1]), "+v"(v0[2]), "+v"(v0[3]), "+v"(v0[4]), "+v"(v0[5]), "+v"(v0[6]), "+v"(v0[7]) :: "memory");
        asm volatile("" : "+v"(v1[0]), "+v"(v1[1]), "+v"(v1[2]), "+v"(v1[3]), "+v"(v1[4]), "+v"(v1[5]), "+v"(v1[6]), "+v"(v1[7]) :: "memory");
#pragma unroll
        for (int c = 0; c < 8; ++c) st.o[c] = MFMA16(cat8(v0[c], v1[c]), pf, st.o[c]);
    }
}
#define STAGE_TILE(ldsoff, nrows, ROWPTR) do { for (int _n = F.tid; _n < (nrows) * 16; _n += NTHREADS) { const int _r = _n >> 4, _ch = _n & 15; \
        const u32x4 _v = *(const u32x4*)((const char*)(ROWPTR(_r)) + _ch * 16); *(LAS u32x4*)(F.lds + (ldsoff) + off_b(_r, _ch)) = _v; } } while (0)

struct DilItem { int br, dil, b, h, res, n, seq; };
__device__ __forceinline__ DilItem dil_make(int w, int k) { DilItem d;
    if (k < 4) { const int s = w >> 3; d.br = 0; d.dil = 1; d.b = s >> 3; d.h = s & 7; d.res = 0; d.n = (w & 7) * 4 + k; d.seq = s; }
    else if (k < 8) { const int s = w >> 1; d.br = 1; d.dil = 4; d.b = s >> 5; d.h = (s >> 2) & 7; d.res = s & 3; d.n = (w & 1) * 4 + (k - 4); d.seq = 32 + s; }
    else { const int s = 2 * w + ((k - 8) >> 1); d.br = 2; d.dil = 16; d.b = s >> 7; d.h = (s >> 4) & 7; d.res = s & 15; d.n = (k - 8) & 1; d.seq = 160 + s; }
    return d; }
__device__ __forceinline__ void dilated_items(const Frame& F) {
    const bf16_t* proj = (const bf16_t*)(F.ws + WS_PROJ);
    const int lane = F.lane, wave = F.wave, fr = lane & 15, fq = lane >> 4;
    const unsigned ldsbase = (unsigned)(size_t)F.lds;
    constexpr int KOFF = 0, VOFF = 65536, BOFF = 131072;
    const int sr = F.tid >> 4, sch = F.tid & 15;
    u32x4 rk[8], rv[8];
#define DIL_TOKF(d, ki) ((size_t)(d).b * SEQ + (size_t)(128 * ((d).n - 1) + (ki)) * (d).dil + (d).res)
#define DIL_LD1(d, _i) do { const bf16_t* _p = proj + DIL_TOKF(d, sr + 32 * (_i)) * IN0W + 128 * (d).h + 8 * sch; rk[_i] = *(const u32x4*)(_p + 1024); rv[_i] = *(const u32x4*)(_p + 2048); } while (0)
#define DIL_LOAD(d, reuse) do { DIL_LD1(d, 4); DIL_LD1(d, 5); DIL_LD1(d, 6); DIL_LD1(d, 7); \
        if ((d).n > 0 && !(reuse)) { DIL_LD1(d, 0); DIL_LD1(d, 1); DIL_LD1(d, 2); DIL_LD1(d, 3); } } while (0)
    int w = F.bid, k = 0; if (w >= 256) return;
    DilItem d = dil_make(w, 0);
    bool reuse = false; int ph = 1;
    DIL_LOAD(d, false);
    for (;;) {
        __syncthreads();
#pragma unroll
        for (int i = 4; i < 8; ++i) { const unsigned o_ = off_b(128 * ph + sr + 32 * (i - 4), sch); *(LAS u32x4*)(F.lds + KOFF + o_) = rk[i]; *(LAS u32x4*)(F.lds + VOFF + o_) = rv[i]; }
        if (d.n > 0 && !reuse) {
#pragma unroll
            for (int i = 0; i < 4; ++i) { const unsigned o_ = off_b(128 * (ph ^ 1) + sr + 32 * i, sch); *(LAS u32x4*)(F.lds + KOFF + o_) = rk[i]; *(LAS u32x4*)(F.lds + VOFF + o_) = rv[i]; } }
        if (F.tid < 132) ((LAS float*)(F.lds + BOFF))[F.tid] = ((const float*)(F.ws + WS_BIASREL))[(d.br * 8 + d.h) * 132 + F.tid];
        bf16x8 qf[4];
        { const size_t qt_ = (size_t)d.b * SEQ + (size_t)(128 * d.n + 16 * wave + fr) * d.dil + d.res;
#pragma unroll
          for (int ks = 0; ks < 4; ++ks) qf[ks] = *(const bf16x8*)(proj + qt_ * IN0W + 128 * d.h + 32 * ks + 8 * fq); }
        const DilItem c = d; const int cph = ph;
        int nk = k + 1, nw = w; if (nk == 12) { nk = 0; nw = w + F.G; }
        const bool has_next = nw < 256;
        if (has_next) { d = dil_make(nw, nk); reuse = (d.seq == c.seq) && (d.n == c.n + 1); ph = reuse ? (cph ^ 1) : 1; DIL_LOAD(d, reuse); }
        __syncthreads();
        const int qi = 16 * wave + fr; const size_t qtok = (size_t)c.b * SEQ + (size_t)(128 * c.n + qi) * c.dil + c.res;
        AttnState st; attn_init(st);
        const LAS float* bt = (const LAS float*)(F.lds + BOFF);
#pragma unroll 1
        for (int j = (c.n == 0 ? 2 : 0); j < 4; ++j) {
            if (64 * j > 16 * wave + 15 + 128 || 64 * j + 63 < 16 * wave) continue;
            const int jp = j ^ ((cph ^ 1) << 1);
            f32x4 s[4];
            attn_scores(F.lds, KOFF + jp * 16384, qf, s, fr, fq);
#pragma unroll
            for (int kt = 0; kt < 4; ++kt)
#pragma unroll
                for (int r = 0; r < 4; ++r) { const int ki = 64 * j + 16 * kt + 4 * fq + r, rel = qi + 128 - ki; const bool ok = rel >= 0 && rel <= 128; const int rc = ok ? rel : 0;
                    s[kt][r] = ok ? s[kt][r] * ATT_SCALE + bt[rc] : -1e30f; }
            attn_update(ldsbase, VOFF + jp * 16384, s, st, lane);
        }
        const float inv = 1.0f / st.l; bf16_t* ob = (bf16_t*)(F.ws + WS_OBR) + ((size_t)c.br * NTOK + qtok) * 1024 + 128 * c.h;
#pragma unroll
        for (int cc = 0; cc < 8; ++cc) { u32x2 w_; w_.x = cvt_pk_bf16(st.o[cc][0] * inv, st.o[cc][1] * inv); w_.y = cvt_pk_bf16(st.o[cc][2] * inv, st.o[cc][3] * inv); *(u32x2*)(ob + 16 * cc + 4 * fq) = w_; }
        if (fq == 0) ((float*)(F.ws + WS_LSE))[((size_t)c.br * NTOK + qtok) * 8 + c.h] = st.m + __logf(st.l);
        if (!has_next) break;
        k = nk; w = nw;
    }
#undef DIL_TOKF
#undef DIL_LD1
#undef DIL_LOAD
}
__device__ __forceinline__ void combine_tokens(const Frame& F) {
    const int gw = F.bid * NWAVES + F.wave, NGW = F.G * NWAVES, lane = F.lane, h = lane >> 3;
    const bf16_t* ob = (const bf16_t*)(F.ws + WS_OBR); const float* lse = (const float*)(F.ws + WS_LSE); unsigned char* a2 = F.ws + WS_A2Q;
    for (int tok = gw; tok < NTOK; tok += NGW) {
        const float l0 = lse[((size_t)0 * NTOK + tok) * 8 + h], l1 = lse[((size_t)1 * NTOK + tok) * 8 + h], l2 = lse[((size_t)2 * NTOK + tok) * 8 + h];
        const float m = fmaxf(l0, fmaxf(l1, l2)); const float e0 = __expf(l0 - m), e1 = __expf(l1 - m), e2 = __expf(l2 - m), inv = 1.0f / (e0 + e1 + e2);
        const float w[3] = {e0 * inv, e1 * inv, e2 * inv};
        float acc[16];
#pragma unroll
        for (int j = 0; j < 16; ++j) acc[j] = 0.f;
#pragma unroll
        for (int b3 = 0; b3 < 3; ++b3) { const u32x4* p = (const u32x4*)(ob + ((size_t)b3 * NTOK + tok) * 1024 + 16 * lane); const u32x4 x0 = __builtin_nontemporal_load(p), x1 = __builtin_nontemporal_load(p + 1);
            acc[0] += w[b3] * bf_lo(x0.x); acc[1] += w[b3] * bf_hi(x0.x); acc[2] += w[b3] * bf_lo(x0.y); acc[3] += w[b3] * bf_hi(x0.y);
            acc[4] += w[b3] * bf_lo(x0.z); acc[5] += w[b3] * bf_hi(x0.z); acc[6] += w[b3] * bf_lo(x0.w); acc[7] += w[b3] * bf_hi(x0.w);
            acc[8] += w[b3] * bf_lo(x1.x); acc[9] += w[b3] * bf_hi(x1.x); acc[10] += w[b3] * bf_lo(x1.y); acc[11] += w[b3] * bf_hi(x1.y);
            acc[12] += w[b3] * bf_lo(x1.z); acc[13] += w[b3] * bf_hi(x1.z); acc[14] += w[b3] * bf_lo(x1.w); acc[15] += w[b3] * bf_hi(x1.w); }
        u32x4 o; o.x = cvt_pk4_fp8(acc[0], acc[1], acc[2], acc[3]); o.y = cvt_pk4_fp8(acc[4], acc[5], acc[6], acc[7]); o.z = cvt_pk4_fp8(acc[8], acc[9], acc[10], acc[11]); o.w = cvt_pk4_fp8(acc[12], acc[13], acc[14], acc[15]);
        *(u32x4*)(a2 + (size_t)tok * D + 16 * lane) = o;
    }
}
__device__ __forceinline__ void fox_item(const Frame& F, int item) {
    const int rnd = item >> 8, cc = item & 255, bh = cc & 63, g4 = cc >> 6; const int qb = 31 - (4 * rnd + ((rnd & 1) ? 3 - g4 : g4));
    const int b = bh >> 4, h = bh & 15;
    const bf16_t* proj = (const bf16_t*)(F.ws + WS_PROJ); const float* cbase = (const float*)(F.ws + WS_CC) + (size_t)bh * SEQ;
    const int lane = F.lane, wave = F.wave, fr = lane & 15, fq = lane >> 4;
    const unsigned ldsbase = (unsigned)(size_t)F.lds;
    constexpr int BUFB = 33792;
    const int qrow = 128 * qb + 16 * wave + fr; const size_t qtok = (size_t)b * SEQ + qrow;
    bf16x8 qf[4];
#pragma unroll
    for (int ks = 0; ks < 4; ++ks) qf[ks] = *(const bf16x8*)(proj + qtok * IN1W + 128 * h + 32 * ks + 8 * fq);
    const float cq = cbase[qrow];
    const int j0 = 2 * qb + 1;
    float qk;
    { const unsigned* kn = (const unsigned*)(F.ws + WS_CTL) + CW_KN + bh * 4; const float kmax = sqrtf(__uint_as_float(kn[0]) + __uint_as_float(kn[1]) + __uint_as_float(kn[2]) + __uint_as_float(kn[3]));
      float qs = 0.f;
#pragma unroll
      for (int ks = 0; ks < 4; ++ks) { const u32x4 w = __builtin_bit_cast(u32x4, qf[ks]);
          qs += bf_lo(w.x) * bf_lo(w.x) + bf_hi(w.x) * bf_hi(w.x) + bf_lo(w.y) * bf_lo(w.y) + bf_hi(w.y) * bf_hi(w.y) + bf_lo(w.z) * bf_lo(w.z) + bf_hi(w.z) * bf_hi(w.z) + bf_lo(w.w) * bf_lo(w.w) + bf_hi(w.w) * bf_hi(w.w); }
      qs += __shfl_xor(qs, 16); qs += __shfl_xor(qs, 32); qk = sqrtf(qs) * kmax * ATT_SCALE; }
    LAS unsigned* pflag = (LAS unsigned*)(F.lds + 2 * BUFB);
    const int sr0 = F.tid >> 4, sch = F.tid & 15;
    u32x4 rk0, rk1, rv0, rv1; float rc = 0.f;
#define FOX_LOAD(j) do { const bf16_t* _p0 = proj + ((size_t)b * SEQ + 64 * (j) + sr0) * IN1W + 128 * h + 8 * sch; const bf16_t* _p1 = _p0 + (size_t)32 * IN1W; \
        rk0 = *(const u32x4*)(_p0 + 2048); rk1 = *(const u32x4*)(_p1 + 2048); rv0 = *(const u32x4*)(_p0 + 4096); rv1 = *(const u32x4*)(_p1 + 4096); if (F.tid < 64) rc = cbase[64 * (j) + F.tid]; } while (0)
#define FOX_WRITE(bufo) do { *(LAS u32x4*)(F.lds + (bufo) + off_b(sr0, sch)) = rk0; *(LAS u32x4*)(F.lds + (bufo) + off_b(sr0 + 32, sch)) = rk1; \
        *(LAS u32x4*)(F.lds + (bufo) + 16384 + off_b(sr0, sch)) = rv0; *(LAS u32x4*)(F.lds + (bufo) + 16384 + off_b(sr0 + 32, sch)) = rv1; if (F.tid < 64) ((LAS float*)(F.lds + (bufo) + 32768))[F.tid] = rc; } while (0)
    __syncthreads();
    FOX_LOAD(j0); FOX_WRITE(0);
    __syncthreads();
    AttnState st; attn_init(st);
    int cur = 0;
#pragma unroll 1
    for (int j = j0; j >= 0; --j) {
        if (j > 0) FOX_LOAD(j - 1);
        const int bufo = cur * BUFB;
        if (64 * j <= 128 * qb + 16 * wave + 15) {
            f32x4 s[4];
            attn_scores(F.lds, bufo, qf, s, fr, fq);
            const LAS float* ck = (const LAS float*)(F.lds + bufo + 32768);
#pragma unroll
            for (int kt = 0; kt < 4; ++kt) { const f32x4 c4 = *(const LAS f32x4*)(ck + 16 * kt + 4 * fq);
#pragma unroll
                for (int r = 0; r < 4; ++r) { const int key = 64 * j + 16 * kt + 4 * fq + r; s[kt][r] = key <= qrow ? s[kt][r] * ATT_SCALE + (cq - c4[r]) : -1e30f; } }
            attn_update(ldsbase, bufo + 16384, s, st, lane);
        }
        if (j > 0) { const float cend = cbase[64 * j - 1];
            const bool need = qk + (cq - cend) - st.m >= -FOX_T;
            const bool anyneed = __any(need);
            if (lane == 0) pflag[cur * 8 + wave] = anyneed ? 1u : 0u;
            FOX_WRITE((cur ^ 1) * BUFB); }
        __syncthreads();
        if (j > 0) { const u32x4 f0 = *(const LAS u32x4*)(pflag + cur * 8), f1 = *(const LAS u32x4*)(pflag + cur * 8 + 4);
            if ((f0.x | f0.y | f0.z | f0.w | f1.x | f1.y | f1.z | f1.w) == 0u) break; }
        cur ^= 1;
    }
    const float inv = 1.0f / st.l; unsigned char* ob = F.ws + WS_A2Q + qtok * D + 128 * h;
#pragma unroll
    for (int c = 0; c < 8; ++c) *(unsigned*)(ob + 16 * c + 4 * fq) = cvt_pk4_fp8(st.o[c][0] * inv, st.o[c][1] * inv, st.o[c][2] * inv, st.o[c][3] * inv);
#undef FOX_LOAD
#undef FOX_WRITE
}
__device__ __forceinline__ unsigned raw_off(int t, int k) { return (unsigned)(t * 256 + ((((k >> 3) ^ (t & 15))) << 4) + (k & 7) * 2); }
__device__ __forceinline__ unsigned raw_chunk(int t, int ch) { return (unsigned)(t * 256 + ((ch ^ (t & 15)) << 4)); }
#define HG_PART_OFF 133120
#ifndef PRB_HA
#define PRB_HA 1
#define PRB_HC 1
#define PRB_DIL 1
#endif
#define HGRN_FRONT(F_OFF, H) \
    const int k_ = F.tid & 127, tq_ = F.tid >> 7; const float lbk_ = ((const float*)(F.ws + WS_LB))[128 * (H) + k_]; \
    float a16[16], key16[16]; { float run_ = 0.f; \
    _Pragma("unroll") for (int i = 0; i < 16; ++i) { const float fl_ = bf2f(*(const LAS bf16_t*)(F.lds + (F_OFF) + raw_off(16 * tq_ + i, k_))); \
        const float fo_ = lbk_ + (1.0f - lbk_) * sigmoidf_(fl_); run_ += __logf(fo_); a16[i] = run_; key16[i] = 1.0f - fo_; } \
    ((LAS float*)(F.lds + HG_PART_OFF))[tq_ * 128 + k_] = run_; } \
    __syncthreads(); \
    float aoff_ = 0.f, atot_ = 0.f; \
    _Pragma("unroll") for (int q = 0; q < 4; ++q) { const float p_ = ((const LAS float*)(F.lds + HG_PART_OFF))[q * 128 + k_]; atot_ += p_; aoff_ += q < tq_ ? p_ : 0.f; } \
    _Pragma("unroll") for (int i = 0; i < 16; ++i) a16[i] += aoff_;

__device__ __forceinline__ void hgrn_a_items(const Frame& F) {
    const bf16_t* proj = (const bf16_t*)(F.ws + WS_PROJ);
    const int lane = F.lane, wave = F.wave, fr = lane & 15, fq = lane >> 4;
    const unsigned ldsbase = (unsigned)(size_t)F.lds;
    constexpr int KD_OFF = 0, VAL_OFF = 20480, F_OFF = 40960;
    const int sr = F.tid >> 4, sch = F.tid & 15;
    u32x2 rf[2], rv[2];
#define HGA_LOAD(it_) do { const int _bh = (it_) >> 6, _c = (it_) & 63, _t0 = (_bh >> 3) * SEQ + 64 * _c, _h = _bh & 7; \
        _Pragma("unroll") for (int _i = 0; _i < 2; ++_i) { const unsigned char* _p = (const unsigned char*)proj + (size_t)(_t0 + sr + 32 * _i) * (IN0W * 2) + 6144 + 128 * _h + 8 * sch; rf[_i] = *(const u32x2*)(_p + 1024); rv[_i] = *(const u32x2*)(_p + 2048); } } while (0)
    int itx = F.bid; if (itx >= 2048 * PRB_HA) return;
    HGA_LOAD(itx & 2047);
    for (;;) {
        const int it = itx & 2047;
        const int h = (it >> 6) & 7;
        __syncthreads();
#pragma unroll
        for (int i = 0; i < 2; ++i) { *(LAS u32x4*)(F.lds + F_OFF + raw_chunk(sr + 32 * i, sch)) = f8x8_to_bf16(rf[i]); *(LAS u32x4*)(F.lds + VAL_OFF + off_b(sr + 32 * i, sch)) = f8x8_to_bf16(rv[i]); }
        const int nit = itx + F.G; const bool has_next = nit < 2048 * PRB_HA;
        if (has_next) HGA_LOAD(nit & 2047);
        __syncthreads();
        HGRN_FRONT(F_OFF, h)
        {
            u32x4 w0, w1; float kd[16];
#pragma unroll
            for (int i = 0; i < 16; ++i) kd[i] = key16[i] * __expf(atot_ - a16[i]);
            w0.x = cvt_pk_bf16(kd[0], kd[1]); w0.y = cvt_pk_bf16(kd[2], kd[3]); w0.z = cvt_pk_bf16(kd[4], kd[5]); w0.w = cvt_pk_bf16(kd[6], kd[7]);
            w1.x = cvt_pk_bf16(kd[8], kd[9]); w1.y = cvt_pk_bf16(kd[10], kd[11]); w1.z = cvt_pk_bf16(kd[12], kd[13]); w1.w = cvt_pk_bf16(kd[14], kd[15]);
            *(LAS u32x4*)(F.lds + KD_OFF + k_ * 144 + tq_ * 32) = w0; *(LAS u32x4*)(F.lds + KD_OFF + k_ * 144 + tq_ * 32 + 16) = w1;
            if (tq_ == 0) ((float*)(F.ws + WS_ALAST))[(size_t)it * 128 + k_] = atot_;
        }
        __syncthreads();
        const unsigned g = lane >> 4, q = (lane & 15) >> 2, p = lane & 3;
        bf16x8 af[2];
        {   s16x4 x0[2], x1[2];
#pragma unroll
            for (int ks = 0; ks < 2; ++ks) { x0[ks] = tr_read(ldsbase + VAL_OFF + off_b(32 * ks + 8 * g + q, 2 * wave + (p >> 1)) + 8 * (p & 1));
                x1[ks] = tr_read(ldsbase + VAL_OFF + off_b(32 * ks + 8 * g + 4 + q, 2 * wave + (p >> 1)) + 8 * (p & 1)); }
            asm volatile("s_waitcnt lgkmcnt(0)" : "+v"(x0[0]), "+v"(x0[1]), "+v"(x1[0]), "+v"(x1[1]) :: "memory");
            af[0] = cat8(x0[0], x1[0]); af[1] = cat8(x0[1], x1[1]); }
        bf16_t* lt = (bf16_t*)(F.ws + WS_LT) + (size_t)it * 16384;
#pragma unroll
        for (int nt = 0; nt < 8; ++nt) { f32x4 acc = (f32x4){0.f, 0.f, 0.f, 0.f};
#pragma unroll
            for (int ks = 0; ks < 2; ++ks) { const bf16x8 bfr = *(const LAS bf16x8*)(F.lds + KD_OFF + (16 * nt + fr) * 144 + (32 * ks + 8 * fq) * 2); acc = MFMA16(af[ks], bfr, acc); }
#pragma unroll
            for (int r = 0; r < 4; ++r) { unsigned ub = __float_as_uint(acc[r]); ub = (ub + 0x7fffu + ((ub >> 16) & 1u)) >> 16;
                lt[(size_t)(16 * wave + 4 * fq + r) * 128 + 16 * nt + fr] = (bf16_t)ub; } }
        if (!has_next) break;
        itx = nit;
    }
#undef HGA_LOAD
}
__device__ __forceinline__ void hgrn_scan(const Frame& F) {
    const int gt = F.bid * NTHREADS + F.tid, GT = F.G * NTHREADS;
    const bf16_t* lt = (const bf16_t*)(F.ws + WS_LT); const float* al = (const float*)(F.ws + WS_ALAST); bf16_t* st = (bf16_t*)(F.ws + WS_ST);
    for (int e = gt; e < 32 * 128 * 32; e += GT) { const int bh = e >> 12, v = (e >> 5) & 127, k4 = (e & 31) * 4;
        f32x4 s = (f32x4){0.f, 0.f, 0.f, 0.f};
#pragma unroll 4
        for (int c = 0; c < 64; ++c) { const size_t it = (size_t)bh * 64 + c; const size_t o = (it * 128 + v) * 128 + k4;
            u32x2 w; w.x = cvt_pk_bf16(s[0], s[1]); w.y = cvt_pk_bf16(s[2], s[3]); *(u32x2*)(st + o) = w;
            const u32x2 lw = __builtin_nontemporal_load((const u32x2*)(lt + o)); const f32x4 l = (f32x4){bf_lo(lw.x), bf_hi(lw.x), bf_lo(lw.y), bf_hi(lw.y)}, a = *(const f32x4*)(al + it * 128 + k4);
            s[0] = __expf(a[0]) * s[0] + l[0]; s[1] = __expf(a[1]) * s[1] + l[1]; s[2] = __expf(a[2]) * s[2] + l[2]; s[3] = __expf(a[3]) * s[3] + l[3]; } }
}
__device__ __forceinline__ void hgrn_c_items(const Frame& F) {
    const bf16_t* proj = (const bf16_t*)(F.ws + WS_PROJ);
    const int lane = F.lane, wave = F.wave, fr = lane & 15, fq = lane >> 4;
    const unsigned ldsbase = (unsigned)(size_t)F.lds;
    constexpr int A_OFF = 0, F_OFF = 34816, Q_OFF = 51200, G_OFF = 67584, VAL_OFF = 83968, ST_OFF = 100352, RMS_OFF = 135168;
    static_assert(G_OFF + 16384 <= VAL_OFF && VAL_OFF + 16384 <= ST_OFF && ST_OFF + 32768 <= HG_PART_OFF && HG_PART_OFF + 2048 <= RMS_OFF && RMS_OFF + 512 <= LDS_MISC, "LDS map");
    const int sr = F.tid >> 4, sch = F.tid & 15;
    u32x2 rf[2], rq[2], rv[2], rg[2]; u32x4 rs[4];
#define HGC_LOAD(it_) do { const int _bh = (it_) >> 6, _c = (it_) & 63, _t0 = (_bh >> 3) * SEQ + 64 * _c, _h = _bh & 7; \
        _Pragma("unroll") for (int _i = 0; _i < 2; ++_i) { const unsigned char* _p = (const unsigned char*)proj + (size_t)(_t0 + sr + 32 * _i) * (IN0W * 2) + 6144 + 128 * _h + 8 * sch; \
            rq[_i] = __builtin_nontemporal_load((const u32x2*)(_p)); rf[_i] = __builtin_nontemporal_load((const u32x2*)(_p + 1024)); rv[_i] = __builtin_nontemporal_load((const u32x2*)(_p + 2048)); rg[_i] = __builtin_nontemporal_load((const u32x2*)(_p + 3072)); } \
        _Pragma("unroll") for (int _i = 0; _i < 4; ++_i) rs[_i] = __builtin_nontemporal_load((const u32x4*)((const bf16_t*)(F.ws + WS_ST) + ((size_t)(it_) * 128 + sr + 32 * _i) * 128 + 8 * sch)); } while (0)
    int itx = F.bid; if (itx >= 2048 * PRB_HC) return;
    HGC_LOAD(itx & 2047);
    for (;;) {
        const int it = itx & 2047;
        const int bh = it >> 6, c = it & 63, b = bh >> 3, h = bh & 7, t0 = b * SEQ + 64 * c;
        __syncthreads();
#pragma unroll
        for (int i = 0; i < 2; ++i) { const unsigned ro = raw_chunk(sr + 32 * i, sch);
            *(LAS u32x4*)(F.lds + F_OFF + ro) = f8x8_to_bf16(rf[i]); *(LAS u32x4*)(F.lds + Q_OFF + ro) = f8x8_to_bf16(rq[i]); *(LAS u32x4*)(F.lds + G_OFF + ro) = f8x8_to_bf16(rg[i]); *(LAS u32x4*)(F.lds + VAL_OFF + off_b(sr + 32 * i, sch)) = f8x8_to_bf16(rv[i]); }
#pragma unroll
        for (int i = 0; i < 4; ++i) *(LAS u32x4*)(F.lds + ST_OFF + off_b(sr + 32 * i, sch)) = rs[i];
        const int nit = itx + F.G; const bool has_next = nit < 2048 * PRB_HC;
        if (has_next) HGC_LOAD(nit & 2047);
        __syncthreads();
        {
        HGRN_FRONT(F_OFF, h)
#pragma unroll
        for (int i = 0; i < 16; ++i) { const int t = 16 * tq_ + i; ((LAS float*)(F.lds + A_OFF))[t * 132 + k_] = a16[i];
            LAS bf16_t* qp = (LAS bf16_t*)(F.lds + Q_OFF + raw_off(t, k_)); *qp = (bf16_t)(cvt_pk_bf16(siluf_(bf2f(*qp)), 0.f) & 0xffffu);
            *(LAS bf16_t*)(F.lds + F_OFF + raw_off(t, k_)) = (bf16_t)(cvt_pk_bf16(key16[i], 0.f) & 0xffffu); }
        }
        __syncthreads();
        const int vh = wave >> 2, I = vh ? 3 - (wave & 3) : (wave & 3);
        const LAS float* al = (const LAS float*)(F.lds + A_OFF);
        f32x4 o[4];
#pragma unroll
        for (int c4 = 0; c4 < 4; ++c4) o[c4] = (f32x4){0.f, 0.f, 0.f, 0.f};
        bf16x8 qh[4];
#pragma unroll
        for (int ks = 0; ks < 4; ++ks) {
            const int t = 16 * I + fr, k = 32 * ks + 8 * fq;
            const u32x4 fw = *(const LAS u32x4*)(F.lds + Q_OFF + raw_chunk(t, 4 * ks + fq));
            const f32x4 a0 = *(const LAS f32x4*)(al + t * 132 + k), a1 = *(const LAS f32x4*)(al + t * 132 + k + 4);
            f32x4 r0 = (f32x4){0.f, 0.f, 0.f, 0.f}, r1 = r0;
            if (I > 0) { r0 = *(const LAS f32x4*)(al + (16 * I - 1) * 132 + k); r1 = *(const LAS f32x4*)(al + (16 * I - 1) * 132 + k + 4); }
            const float f0 = bf_lo(fw.x), f1 = bf_hi(fw.x), f2 = bf_lo(fw.y), f3 = bf_hi(fw.y), f4 = bf_lo(fw.z), f5 = bf_hi(fw.z), f6 = bf_lo(fw.w), f7 = bf_hi(fw.w);
            u32x4 qi; qi.x = cvt_pk_bf16(f0 * __expf(a0[0]), f1 * __expf(a0[1])); qi.y = cvt_pk_bf16(f2 * __expf(a0[2]), f3 * __expf(a0[3]));
            qi.z = cvt_pk_bf16(f4 * __expf(a1[0]), f5 * __expf(a1[1])); qi.w = cvt_pk_bf16(f6 * __expf(a1[2]), f7 * __expf(a1[3]));
            u32x4 qr; qr.x = cvt_pk_bf16(f0 * __expf(a0[0] - r0[0]), f1 * __expf(a0[1] - r0[1])); qr.y = cvt_pk_bf16(f2 * __expf(a0[2] - r0[2]), f3 * __expf(a0[3] - r0[3]));
            qr.z = cvt_pk_bf16(f4 * __expf(a1[0] - r1[0]), f5 * __expf(a1[1] - r1[1])); qr.w = cvt_pk_bf16(f6 * __expf(a1[2] - r1[2]), f7 * __expf(a1[3] - r1[3]));
            qh[ks] = __builtin_bit_cast(bf16x8, qr);
            const bf16x8 qib = __builtin_bit_cast(bf16x8, qi);
#pragma unroll
            for (int c4 = 0; c4 < 4; ++c4) { const bf16x8 sf = *(const LAS bf16x8*)(F.lds + ST_OFF + off_b(16 * (4 * vh + c4) + fr, 4 * ks + fq)); o[c4] = MFMA16(sf, qib, o[c4]); }
        }
        f32x4 sc[4];
#pragma unroll
        for (int J = 0; J < 4; ++J) { sc[J] = (f32x4){0.f, 0.f, 0.f, 0.f};
            if (J <= I && (J & 1) == vh) {
#pragma unroll
                for (int ks = 0; ks < 4; ++ks) {
                    const int s = 16 * J + fr, k = 32 * ks + 8 * fq;
                    const u32x4 kw = *(const LAS u32x4*)(F.lds + F_OFF + raw_chunk(s, 4 * ks + fq));
                    const f32x4 a0 = *(const LAS f32x4*)(al + s * 132 + k), a1 = *(const LAS f32x4*)(al + s * 132 + k + 4);
                    f32x4 r0 = (f32x4){0.f, 0.f, 0.f, 0.f}, r1 = r0;
                    if (I > 0) { r0 = *(const LAS f32x4*)(al + (16 * I - 1) * 132 + k); r1 = *(const LAS f32x4*)(al + (16 * I - 1) * 132 + k + 4); }
                    u32x4 kh; kh.x = cvt_pk_bf16(bf_lo(kw.x) * __expf(r0[0] - a0[0]), bf_hi(kw.x) * __expf(r0[1] - a0[1])); kh.y = cvt_pk_bf16(bf_lo(kw.y) * __expf(r0[2] - a0[2]), bf_hi(kw.y) * __expf(r0[3] - a0[3]));
                    kh.z = cvt_pk_bf16(bf_lo(kw.z) * __expf(r1[0] - a1[0]), bf_hi(kw.z) * __expf(r1[1] - a1[1])); kh.w = cvt_pk_bf16(bf_lo(kw.w) * __expf(r1[2] - a1[2]), bf_hi(kw.w) * __expf(r1[3] - a1[3]));
                    sc[J] = MFMA16(__builtin_bit_cast(bf16x8, kh), qh[ks], sc[J]);
                }
#pragma unroll
                for (int r = 0; r < 4; ++r) sc[J][r] = (J < I || (4 * fq + r) <= fr) ? sc[J][r] : 0.f;
            }
        }
        const unsigned g = lane >> 4, q = (lane & 15) >> 2, p = lane & 3, xm = (q << 2) | g;
        LAS u32x2* xch = (LAS u32x2*)(F.lds + LDS_REC);
        u32x2 own[2];
#pragma unroll
        for (int ks = 0; ks < 2; ++ks) {
            const f32x4 se = sc[2 * ks], so = sc[2 * ks + 1];
            const float x0 = vh ? so[0] : se[0], x1 = vh ? so[1] : se[1], x2 = vh ? so[2] : se[2], x3 = vh ? so[3] : se[3];
            own[ks].x = cvt_pk_bf16(x0, x1); own[ks].y = cvt_pk_bf16(x2, x3);
            xch[((I * 2 + ks) * 2 + vh) * 64 + lane] = own[ks]; }
        __syncthreads();
#pragma unroll
        for (int ks = 0; ks < 2; ++ks) {
            if (2 * ks <= I) {
                const u32x2 oth = xch[((I * 2 + ks) * 2 + (vh ^ 1)) * 64 + lane];
                u32x4 pw; pw.x = vh ? oth.x : own[ks].x; pw.y = vh ? oth.y : own[ks].y; pw.z = vh ? own[ks].x : oth.x; pw.w = vh ? own[ks].y : oth.y;
                const bf16x8 pf = __builtin_bit_cast(bf16x8, pw);
                s16x4 v0[4], v1[4];
#pragma unroll
                for (int c4 = 0; c4 < 4; ++c4) { const unsigned chunk = ((2u * (4 * vh + c4) + (p >> 1)) ^ xm) * 16u + 8u * (p & 1u);
                    v0[c4] = tr_read(ldsbase + VAL_OFF + 256u * (32u * ks + 4u * g + q) + chunk);
                    v1[c4] = tr_read(ldsbase + VAL_OFF + 256u * (32u * ks + 16u + 4u * g + q) + chunk); }
                asm volatile("s_waitcnt lgkmcnt(0)" : "+v"(v0[0]), "+v"(v0[1]), "+v"(v0[2]), "+v"(v0[3]), "+v"(v1[0]), "+v"(v1[1]), "+v"(v1[2]), "+v"(v1[3]) :: "memory");
#pragma unroll
                for (int c4 = 0; c4 < 4; ++c4) o[c4] = MFMA16(cat8(v0[c4], v1[c4]), pf, o[c4]);
            }
        }
        float ss = 0.f;
#pragma unroll
        for (int c4 = 0; c4 < 4; ++c4)
#pragma unroll
            for (int r = 0; r < 4; ++r) ss += o[c4][r] * o[c4][r];
        ss += __shfl_xor(ss, 16); ss += __shfl_xor(ss, 32);
        if (fq == 0) ((LAS float*)(F.lds + RMS_OFF))[vh * 64 + 16 * I + fr] = ss;
        __syncthreads();
        const float tot = ((const LAS float*)(F.lds + RMS_OFF))[16 * I + fr] + ((const LAS float*)(F.lds + RMS_OFF))[64 + 16 * I + fr];
        const float rstd = 1.0f / sqrtf(tot * (1.0f / 128.0f) + RMS_EPS);
        const size_t tok = (size_t)t0 + 16 * I + fr; const float* gn = F.in[4] + 128 * h; unsigned char* a2 = F.ws + WS_A2Q + tok * D + 1024 + 128 * h;
#pragma unroll
        for (int c4 = 0; c4 < 4; ++c4) { const int cc = 4 * vh + c4, v = 16 * cc + 4 * fq;
            const u32x2 gw = *(const LAS u32x2*)(F.lds + G_OFF + raw_chunk(16 * I + fr, 2 * cc + (fq >> 1)) + 8 * (fq & 1)); const f32x4 gg = *(const f32x4*)(gn + v);
            const float g0 = bf_lo(gw.x), g1 = bf_hi(gw.x), g2 = bf_lo(gw.y), g3 = bf_hi(gw.y);
            *(unsigned*)(a2 + v) = cvt_pk4_fp8(o[c4][0] * rstd * gg[0] * siluf_(g0), o[c4][1] * rstd * gg[1] * siluf_(g1), o[c4][2] * rstd * gg[2] * siluf_(g2), o[c4][3] * rstd * gg[3] * siluf_(g3)); }
        if (!has_next) break;
        itx = nit;
    }
#undef HGC_LOAD
}
__device__ __forceinline__ int build_tile_table(const Frame& F, const unsigned* cnt) {
    LAS int* cnts = (LAS int*)(F.lds + LDS_TT); LAS int* tstart = cnts + 72; LAS int* tt = cnts + 256;
    __syncthreads();
    if (F.wave == 0) {
        int c = (int)cnt[64 * F.lane]; c = c > LISTCAP ? LISTCAP : c;
        int n = (c + 255) >> 8, incl = n;
#pragma unroll
        for (int o = 1; o < 64; o <<= 1) { const int u = __shfl_up(incl, o); if (F.lane >= o) incl += u; }
        int s = incl - n;
        if (s > 640) s = 640;
        if (s + n > 640) { n = 640 - s; c = n * 256 < c ? n * 256 : c; }
        cnts[F.lane] = c; tstart[F.lane] = s; if (F.lane == 63) tstart[NE] = s + n;
        for (int ti = 0; ti < n; ++ti) { tt[2 * (s + ti)] = F.lane; tt[2 * (s + ti) + 1] = ti; }
    }
    __syncthreads();
    return tstart[NE];
}
__device__ __forceinline__ int reuse_tile_table(const Frame& F) { return ((const LAS int*)(F.lds + LDS_TT))[72 + NE]; }

__device__ __forceinline__ void phase_stagger(const Frame& F, int groups, int step_ticks) {
    const unsigned long long t0 = __builtin_amdgcn_s_memrealtime(); const unsigned long long wait = (unsigned long long)(((F.bid >> 3) % groups) * step_ticks);
    while (__builtin_amdgcn_s_memrealtime() - t0 < wait) __builtin_amdgcn_s_sleep(4);
}
#ifndef STG_DOWN_G
#define STG_DOWN_G 1
#define STG_DOWN_T 0
#endif
struct Args { const float* in[21]; float* out; unsigned char* ws; int ph_lo, ph_hi; };
constexpr int N_PHASES = 18;

__global__ void __launch_bounds__(NTHREADS, 2) hybrid_fwd(Args args) {
    extern __shared__ __attribute__((aligned(16))) unsigned char lds_raw[];
    Frame F0;
    F0.lds = (LAS unsigned char*)lds_raw; F0.tid = 0; F0.lane = 0; F0.wave = 0; F0.G = gridDim.x; F0.bid = blockIdx.x;
    F0.in = args.in; F0.out = args.out; F0.ws = args.ws;
    unsigned char* ws = args.ws;
    unsigned* ctl = (unsigned*)(ws + WS_CTL);
    volatile LAS unsigned* MISC = (volatile LAS unsigned*)(F0.lds + LDS_MISC);
    const int wave0 = __builtin_amdgcn_readfirstlane((int)threadIdx.x >> 6);
    if (threadIdx.x < 64) MISC[threadIdx.x] = 0u;
    __syncthreads();
    const int lo = args.ph_lo, hi = args.ph_hi;
    XcdBarrier bar; bar.bar = ctl + CW_BAR; bar.x = 0; bar.st = MISC + 8; bar.w0 = wave0;
    if (hi - lo > 1) bar = xcd_barrier_post(ctl + CW_BAR, MISC + 8, wave0);
#ifndef PROBE_MASK
#define PROBE_MASK 0
#endif
#define REPS(k) (((((PROBE_MASK) >> (k)) & 1) && hi > 1) ? 2 : 1)
#ifndef DBG_MASK
#define DBG_MASK 0x3ffff
#endif
#define IN(k) (((DBG_MASK >> (k)) & 1) && lo <= (k) && (k) < hi)
#define PHASE_FRAME() Frame F = F0; { int t_ = (wave0 << 6) + lane_id_(); asm volatile("" : "+v"(t_)); F.tid = t_; F.lane = t_ & 63; F.wave = __builtin_amdgcn_readfirstlane(t_ >> 6); }
#define SEAM(k) do { if (lo <= (k) && (k) + 1 < hi) xcd_barrier(bar); } while (0)
    constexpr int SHADOW_IPS = 2 * 256 * NWAVES, SHADOW_SEAMS = 12, SHADOW_ITEMS = (SHADOW_IPS * SHADOW_SEAMS < NEX * EXP_ITEMS) ? SHADOW_IPS * SHADOW_SEAMS : NEX * EXP_ITEMS;
    const bool shadow_on = (lo == 0 && hi == N_PHASES && F0.G == 256);
#define SEAM_CONV(k, slot) do { if (lo <= (k) && (k) + 1 < hi) { if (shadow_on) { const XbTicket tk_ = xcd_barrier_arrive(bar); \
            { Frame FS = F0; int t_ = (wave0 << 6) + lane_id_(); asm volatile("" : "+v"(t_)); FS.tid = t_; FS.lane = t_ & 63; FS.wave = __builtin_amdgcn_readfirstlane(t_ >> 6); \
              convert_items<1>(FS, 1, (slot) * SHADOW_IPS, ((slot) + 1) * SHADOW_IPS < NEX * EXP_ITEMS ? ((slot) + 1) * SHADOW_IPS : NEX * EXP_ITEMS, FS.bid * NWAVES + FS.wave, FS.G * NWAVES); } \
            xcd_barrier_wait(bar, tk_); } else xcd_barrier(bar); } } while (0)

#define SEAM_L(pid, layer) do { if ((layer) == 0 && (pid) != 7) SEAM_CONV(pid, (pid) <= 6 ? (pid) : (pid) - 1); else if ((layer) == 1 && (pid) <= 13) SEAM_CONV(pid, (pid) - 2); else SEAM(pid); } while (0)
    if (IN(0)) { PHASE_FRAME(); _Pragma("unroll 1") for (int rep_ = 0; rep_ < REPS(0); ++rep_) phase_prologue(F); SEAM_CONV(0, 0); }
#define PH_INPROJ(pid, layer) if (IN(pid)) { PHASE_FRAME(); \
        if ((layer) == 1) { fox_cumsum(F); convert_experts(F, 1, shadow_on ? SHADOW_ITEMS : 0, NEX * EXP_ITEMS, F.bid * NWAVES + F.wave, F.G * NWAVES); __syncthreads();     \
            pg8::ProbPlain8 P{(const char*)(ws + WS_XQ), (const char*)(ws + WS_WIN1), D, NTOK / 256, IN1W / 256, F.G, F.bid}; \
            pg8::EpiBf16 E{(bf16_t*)(ws + WS_PROJ), IN1W, ctl + CW_KN, 8, 16}; pg8::gemm_phase(F.lds, P, E, F.wave); } \
        else if (F8_FGATE) { pg8::ProbPlain8 P{(const char*)(ws + WS_XQ), (const char*)(ws + WS_WIN0Q), D, NTOK / 256, IN0W / 256, F.G, F.bid};            \
              pg8::EpiProj0 E{(bf16_t*)(ws + WS_PROJ)}; pg8::gemm_phase(F.lds, P, E, F.wave); } \
        else { { pg8::ProbPlain8 P{(const char*)(ws + WS_XQ), (const char*)(ws + WS_WIN0Q), D, NTOK / 256, 16, F.G, F.bid};            \
              pg8::EpiBf16 E{(bf16_t*)(ws + WS_PROJ), IN0W, nullptr, 8, 16}; pg8::gemm_phase(F.lds, P, E, F.wave); } \
            { pg8::ProbPlain P{(const char*)(ws + WS_XA), (const char*)(ws + WS_WIN0) + (size_t)4096 * D * 2, D, NTOK / 256, 4, F.G, F.bid};     \
              pg8::EpiBf16 E{(bf16_t*)(ws + WS_PROJ) + 4096, IN0W, nullptr, 8, 16}; pg8::gemm_phase(F.lds, P, E, F.wave); } \
            { pg8::ProbPlain8 P{(const char*)(ws + WS_XQ), (const char*)(ws + WS_WIN0Q) + (size_t)5120 * D, D, NTOK / 256, 8, F.G, F.bid};     \
              pg8::EpiBf16 E{(bf16_t*)(ws + WS_PROJ) + 5120, IN0W, nullptr, 8, 16}; pg8::gemm_phase(F.lds, P, E, F.wave); } } SEAM_L(pid, layer); }
#define PH_OUTPROJ(pid, layer) if (IN(pid)) { PHASE_FRAME(); \
        pg8::ProbPlain8 P{(const char*)(ws + WS_A2Q), (const char*)(ws + ((layer) ? WS_WOUT1 : WS_WOUT0)), D, NTOK / 256, D / 256, F.G, F.bid}; \
        pg8::EpiF8 E{(unsigned char*)(ws + WS_YF), D, YF_SCALE}; pg8::gemm_phase(F.lds, P, E, F.wave); SEAM_L(pid, layer); }
#define PH_ROUTER(pid, layer) if (IN(pid)) { PHASE_FRAME(); \
        RouterArgs a{(layer) ? (const float*)(ws + WS_X2F) : F.in[0], (const bf16_t*)(ws + WS_YF), F.in[9] + (layer) * D, F.in[10] + (layer) * D, (bf16_t*)(ws + WS_X1B), (unsigned char*)(ws + WS_X1Q), \
                  (const bf16_t*)(ws + WS_RT) + (size_t)((layer) * 2 + 0) * 64 * D, (const bf16_t*)(ws + WS_RT) + (size_t)((layer) * 2 + 1) * 64 * D, \
                  (const float*)(ws + WS_RGB) + ((layer) * 2 + 0) * 64, (const float*)(ws + WS_RGB) + ((layer) * 2 + 1) * 64, F.in[14] + (layer) * 64, ctl + CW_CNT + (layer) * 66 * 64, (int*)(ws + WS_LISTS)}; \
        phase_router<((layer) != 0)>(F, a); SEAM_L(pid, layer); }
#define PH_GATEUP(pid, layer) if (IN(pid)) { PHASE_FRAME(); \
        const int ntiles = build_tile_table(F, ctl + CW_CNT + (layer) * 66 * 64); \
        pg8::ProbMoE<true> P{(const char*)(ws + WS_X1Q), (const char*)(ws + WS_WGU + (size_t)(layer) * WGU_LAYER), D, ntiles, 4, F.G, F.bid, (const int*)(ws + WS_LISTS), (const LAS int*)(F.lds + LDS_TT) + 256, (const LAS int*)(F.lds + LDS_TT), (const LAS unsigned short*)(F.lds + LDS_TT + 6656)}; \
        pg8::fill_tok_cache(P, (LAS unsigned short*)(F.lds + LDS_TT + 6656), F.tid); \
        pg8::EpiSwiGLU E{(unsigned char*)(ws + WS_H)}; pg8::gemm_phase(F.lds, P, E, F.wave); \
        { pg8::ProbPlain8 PS{(const char*)(ws + WS_X1Q), (const char*)(ws + WS_WSH + (size_t)(layer) * WSH_LAYER), D, NTOK / 256, 4, F.G, F.bid}; \
          pg8::EpiSwiGLU16 ES{(bf16_t*)(ws + WS_HSH)}; pg8::gemm_phase(F.lds, PS, ES, F.wave); } SEAM_L(pid, layer); }
#define PH_DOWN(pid, layer) if (IN(pid)) { PHASE_FRAME(); \
        const int ntiles = (lo < (pid)) ? reuse_tile_table(F) : build_tile_table(F, ctl + CW_CNT + (layer) * 66 * 64);     \
        pg8::ProbMoE<false> P{(const char*)(ws + WS_H), (const char*)(ws + WS_WD + (size_t)(layer) * WD_LAYER), EDIM, ntiles, 8, F.G, F.bid, (const int*)(ws + WS_LISTS), (const LAS int*)(F.lds + LDS_TT) + 256, (const LAS int*)(F.lds + LDS_TT), nullptr}; \
        pg8::EpiDown E{(unsigned char*)(ws + WS_Y), F.lds}; pg8::fill_rec_cache(P, F.lds, F.tid); pg8::gemm_phase(F.lds, P, E, F.wave); if (REPS(pid) > 1) { asm volatile("" : "+s"(P.A), "+s"(P.Bt) :: "memory"); pg8::gemm_phase(F.lds, P, E, F.wave); } \
        { pg8::ProbPlain PS{(const char*)(ws + WS_HSH), (const char*)(ws + WS_WSH + (size_t)(layer) * WSH_LAYER + 4 * MiB), EDIM, NTOK / 256, D / 256, F.G, F.bid}; \
          pg8::EpiY8 ES{(unsigned char*)(ws + WS_Y)}; pg8::gemm_phase(F.lds, PS, ES, F.wave); } SEAM_L(pid, layer); }
    PH_INPROJ(1, 0)
    constexpr int CJ2 = (int)((long)CONV_JOBS * CONV_F2 / 1024), CJ3 = (int)((long)CONV_JOBS * CONV_F3 / 1024);
    if (IN(2)) { PHASE_FRAME(); if (is_converter(F)) convert_jobs(F, 0, CJ2); else { const Frame W = work_frame(F); dilated_items(W); hgrn_a_items(W); } SEAM_CONV(2, 2); }
    if (IN(3)) { PHASE_FRAME(); if (is_converter(F)) convert_jobs(F, CJ2, CJ3); else { const Frame W = work_frame(F); hgrn_scan(W); } SEAM_CONV(3, 3); }
    if (IN(4)) { PHASE_FRAME(); if (is_converter(F)) convert_jobs(F, CJ3, CONV_JOBS); else { const Frame W = work_frame(F); hgrn_c_items(W); combine_tokens(W); } SEAM_CONV(4, 4); }
    PH_OUTPROJ(5, 0)
    PH_ROUTER(6, 0)
    PH_GATEUP(7, 0)
    PH_DOWN(8, 0)
    if (IN(9)) { PHASE_FRAME();
        RowArgs a{(const float*)(ws + WS_X1B), (const bf16_t*)(ws + WS_Y), F.in[11], F.in[12], (float*)(ws + WS_X2F), (bf16_t*)(ws + WS_XQ),
                  (const bf16_t*)(ws + WS_FGHI), (const bf16_t*)(ws + WS_FGLO), nullptr, nullptr, nullptr, (const bf16_t*)(ws + WS_YSH), (float*)(ws + WS_FLOG)};
        _Pragma("unroll 1") for (int rep_ = 0; rep_ < REPS(9); ++rep_) phase_rows<1, 1>(F, a); SEAM_CONV(9, 8); }
    PH_INPROJ(11, 1)
    if (IN(12)) { PHASE_FRAME(); _Pragma("unroll 1") for (int rep_ = 0; rep_ < REPS(12); ++rep_) for (int it = F.bid; it < 2048; it += F.G) fox_item(F, it); SEAM_CONV(12, 10); }
    PH_OUTPROJ(13, 1)
    PH_ROUTER(14, 1)
    PH_GATEUP(15, 1)
    PH_DOWN(16, 1)
    if (IN(17)) { PHASE_FRAME();
        RowArgs a{(const float*)(ws + WS_X1B), (const bf16_t*)(ws + WS_Y), F.in[11] + D, F.in[12] + D, F.out, (bf16_t*)(ws + WS_XA),
                  nullptr, nullptr, nullptr, nullptr, nullptr, (const bf16_t*)(ws + WS_YSH), nullptr};
        _Pragma("unroll 1") for (int rep_ = 0; rep_ < REPS(17); ++rep_) phase_rows<1, 0>(F, a); }
#undef IN
#undef SEAM
}

#ifndef MK_N_LAUNCHES
#define MK_N_LAUNCHES 1
#endif
extern "C" void kernel_launch(void* const* d_in, const int* in_sizes, int n_in, void* d_out, int out_size, void* d_ws, size_t ws_size, hipStream_t stream) {
    static int grid = 0;
    if (grid == 0) {
        if (n_in != 21 || out_size != NTOK * D || ws_size < WS_END) { fprintf(stderr, "kernel_launch: unexpected shapes (n_in %d, out %d, ws %zu < %zu)\n", n_in, out_size, ws_size, (size_t)WS_END); grid = -1; return; }
        int dev = 0, cus = 0, per_cu = 0;
        if (hipGetDevice(&dev) != hipSuccess || hipDeviceGetAttribute(&cus, hipDeviceAttributeMultiprocessorCount, dev) != hipSuccess) { grid = -1; return; }
        if (hipFuncSetAttribute((const void*)hybrid_fwd, hipFuncAttributeMaxDynamicSharedMemorySize, LDS_BYTES) != hipSuccess) { fprintf(stderr, "kernel_launch: hipFuncSetAttribute failed\n"); grid = -1; return; }
        if (hipOccupancyMaxActiveBlocksPerMultiprocessor(&per_cu, (const void*)hybrid_fwd, NTHREADS, LDS_BYTES) != hipSuccess || per_cu < 1) { fprintf(stderr, "kernel_launch: occupancy query says %d\n", per_cu); }
        (void)hipGetLastError();
        grid = cus;
    }
    if (grid < 0) return;
    (void)in_sizes;
    if (hipMemsetAsync((char*)d_ws + WS_CTL, 0, CTL_ZERO_BYTES, stream) != hipSuccess) return;
    Args a{};
    for (int i = 0; i < 21; ++i) a.in[i] = (const float*)d_in[i];
    a.out = (float*)d_out; a.ws = (unsigned char*)d_ws;
    if (MK_N_LAUNCHES == 1) { a.ph_lo = 0; a.ph_hi = N_PHASES; hipLaunchKernelGGL(hybrid_fwd, dim3(grid), dim3(NTHREADS), LDS_BYTES, stream, a); }
    else for (int p = 0; p < N_PHASES; ++p) { a.ph_lo = p; a.ph_hi = p + 1; hipLaunchKernelGGL(hybrid_fwd, dim3(grid), dim3(NTHREADS), LDS_BYTES, stream, a); }
}
```
